# Optimizing an MI355X kernel written in HIP

```python
import math
import jax
import jax.numpy as jnp
from jax import lax
import numpy as np

D_MODEL = 1024
BATCH = 8
SEQ = 2048
DEPTH = 4
DEC_BATCH = 128
DEC_SEQ = 8
PAST_LEN = 2048
PAGE_SIZE = 128

HEAD_DIM = 64
NSA_HEADS = D_MODEL // (2 * HEAD_DIM)
NSA_KV = 2
NSA_QPG = NSA_HEADS // NSA_KV
NSA_WIDTH = NSA_HEADS * HEAD_DIM
NSA_KV_WIDTH = NSA_KV * HEAD_DIM
CMP_LEN = 32
CMP_STRIDE = 16
CMP_HIDDEN = 2 * HEAD_DIM
SEL_LEN = 64
N_SELECT = 16
WINDOW = 512
NSA_CHUNK = 64
FORCE_SCORE = 1e9
RWKV_HEADS = D_MODEL // (2 * HEAD_DIM)
RWKV_WIDTH = RWKV_HEADS * HEAD_DIM
DECAY_LORA = 64
AAA_LORA = 64
GATE_LORA = 128
RWKV_PROJ = 3 * RWKV_WIDTH + DECAY_LORA + AAA_LORA + GATE_LORA
NSA_PROJ = NSA_WIDTH + 6 * NSA_KV_WIDTH + 3 * NSA_HEADS
EVEN_PROJ = NSA_PROJ + RWKV_PROJ
MIX_WIDTH = NSA_WIDTH + RWKV_WIDTH
CONV_WIDTH = D_MODEL
CONV_K = 3
D_FF = ((8 * D_MODEL // 3 + 255) // 256) * 256
FFN_CONV_K = 3
NUM_BUCKETS = 32
MAX_DISTANCE = 128
N_EVEN = (DEPTH + 1) // 2
N_ODD = DEPTH // 2
RMS_EPS = 1e-6
GN_EPS = 64e-5

kernel_name = 'nsa_rwkv7_shortconv_convffn_decode_step'


def rms_norm(x, g):
    xf = x.astype(jnp.float32)
    y = xf * lax.rsqrt(jnp.mean(xf * xf, axis=-1, keepdims=True) + RMS_EPS)
    return (y * g.astype(jnp.float32)).astype(x.dtype)


def masked_softmax(s, mask):
    s = jnp.where(mask, s, -jnp.inf)
    m = jnp.max(s, axis=-1, keepdims=True)
    e = jnp.exp(s - jnp.where(jnp.isfinite(m), m, 0.0))
    den = jnp.sum(e, axis=-1, keepdims=True)
    return e / jnp.where(den > 0, den, 1.0)


def rel_bucket(dist):
    n = jnp.maximum(dist, 0)
    max_exact = NUM_BUCKETS // 2
    nf = jnp.maximum(n, 1).astype(jnp.float32)
    large = max_exact + (jnp.log(nf / max_exact) / math.log(MAX_DISTANCE / max_exact)
                         * (NUM_BUCKETS - max_exact)).astype(jnp.int32)
    large = jnp.minimum(large, NUM_BUCKETS - 1)
    return jnp.where(n < max_exact, n, large)


def causal_dwconv(u, prev, w):
    kw = w.shape[0]
    t = u.shape[1]
    ext = jnp.concatenate([prev.astype(u.dtype), u], axis=1)
    y = ext[:, 0:t] * w[0]
    for j in range(1, kw):
        y = y + ext[:, j:j + t] * w[j]
    return y, ext[:, t:]


def compress(k, pe, w1, w2):
    b, t = k.shape[:2]
    r_n = CMP_LEN // CMP_STRIDE
    m = t // CMP_STRIDE
    nc = m - r_n + 1
    seg = k[:, :m * CMP_STRIDE].reshape(b, m, CMP_STRIDE, NSA_KV, HEAD_DIM)
    w1r = w1.reshape(r_n, CMP_STRIDE, HEAD_DIM, CMP_HIDDEN)
    part = jnp.einsum('bmjgd,rjde->rbmge', seg, w1r)
    hid = jnp.einsum('jd,jde->e', pe, w1) + part[0, :, 0:nc]
    for r in range(1, r_n):
        hid = hid + part[r, :, r:r + nc]
    return jnp.einsum('bnge,ed->bngd', jax.nn.gelu(hid), w2)


def nsa_chunk(q, gate, qpos, kc, vc, cend, ks_blk, vs_blk, kw, vw, wpos, overlap, rel_bias):
    b, c = q.shape[:2]
    scale = HEAD_DIM ** -0.5
    tb = rel_bias.astype(jnp.float32).reshape(NUM_BUCKETS, NSA_KV, NSA_QPG)
    dist_c = qpos[:, None] - cend[None, :]
    s_c = jnp.einsum('bcgqd,bngd->bcgqn', q, kc).astype(jnp.float32) * scale
    s_c = s_c + jnp.moveaxis(tb[rel_bucket(dist_c)], 1, -1)[None]
    p_c = masked_softmax(s_c, (dist_c >= 0)[None, :, None, None, :])
    o_c = jnp.einsum('bcgqn,bngd->bcgqd', p_c.astype(vc.dtype), vc)
    ns = ks_blk.shape[2]
    imp = jnp.einsum('bcgqn,ns->bcgs', p_c, overlap)
    blk = jnp.arange(ns, dtype=jnp.int32)[None, :]
    cur = (qpos // SEL_LEN)[:, None]
    forced = (blk == 0) | (blk == cur) | (blk == cur - 1)
    future = blk * SEL_LEN > qpos[:, None]
    imp = jnp.where(forced[None, :, None], FORCE_SCORE, imp)
    imp = jnp.where(future[None, :, None], -FORCE_SCORE, imp)
    n_top = min(N_SELECT, ns)
    _, idx = lax.top_k(imp, n_top)
    bi = jnp.arange(b)[:, None, None, None]
    gi = jnp.arange(NSA_KV)[None, None, :, None]
    n_keys = n_top * SEL_LEN
    k_sel = ks_blk[bi, gi, idx].reshape(b, c, NSA_KV, n_keys, HEAD_DIM)
    v_sel = vs_blk[bi, gi, idx].reshape(b, c, NSA_KV, n_keys, HEAD_DIM)
    kpos = (idx[..., None] * SEL_LEN + jnp.arange(SEL_LEN, dtype=jnp.int32)).reshape(b, c, NSA_KV, n_keys)
    dist_s = qpos[None, :, None, None] - kpos
    s_s = jnp.einsum('bcgqd,bcgkd->bcgqk', q, k_sel).astype(jnp.float32) * scale
    s_s = s_s + jnp.swapaxes(tb[rel_bucket(dist_s), gi], -1, -2)
    p_s = masked_softmax(s_s, (dist_s >= 0)[:, :, :, None, :])
    o_s = jnp.einsum('bcgqk,bcgkd->bcgqd', p_s.astype(v_sel.dtype), v_sel)
    dist_w = qpos[:, None] - wpos[None, :]
    s_w = jnp.einsum('bcgqd,bwgd->bcgqw', q, kw).astype(jnp.float32) * scale
    s_w = s_w + jnp.moveaxis(tb[rel_bucket(dist_w)], 1, -1)[None]
    mask_w = (dist_w >= 0) & (dist_w < WINDOW) & (wpos >= 0)[None, :]
    p_w = masked_softmax(s_w, mask_w[None, :, None, None, :])
    o_w = jnp.einsum('bcgqw,bwgd->bcgqd', p_w.astype(vw.dtype), vw)
    g = jax.nn.sigmoid(gate.astype(jnp.float32))
    o = g[..., 0:1] * o_c + g[..., 1:2] * o_s + g[..., 2:3] * o_w
    return o.astype(q.dtype)


def nsa_attend(q, gates, k_cmp, v_cmp, k_slc, v_slc, k_win, v_win, q0, w0, chunk, banded, phi, rel_bias):
    b, tq = q.shape[:2]
    pe, w1, w2, kn_cmp = phi
    kc = rms_norm(compress(k_cmp, pe[0], w1[0], w2[0]), kn_cmp)
    vc = compress(v_cmp, pe[1], w1[1], w2[1])
    nc = kc.shape[1]
    cend = jnp.arange(nc, dtype=jnp.int32) * CMP_STRIDE + (CMP_LEN - 1)
    t_all = k_slc.shape[1]
    ns = -(-t_all // SEL_LEN)

    def blockify(a):
        a = jnp.pad(a, ((0, 0), (0, ns * SEL_LEN - t_all), (0, 0), (0, 0)))
        return a.reshape(b, ns, SEL_LEN, NSA_KV, HEAD_DIM).transpose(0, 3, 1, 2, 4)

    ks_blk, vs_blk = blockify(k_slc), blockify(v_slc)
    c0 = jnp.arange(nc)[:, None] * CMP_STRIDE
    s0 = jnp.arange(ns)[None, :] * SEL_LEN
    overlap = ((c0 < s0 + SEL_LEN) & (c0 + CMP_LEN > s0)).astype(jnp.float32)
    n_chunks = tq // chunk

    def to_chunks(a):
        return jnp.swapaxes(a.reshape((b, n_chunks, chunk) + a.shape[2:]), 0, 1)

    qc = to_chunks(q.reshape(b, tq, NSA_KV, NSA_QPG, HEAD_DIM))
    gc = to_chunks(gates.reshape(b, tq, NSA_KV, NSA_QPG, 3))
    if banded:
        pad = ((0, 0), (WINDOW, 0), (0, 0), (0, 0))
        kw_src, vw_src = jnp.pad(k_win, pad), jnp.pad(v_win, pad)
        span = WINDOW + chunk
    else:
        kw_src, vw_src = k_win, v_win
        span = k_win.shape[1]

    def body(args):
        q_i, g_i, c_i = args
        start = c_i * chunk
        qpos = q0 + start + jnp.arange(chunk, dtype=jnp.int32)
        if banded:
            kw_i = lax.dynamic_slice_in_dim(kw_src, start, span, axis=1)
            vw_i = lax.dynamic_slice_in_dim(vw_src, start, span, axis=1)
            wpos = w0 + start - WINDOW + jnp.arange(span, dtype=jnp.int32)
        else:
            kw_i, vw_i = kw_src, vw_src
            wpos = w0 + jnp.arange(span, dtype=jnp.int32)
        return nsa_chunk(q_i, g_i, qpos, kc, vc, cend, ks_blk, vs_blk, kw_i, vw_i, wpos, overlap, rel_bias)

    out = lax.map(body, (qc, gc, jnp.arange(n_chunks, dtype=jnp.int32)))
    return jnp.swapaxes(out, 0, 1).reshape(b, tq, NSA_WIDTH)


def rwkv_mix(z, z_prev, s0, li, P):
    b, t, _ = z.shape
    f32 = jnp.float32
    shifted = jnp.concatenate([z_prev[:, None].astype(z.dtype), z[:, :-1]], axis=1)
    zz = z + (shifted - z) * P['rwkv_mu'][li]
    offs = [RWKV_WIDTH, 2 * RWKV_WIDTH, 3 * RWKV_WIDTH, 3 * RWKV_WIDTH + DECAY_LORA,
            3 * RWKV_WIDTH + DECAY_LORA + AAA_LORA]
    r, k, v, zw, za, zg = jnp.split(zz, offs, axis=-1)
    w_log = -jax.nn.softplus(-(P['rwkv_w0'][li] + jnp.tanh(zw) @ P['rwkv_w2'][li]).astype(f32)) - 0.5
    decay = jnp.exp(-jnp.exp(w_log))
    a = jax.nn.sigmoid((P['rwkv_a0'][li] + za @ P['rwkv_a2'][li]).astype(f32))
    g = jax.nn.sigmoid(zg) @ P['rwkv_g2'][li]

    def hd(a_):
        return a_.reshape(b, t, RWKV_HEADS, HEAD_DIM)

    kk = hd((k * P['rwkv_kk'][li]).astype(f32))
    kk = kk * lax.rsqrt(jnp.maximum(jnp.sum(kk * kk, axis=-1, keepdims=True), 1e-24))
    k_mod = hd(k.astype(f32) * (1.0 + (a - 1.0) * P['rwkv_ka'][li].astype(f32)))
    r_h, v_h, a_h, w_h = hd(r.astype(f32)), hd(v.astype(f32)), hd(a), hd(decay)

    def step(S, inp):
        r_t, w_t, k_t, v_t, kk_t, a_t = inp
        sa = jnp.einsum('bhij,bhj->bhi', S, -kk_t)
        S = (S * w_t[:, :, None, :] + sa[..., None] * (kk_t * a_t)[:, :, None, :]
             + v_t[..., None] * k_t[:, :, None, :])
        return S, jnp.einsum('bhij,bhj->bhi', S, r_t)

    xs = tuple(jnp.swapaxes(a_, 0, 1) for a_ in (r_h, w_h, k_mod, v_h, kk, a_h))
    s_t, y = lax.scan(step, s0.astype(f32), xs)
    y = jnp.swapaxes(y, 0, 1)
    mu = jnp.mean(y, axis=-1, keepdims=True)
    var = jnp.mean(jnp.square(y - mu), axis=-1, keepdims=True)
    y = (y - mu) * lax.rsqrt(var + GN_EPS)
    y = (y * P['rwkv_ln_w'][li].astype(f32).reshape(RWKV_HEADS, HEAD_DIM)
         + P['rwkv_ln_b'][li].astype(f32).reshape(RWKV_HEADS, HEAD_DIM))
    y = y + jnp.sum(r_h * k_mod * P['rwkv_rk'][li].astype(f32), axis=-1, keepdims=True) * v_h
    y = y.reshape(b, t, RWKV_WIDTH).astype(z.dtype) * g
    return y, s_t, z[:, -1]


def nsa_rwkv_mixer(h, li, P, st):
    b, t, _ = h.shape
    z = jnp.einsum('btd,de->bte', h, P['w_in_even'][li])
    sizes = [NSA_WIDTH] + [NSA_KV_WIDTH] * 6 + [3 * NSA_HEADS]
    offs, acc = [], 0
    for s in sizes:
        acc += s
        offs.append(acc)
    q, k_c, v_c, k_s, v_s, k_w, v_w, gates, z_rwkv = jnp.split(z, offs, axis=-1)

    def kvh(a_):
        return a_.reshape(b, t, NSA_KV, HEAD_DIM)

    q = rms_norm(q.reshape(b, t, NSA_HEADS, HEAD_DIM), P['q_norm'][li])
    k_c, v_c, v_s, v_w = kvh(k_c), kvh(v_c), kvh(v_s), kvh(v_w)
    k_s = rms_norm(kvh(k_s), P['k_norm'][li, 1])
    k_w = rms_norm(kvh(k_w), P['k_norm'][li, 2])
    phi = (P['phi_pe'][li], P['phi_w1'][li], P['phi_w2'][li], P['k_norm'][li, 0])
    if st is None:
        nsa = nsa_attend(q, gates, k_c, v_c, k_s, v_s, k_w, v_w, 0, 0, NSA_CHUNK, True, phi, P['rel_bias'])
        win_k, win_v = k_w, v_w
        z_prev = jnp.zeros((b, RWKV_PROJ), h.dtype)
        s0 = jnp.zeros((b, RWKV_HEADS, HEAD_DIM, HEAD_DIM), jnp.float32)
    else:
        pt = st['page_table']
        past = pt.shape[1] * PAGE_SIZE

        def paged(pool):
            rows = pool[pt, li]
            return rows.reshape(b, past, 2, NSA_KV, HEAD_DIM).astype(h.dtype)

        def cat(a_, b_):
            return jnp.concatenate([a_, b_], axis=1)

        pc, ps = paged(st['cmp']), paged(st['slc'])
        buf = st['win'][:, li].astype(h.dtype)
        wb = buf.shape[1]
        win_k, win_v = cat(buf[:, :, 0], k_w), cat(buf[:, :, 1], v_w)
        nsa = nsa_attend(q, gates, cat(pc[:, :, 0], k_c), cat(pc[:, :, 1], v_c),
                         cat(ps[:, :, 0], k_s), cat(ps[:, :, 1], v_s), win_k, win_v,
                         past, past - wb, 1, False, phi, P['rel_bias'])
        z_prev = st['shift'][:, li]
        s0 = st['wkv'][:, li]
    n_keep = min(WINDOW, win_k.shape[1])
    win_rows = jnp.stack([win_k, win_v], axis=2)[:, -n_keep:]
    rw, s_t, z_last = rwkv_mix(z_rwkv, z_prev, s0, li, P)
    out = jnp.einsum('bte,ed->btd', jnp.concatenate([nsa, rw], axis=-1), P['w_out_even'][li])
    return out, (jnp.stack([k_c, v_c], axis=2), jnp.stack([k_s, v_s], axis=2), win_rows, s_t, z_last)


def conv_mixer(h, li, P, st):
    b = h.shape[0]
    z = jnp.einsum('btd,de->bte', h, P['w_in_odd'][li])
    bg, cg, xi = jnp.split(z, [CONV_WIDTH, 2 * CONV_WIDTH], axis=-1)
    prev = jnp.zeros((b, CONV_K - 1, CONV_WIDTH), h.dtype) if st is None else st['conv'][:, li]
    c, new = causal_dwconv(cg * xi, prev, P['conv_w'][li])
    return jnp.einsum('bte,ed->btd', bg * c, P['w_out_odd'][li]), new


def conv_ffn(h, l, P, st):
    b = h.shape[0]
    a, u = jnp.split(jnp.einsum('btd,df->btf', h, P['ffn_up'][l]), [D_FF], axis=-1)
    prev = jnp.zeros((b, FFN_CONV_K - 1, D_FF), h.dtype) if st is None else st['ffn'][:, l]
    ac, new = causal_dwconv(a, prev, P['ffn_conv'][l])
    return jnp.einsum('btf,fd->btd', jax.nn.silu(ac) * u, P['ffn_down'][l]), new


def trunk(x, P, st):
    cmp_r, slc_r, win_r, wkv_r, sh_r, conv_r, ffn_r = [], [], [], [], [], [], []
    for l in range(DEPTH):
        li = l // 2
        h = rms_norm(x, P['norm_mix'][l])
        if l % 2 == 0:
            o, (c_, s_, w_, S_, sh_) = nsa_rwkv_mixer(h, li, P, st)
            cmp_r.append(c_)
            slc_r.append(s_)
            win_r.append(w_)
            wkv_r.append(S_)
            sh_r.append(sh_)
        else:
            o, cs = conv_mixer(h, li, P, st)
            conv_r.append(cs)
        x = x + o
        o, fs = conv_ffn(rms_norm(x, P['norm_ffn'][l]), l, P, st)
        ffn_r.append(fs)
        x = x + o
    stk = lambda a_: jnp.stack(a_, axis=1)
    return x, (stk(cmp_r), stk(slc_r), stk(win_r), stk(wkv_r), stk(sh_r), stk(conv_r), stk(ffn_r))


def setup_inputs(seed: int = 0) -> dict:
    key = jax.random.key(seed)
    keys = jax.random.split(key, 64)
    counter = iter(range(64))

    def nk():
        return keys[next(counter)]

    def nrm(shape, scale=1.0):
        return jax.random.normal(nk(), shape, jnp.float32) * scale

    def gain(shape, base=1.0):
        return base + 0.05 * jax.random.normal(nk(), shape, jnp.float32)

    def unif(shape, lo, hi):
        return jax.random.uniform(nk(), shape, jnp.float32, lo, hi)

    n_pages = PAST_LEN // PAGE_SIZE
    used = DEC_BATCH * n_pages
    n_pool = used + max(used // 4, 1)
    wb = min(WINDOW, PAST_LEN)
    d = D_MODEL
    return {
        'x_prompt': nrm((BATCH, SEQ, d)),
        'x_sample': nrm((DEC_BATCH, DEC_SEQ, d)),
        'cache_cmp_kv': nrm((n_pool, N_EVEN, PAGE_SIZE, 2, NSA_KV, HEAD_DIM)),
        'cache_slc_kv': nrm((n_pool, N_EVEN, PAGE_SIZE, 2, NSA_KV, HEAD_DIM)),
        'cache_win_kv': nrm((DEC_BATCH, N_EVEN, wb, 2, NSA_KV, HEAD_DIM)),
        'state_rwkv_wkv': nrm((DEC_BATCH, N_EVEN, RWKV_HEADS, HEAD_DIM, HEAD_DIM), 0.3),
        'state_rwkv_shift': nrm((DEC_BATCH, N_EVEN, RWKV_PROJ)),
        'state_conv': nrm((DEC_BATCH, N_ODD, CONV_K - 1, CONV_WIDTH)),
        'state_ffn_conv': nrm((DEC_BATCH, DEPTH, FFN_CONV_K - 1, D_FF)),
        'page_table': jax.random.permutation(nk(), n_pool)[:used].reshape(DEC_BATCH, n_pages).astype(jnp.int32),
        'norm_mix': gain((DEPTH, d)),
        'norm_ffn': gain((DEPTH, d)),
        'rel_bias': nrm((NUM_BUCKETS, NSA_HEADS), 0.5),
        'w_in_even': nrm((N_EVEN, d, EVEN_PROJ), d ** -0.5),
        'w_out_even': nrm((N_EVEN, MIX_WIDTH, d), MIX_WIDTH ** -0.5),
        'q_norm': gain((N_EVEN, HEAD_DIM)),
        'k_norm': gain((N_EVEN, 3, HEAD_DIM)),
        'phi_pe': nrm((N_EVEN, 2, CMP_LEN, HEAD_DIM), 0.5),
        'phi_w1': nrm((N_EVEN, 2, CMP_LEN, HEAD_DIM, CMP_HIDDEN), (CMP_LEN * HEAD_DIM) ** -0.5),
        'phi_w2': nrm((N_EVEN, 2, CMP_HIDDEN, HEAD_DIM), CMP_HIDDEN ** -0.5),
        'rwkv_mu': unif((N_EVEN, RWKV_PROJ), 0.0, 1.0),
        'rwkv_w0': unif((N_EVEN, RWKV_WIDTH), -5.0, -0.5),
        'rwkv_w2': nrm((N_EVEN, DECAY_LORA, RWKV_WIDTH), 0.1 * DECAY_LORA ** -0.5),
        'rwkv_a0': nrm((N_EVEN, RWKV_WIDTH), 0.1),
        'rwkv_a2': nrm((N_EVEN, AAA_LORA, RWKV_WIDTH), AAA_LORA ** -0.5),
        'rwkv_g2': nrm((N_EVEN, GATE_LORA, RWKV_WIDTH), GATE_LORA ** -0.5),
        'rwkv_kk': gain((N_EVEN, RWKV_WIDTH), 0.85),
        'rwkv_ka': gain((N_EVEN, RWKV_WIDTH)),
        'rwkv_rk': nrm((N_EVEN, RWKV_HEADS, HEAD_DIM), 0.1),
        'rwkv_ln_w': gain((N_EVEN, RWKV_WIDTH)),
        'rwkv_ln_b': nrm((N_EVEN, RWKV_WIDTH), 0.02),
        'w_in_odd': nrm((N_ODD, d, 3 * CONV_WIDTH), d ** -0.5),
        'conv_w': nrm((N_ODD, CONV_K, CONV_WIDTH), CONV_K ** -0.5),
        'w_out_odd': nrm((N_ODD, CONV_WIDTH, d), CONV_WIDTH ** -0.5),
        'ffn_up': nrm((DEPTH, d, 2 * D_FF), d ** -0.5),
        'ffn_conv': nrm((DEPTH, FFN_CONV_K, D_FF), FFN_CONV_K ** -0.5),
        'ffn_down': nrm((DEPTH, D_FF, d), D_FF ** -0.5),
    }


def reference(x_prompt, x_sample, cache_cmp_kv, cache_slc_kv, cache_win_kv, state_rwkv_wkv,
              state_rwkv_shift, state_conv, state_ffn_conv, page_table, norm_mix, norm_ffn,
              rel_bias, w_in_even, w_out_even, q_norm, k_norm, phi_pe, phi_w1, phi_w2,
              rwkv_mu, rwkv_w0, rwkv_w2, rwkv_a0, rwkv_a2, rwkv_g2, rwkv_kk, rwkv_ka, rwkv_rk,
              rwkv_ln_w, rwkv_ln_b, w_in_odd, conv_w, w_out_odd, ffn_up, ffn_conv, ffn_down):
    P = dict(norm_mix=norm_mix, norm_ffn=norm_ffn, rel_bias=rel_bias, w_in_even=w_in_even,
             w_out_even=w_out_even, q_norm=q_norm, k_norm=k_norm, phi_pe=phi_pe, phi_w1=phi_w1,
             phi_w2=phi_w2, rwkv_mu=rwkv_mu, rwkv_w0=rwkv_w0, rwkv_w2=rwkv_w2, rwkv_a0=rwkv_a0,
             rwkv_a2=rwkv_a2, rwkv_g2=rwkv_g2, rwkv_kk=rwkv_kk, rwkv_ka=rwkv_ka, rwkv_rk=rwkv_rk,
             rwkv_ln_w=rwkv_ln_w, rwkv_ln_b=rwkv_ln_b, w_in_odd=w_in_odd, conv_w=conv_w,
             w_out_odd=w_out_odd, ffn_up=ffn_up, ffn_conv=ffn_conv, ffn_down=ffn_down)
    st = dict(cmp=cache_cmp_kv, slc=cache_slc_kv, win=cache_win_kv, wkv=state_rwkv_wkv,
              shift=state_rwkv_shift, conv=state_conv, ffn=state_ffn_conv, page_table=page_table)
    y_prompt, (cmp_p, slc_p, win_p, wkv_p, sh_p, conv_p, ffn_p) = trunk(x_prompt, P, None)
    y_sample, (cmp_s, slc_s, win_s, wkv_s, sh_s, conv_s, ffn_s) = trunk(x_sample, P, st)
    return (y_prompt, y_sample, cmp_p, cmp_s, slc_p, slc_s, win_p, win_s, wkv_p, wkv_s,
            sh_p, sh_s, conv_p, conv_s, ffn_p, ffn_s)
```

```cpp
#include <hip/hip_runtime.h>
#include <cstdio>
#include <cstdint>
namespace pg8 {
#define PG8_LAS __attribute__((address_space(3)))
typedef unsigned short bf16_t;
typedef short bf16x8 __attribute__((ext_vector_type(8)));
typedef float f32x4 __attribute__((ext_vector_type(4)));
typedef unsigned u32x4 __attribute__((ext_vector_type(4)));
constexpr int BM = 256, BK = 64, HALF = 128, HTB = HALF * BK * 2  , STAGE_BYTES = 8 * HTB, NXCD = 8, WGM = 8;

__host__ __device__ __forceinline__ int lds_byte(int r, int c) { const int st = (r >> 4) * 2 + (c >> 5), rr = r & 15, cc = c & 31, ob = rr * 64 + cc * 2; return st * 1024 + (ob ^ (((ob >> 9) & 1) << 5)); }
__host__ __device__ __forceinline__ void stage_rc(int b, int& R, int& C) { const int st = b / 1024, sb = b % 1024, swz = sb ^ (((sb >> 9) & 1) << 5); R = (st >> 1) * 16 + swz / 64; C = (st & 1) * 32 + (swz % 64) / 2; }
__host__ __device__ __forceinline__ int perm32(int rho) { const int n = rho >> 4, i = rho & 15; return 8 * (i >> 2) + 4 * n + (i & 3); }

struct Unit { int pm, pn; };
struct Gemm { const bf16_t* A; const bf16_t* Bt; int M, N, K; };

struct StaticOrder {
    int nM, nN, nwg, G, c;
    __host__ __device__ void init(int M, int N, int G_, int c_) { nM = M / BM; nN = N / BM; nwg = nM * nN; G = G_; c = c_; }
    __host__ __device__ bool next(int i, Unit& u) const {
        const long L = (long)i * G + c; if (L >= nwg) return false;
        int wgid = (int)L; { const int q = nwg / NXCD, r = nwg % NXCD, xcd = wgid % NXCD, off = wgid / NXCD; wgid = (xcd < r ? xcd * (q + 1) : r * (q + 1) + (xcd - r) * q) + off; }
        const int nig = WGM * nN, gid = wgid / nig, fm = gid * WGM, gsz = (nM - fm) < WGM ? (nM - fm) : WGM;
        u.pm = fm + ((wgid % nig) % gsz); u.pn = (wgid % nig) / gsz; return true;
    }
    __device__ __forceinline__ void a_ready(const Unit&) const {}
    __device__ __forceinline__ void done(const Unit&) const {}
};

__device__ __forceinline__ unsigned cvt_pk_bf16(float lo, float hi) { unsigned r; asm volatile("v_cvt_pk_bf16_f32 %0, %1, %2" : "=v"(r) : "v"(lo), "v"(hi)); return r; }
template <class Epi, class Sched, bool ALIGN_EPI = false, bool SP2 = false>
__device__ __forceinline__ void gemm_phase(PG8_LAS unsigned char* lds, const Gemm g, const Sched& S, const Epi& E) {
    int tid_ = threadIdx.x; asm volatile("" : "+v"(tid_));
    const int tid = tid_, wid = __builtin_amdgcn_readfirstlane(tid >> 6), lane = tid & 63, wr = wid >> 2, wc = wid & 3, fr = lane & 15, fq = lane >> 4;
    const int K = g.K, nt = K / BK;
    unsigned voffA[2], voffB[2];
#pragma unroll
    for (int i = 0; i < 2; ++i) { int R, C; stage_rc(tid * 16 + i * 8192, R, C); const int Rb = Epi::PERM ? ((R & ~31) + perm32(R & 31)) : R;
        voffA[i] = (unsigned)(R * K + C) * 2u; voffB[i] = (unsigned)(Rb * K + C) * 2u; }
    const size_t kstep = (size_t)(BK * 2);
    const size_t hstep = (size_t)HALF * K * 2;
    const size_t tstep = 2 * hstep;
    const unsigned ldsw = (unsigned)wid * 1024u;
    const int aoff = lds_byte(wr * 64 + fr, fq * 8), boff = lds_byte(wc * 32 + fr, fq * 8);
#define PG8_SA(b, h) (((b) * 2 + (h)) * HTB)
#define PG8_SB(b, h) ((4 + (b) * 2 + (h)) * HTB)
#define PG8_STAGE(bufoff, gbase, voff) do { _Pragma("unroll") for (int _i = 0; _i < 2; ++_i) \
        __builtin_amdgcn_global_load_lds((const unsigned*)((const char*)(gbase) + (voff)[_i]), (PG8_LAS unsigned*)(lds + (bufoff) + ldsw + _i * 8192), 16, 0, 0); } while (0)
#define PG8_LDA(dst, b, h) do { _Pragma("unroll") for (int m = 0; m < 4; ++m) _Pragma("unroll") for (int k = 0; k < 2; ++k) dst[m][k] = *(const PG8_LAS bf16x8*)(lds + PG8_SA(b, h) + aoff + m * 2048 + k * 1024); } while (0)
#define PG8_LDB(dst, b, h) do { _Pragma("unroll") for (int n = 0; n < 2; ++n) _Pragma("unroll") for (int k = 0; k < 2; ++k) dst[n][k] = *(const PG8_LAS bf16x8*)(lds + PG8_SB(b, h) + boff + n * 2048 + k * 1024); } while (0)
#define PG8_MMA(ai, bj, At, Bt) do { __builtin_amdgcn_s_setprio(1); _Pragma("unroll") for (int m = 0; m < 4; ++m) _Pragma("unroll") for (int n = 0; n < 2; ++n) _Pragma("unroll") for (int k = 0; k < 2; ++k) \
        acc[ai][bj][m][n] = __builtin_amdgcn_mfma_f32_16x16x32_bf16(Bt[n][k], At[m][k], acc[ai][bj][m][n], 0, 0, 0); __builtin_amdgcn_s_setprio(0); } while (0)
#define PG8_WAIT_V(n) asm volatile("s_waitcnt vmcnt(" #n ")" ::: "memory")
#define PG8_WAIT_L(n) asm volatile("s_waitcnt lgkmcnt(" #n ")" ::: "memory")
#define PG8_BAR __builtin_amdgcn_s_barrier()
#define PG8_SCHED __builtin_amdgcn_sched_barrier(0)
    Unit cur, nxt; int ui = 0;
    if (!S.next(0, cur)) return;
    f32x4 acc[2][2][4][2];
#pragma unroll
    for (int a = 0; a < 2; ++a)
#pragma unroll
        for (int b = 0; b < 2; ++b)
#pragma unroll
            for (int m = 0; m < 4; ++m)
#pragma unroll
                for (int n = 0; n < 2; ++n) acc[a][b][m][n] = (f32x4){0.f, 0.f, 0.f, 0.f};
    bf16x8 At[4][2], B0[2][2], B1[2][2];
    const char* cA = (const char*)g.A + (size_t)cur.pm * tstep; const char* cB = (const char*)g.Bt + (size_t)cur.pn * tstep;
    S.a_ready(cur);
    if constexpr (SP2) {
        PG8_STAGE(PG8_SB(0, 0), cB, voffB); PG8_STAGE(PG8_SB(0, 1), cB + hstep, voffB); PG8_STAGE(PG8_SA(0, 0), cA, voffA); PG8_STAGE(PG8_SA(0, 1), cA + hstep, voffA);
        if (wr == 1) PG8_BAR;
        PG8_WAIT_V(2); PG8_BAR;
        PG8_STAGE(PG8_SB(1, 0), cB + kstep, voffB); PG8_STAGE(PG8_SA(1, 0), cA + kstep, voffA); PG8_STAGE(PG8_SB(1, 1), cB + hstep + kstep, voffB);
        PG8_WAIT_V(6); PG8_BAR;
    } else {
        PG8_STAGE(PG8_SB(0, 0), cB, voffB); PG8_STAGE(PG8_SA(0, 0), cA, voffA); PG8_STAGE(PG8_SB(0, 1), cB + hstep, voffB); PG8_STAGE(PG8_SA(0, 1), cA + hstep, voffA);
        if (wr == 1) PG8_BAR;
        PG8_WAIT_V(4); PG8_BAR;
        PG8_STAGE(PG8_SB(1, 0), cB + kstep, voffB); PG8_STAGE(PG8_SA(1, 0), cA + kstep, voffA); PG8_STAGE(PG8_SB(1, 1), cB + hstep + kstep, voffB);
        PG8_WAIT_V(6); PG8_BAR;
    }
    for (;;) {
        const bool has_next = S.next(ui + 1, nxt);
        const char* nA = has_next ? (const char*)g.A + (size_t)nxt.pm * tstep : cA; const char* nB = has_next ? (const char*)g.Bt + (size_t)nxt.pn * tstep : cB;
        for (int t = 0; t < nt; t += 2) {
            const bool last = (t == nt - 2);
            const char* a1 = cA + (size_t)(t + 1) * kstep;
            const char* a2 = last ? nA : cA + (size_t)(t + 2) * kstep; const char* b2 = last ? nB : cB + (size_t)(t + 2) * kstep;
            const char* a3 = a2 + kstep; const char* b3 = b2 + kstep;
            if (last && has_next) S.a_ready(nxt);
            if constexpr (SP2) {
            PG8_LDB(B0, 0, 0); PG8_LDB(B1, 0, 1); PG8_SCHED; PG8_LDA(At, 0, 0); PG8_STAGE(PG8_SA(1, 1), a1 + hstep, voffA);
            PG8_WAIT_V(8); PG8_WAIT_L(0); PG8_BAR; PG8_MMA(0, 0, At, B0); PG8_MMA(0, 1, At, B1); PG8_BAR; PG8_SCHED;
            PG8_LDA(At, 0, 1); PG8_STAGE(PG8_SB(0, 0), b2, voffB); PG8_STAGE(PG8_SB(0, 1), b2 + hstep, voffB); PG8_STAGE(PG8_SA(0, 0), a2, voffA);
            PG8_WAIT_V(8); PG8_WAIT_L(0); PG8_BAR; PG8_MMA(1, 0, At, B0); PG8_MMA(1, 1, At, B1); PG8_BAR; PG8_SCHED;
            PG8_LDB(B0, 1, 0); PG8_LDB(B1, 1, 1); PG8_SCHED; PG8_LDA(At, 1, 0); PG8_STAGE(PG8_SA(0, 1), a2 + hstep, voffA);
            PG8_WAIT_V(8); PG8_WAIT_L(0); PG8_BAR; PG8_MMA(0, 0, At, B0); PG8_MMA(0, 1, At, B1); PG8_BAR; PG8_SCHED;
            PG8_LDA(At, 1, 1); PG8_STAGE(PG8_SB(1, 0), b3, voffB); PG8_STAGE(PG8_SB(1, 1), b3 + hstep, voffB); PG8_STAGE(PG8_SA(1, 0), a3, voffA);
            PG8_WAIT_V(8); PG8_WAIT_L(0); PG8_BAR; PG8_MMA(1, 0, At, B0); PG8_MMA(1, 1, At, B1); PG8_BAR; PG8_SCHED;
            } else {
            PG8_LDB(B0, 0, 0); PG8_SCHED; PG8_LDA(At, 0, 0); PG8_STAGE(PG8_SA(1, 1), a1 + hstep, voffA);
            PG8_WAIT_L(8); PG8_BAR; PG8_WAIT_L(0); PG8_MMA(0, 0, At, B0); PG8_BAR; PG8_SCHED;
            PG8_LDB(B1, 0, 1); PG8_STAGE(PG8_SB(0, 0), b2, voffB);
            PG8_BAR; PG8_WAIT_L(0); PG8_MMA(0, 1, At, B1); PG8_BAR;
            PG8_LDA(At, 0, 1); PG8_STAGE(PG8_SA(0, 0), a2, voffA);
            PG8_BAR; PG8_WAIT_L(0); PG8_MMA(1, 0, At, B0); PG8_BAR; PG8_SCHED;
            PG8_STAGE(PG8_SB(0, 1), b2 + hstep, voffB);
            PG8_WAIT_V(6); PG8_BAR; PG8_MMA(1, 1, At, B1); PG8_BAR;
            PG8_LDB(B0, 1, 0); PG8_SCHED; PG8_LDA(At, 1, 0); PG8_STAGE(PG8_SA(0, 1), a2 + hstep, voffA);
            PG8_WAIT_L(8); PG8_BAR; PG8_WAIT_L(0); PG8_MMA(0, 0, At, B0); PG8_BAR; PG8_SCHED;
            PG8_LDB(B1, 1, 1); PG8_STAGE(PG8_SB(1, 0), b3, voffB);
            PG8_BAR; PG8_WAIT_L(0); PG8_MMA(0, 1, At, B1); PG8_BAR;
            PG8_LDA(At, 1, 1); PG8_STAGE(PG8_SA(1, 0), a3, voffA);
            PG8_BAR; PG8_WAIT_L(0); PG8_MMA(1, 0, At, B0); PG8_BAR; PG8_SCHED;
            PG8_STAGE(PG8_SB(1, 1), b3 + hstep, voffB);
            PG8_WAIT_V(6); PG8_BAR; PG8_MMA(1, 1, At, B1); PG8_BAR;
            }
        }
        if constexpr (ALIGN_EPI) { if (wr == 0) PG8_BAR; }
        if constexpr (!Epi::AFTER_DRAIN) { E(acc, cur, wr, wc, fr, fq); S.done(cur); }
        if (!has_next) break;
#pragma unroll
        for (int a = 0; a < 2; ++a)
#pragma unroll
            for (int b = 0; b < 2; ++b)
#pragma unroll
                for (int m = 0; m < 4; ++m)
#pragma unroll
                    for (int n = 0; n < 2; ++n) acc[a][b][m][n] = (f32x4){0.f, 0.f, 0.f, 0.f};
        cur = nxt; cA = nA; cB = nB; ++ui;
        if constexpr (ALIGN_EPI) { if (wr == 1) PG8_BAR; }
    }
    PG8_WAIT_V(0);
    if constexpr (!ALIGN_EPI) { if (wr == 0) PG8_BAR; }
    PG8_BAR;
    if constexpr (Epi::AFTER_DRAIN) { E.fused(acc, cur, wr, wc, fr, fq, lds, wid, lane); S.done(cur); }
#undef PG8_SA
#undef PG8_SB
#undef PG8_STAGE
#undef PG8_LDA
#undef PG8_LDB
#undef PG8_MMA
#undef PG8_WAIT_V
#undef PG8_WAIT_L
#undef PG8_BAR
#undef PG8_SCHED
}
}

constexpr int DM = 1024, NB = 8, SEQ = 2048, DEPTH = 4, DB = 128, DT = 8, PAST = 2048, PAGE = 128, NPAGE = 16, NPOOL = 2560;
constexpr int HD = 64, NCMP = 127, WIN = 512;
constexpr int MP = NB * SEQ, MS = DB * DT, MT = MP + MS;
constexpr int NE_ORIG = 3096, NE = 3328, RWP = 1792, NO = 3072, DFF = 2816, NUP = 2 * DFF;
constexpr int NLORA = 1536, KLORA = 256;
constexpr float RMS_EPS = 1e-6f, GN_EPS = 64e-5f, LOG2E = 1.4426950408889634f;
constexpr int NWAVES = 8, NTHREADS = 512;

enum { I_XP = 0, I_XS, I_CCMP, I_CSLC, I_CWIN, I_SWKV, I_SSHIFT, I_SCONV, I_SFFN, I_PT, I_NMIX, I_NFFN, I_RELB, I_WINE, I_WOUTE, I_QN, I_KN,
       I_PPE, I_PW1, I_PW2, I_MU, I_W0, I_W2, I_A0, I_A2, I_G2, I_KKW, I_KA, I_RK, I_LNW, I_LNB, I_WINO, I_CONVW, I_WOUTO, I_FUP, I_FCONV, I_FDOWN, N_IN };

constexpr size_t O_YP = 0, O_YS = O_YP + (size_t)MP * DM, O_CMPP = O_YS + (size_t)MS * DM, O_CMPS = O_CMPP + (size_t)NB * 2 * SEQ * 256,
    O_SLCP = O_CMPS + (size_t)DB * 2 * DT * 256, O_SLCS = O_SLCP + (size_t)NB * 2 * SEQ * 256, O_WINP = O_SLCS + (size_t)DB * 2 * DT * 256,
    O_WINS = O_WINP + (size_t)NB * 2 * WIN * 256, O_WKVP = O_WINS + (size_t)DB * 2 * WIN * 256, O_WKVS = O_WKVP + (size_t)NB * 2 * 8 * 4096,
    O_SHP = O_WKVS + (size_t)DB * 2 * 8 * 4096, O_SHS = O_SHP + (size_t)NB * 2 * RWP, O_CVP = O_SHS + (size_t)DB * 2 * RWP, O_CVS = O_CVP + (size_t)NB * 2 * 2 * DM,
    O_FFP = O_CVS + (size_t)DB * 2 * 2 * DM, O_FFS = O_FFP + (size_t)NB * 4 * 2 * DFF, O_END = O_FFS + (size_t)DB * 4 * 2 * DFF;

constexpr size_t al256(size_t x) { return (x + 255) & ~(size_t)255; }
constexpr size_t WS_CTL = 0, CTL_ZERO_BYTES = 1u << 20;
constexpr size_t WS_WIE = CTL_ZERO_BYTES;
constexpr size_t WS_WOE = WS_WIE + (size_t)2 * NE * DM * 2;
constexpr size_t WS_WIO = WS_WOE + (size_t)2 * DM * DM * 2;
constexpr size_t WS_WOO = WS_WIO + (size_t)2 * NO * DM * 2;
constexpr size_t WS_WUP = WS_WOO + (size_t)2 * DM * DM * 2;
constexpr size_t WS_WDN = WS_WUP + (size_t)4 * NUP * DM * 2;
constexpr size_t WS_PHI1 = WS_WDN + (size_t)4 * DM * DFF * 2;
constexpr size_t WS_LORA = WS_PHI1 + (size_t)2 * 512 * 1024 * 2;
constexpr size_t WS_PEC = WS_LORA + (size_t)2 * NLORA * KLORA * 2;
constexpr size_t WS_XN = al256(WS_PEC + 4 * 128 * 4);
constexpr size_t WS_ZB = WS_XN + (size_t)MT * DM * 2;
constexpr size_t WS_QB = WS_ZB + (size_t)MT * NUP * 2;
constexpr size_t WS_CSEG = WS_QB + (size_t)MT * 512 * 2;
constexpr int CS_SK = 0, CS_SV = 32768, CS_PK = 65536, CS_PV = 67584, CS_ROWS = 69632;
constexpr size_t WS_PART = WS_CSEG + (size_t)CS_ROWS * 1024 * 2;
constexpr size_t WS_KC = WS_PART + (size_t)CS_ROWS * 256 * 4;
constexpr size_t WS_VCT = WS_KC + (size_t)272 * 128 * 64 * 2;
constexpr size_t WS_KS = WS_VCT + (size_t)272 * 128 * 64 * 2;
constexpr size_t WS_KW = WS_KS + (size_t)NB * 2 * SEQ * 64 * 2;
constexpr size_t WS_VST = WS_KW + (size_t)NB * 2 * SEQ * 64 * 2;
constexpr size_t WS_VWT = WS_VST + (size_t)NB * 2 * SEQ * 64 * 2;
constexpr size_t WS_GATE = WS_VWT + (size_t)NB * 2 * SEQ * 64 * 2;
constexpr size_t WS_SC = WS_GATE + (size_t)MT * 32 * 4;
constexpr size_t WS_G = WS_SC + (size_t)MT * 8 * 6 * 64 * 4;
constexpr size_t WS_LA = WS_G + (size_t)MT * 512 * 4;
constexpr size_t WS_MIX = WS_LA + (size_t)MT * 256 * 2;
constexpr size_t WS_H = WS_MIX + (size_t)MT * DM * 2;
constexpr size_t WS_END = WS_H + (size_t)MT * DFF * 2;

constexpr int CW_TMO = 0, CW_CODE = 1;
constexpr int CW_QUEUE = 64;
constexpr int CW_BAR = 4096;

constexpr int RING_OFF = 0, RING_BYTES = 131072;
constexpr int LDSCTL_OFF = RING_BYTES, MISC_OFF = LDSCTL_OFF + 320;
constexpr int LDS_BYTES = 147456;

#define GAS __attribute__((address_space(1)))
#define LAS __attribute__((address_space(3)))
typedef unsigned short bf16;
typedef unsigned v4u __attribute__((ext_vector_type(4)));
typedef unsigned v2u __attribute__((ext_vector_type(2)));
typedef float f32x4 __attribute__((ext_vector_type(4)));
typedef float f32x2 __attribute__((ext_vector_type(2)));
typedef float f32x16 __attribute__((ext_vector_type(16)));
typedef short bf16x8 __attribute__((ext_vector_type(8)));
typedef GAS unsigned gu32;
#define RLX_AGENT __ATOMIC_RELAXED, __HIP_MEMORY_SCOPE_AGENT
#define LDS_WAIT() asm volatile("s_waitcnt lgkmcnt(0)" ::: "memory")
#define VM_WAIT() asm volatile("s_waitcnt vmcnt(0)" ::: "memory")
#define DI __device__ __forceinline__
#define MFMA32(a, b, c) __builtin_amdgcn_mfma_f32_32x32x16_bf16((a), (b), (c), 0, 0, 0)

DI float bf2f(unsigned b) { return __builtin_bit_cast(float, b << 16); }
DI float bflo(unsigned w) { return __builtin_bit_cast(float, w << 16); }
DI float bfhi(unsigned w) { return __builtin_bit_cast(float, w & 0xffff0000u); }
DI unsigned pk2(float lo, float hi) {
    typedef __bf16 bf2v __attribute__((ext_vector_type(2)));
    f32x2 v = {lo, hi}; bf2v r = __builtin_convertvector(v, bf2v); return __builtin_bit_cast(unsigned, r);
}
DI float rbf(float x) { return bflo(pk2(x, 0.f) & 0xffffu); }
DI float fexp2(float x) { return __builtin_amdgcn_exp2f(x); }
DI float fexp(float x) { return __builtin_amdgcn_exp2f(x * LOG2E); }
DI float frcp(float x) { return __builtin_amdgcn_rcpf(x); }
DI float sigmoidf_(float x) { return 1.0f / (1.0f + __expf(-x)); }
DI float tanhf_(float x) { const float e = __expf(2.0f * x); return 1.0f - 2.0f / (e + 1.0f); }
template <int CTRL> DI float dppf(float x) { return __builtin_bit_cast(float, __builtin_amdgcn_mov_dpp(__builtin_bit_cast(int, x), CTRL, 0xf, 0xf, true)); }
template <int CTRL> DI unsigned dppu(unsigned x) { return (unsigned)__builtin_amdgcn_mov_dpp((int)x, CTRL, 0xf, 0xf, true); }
constexpr int XOR1 = 0xB1, XOR2 = 0x4E, HMIR = 0x141, ROR8 = 0x128;
DI float sum4(float v) { v += dppf<XOR1>(v); v += dppf<XOR2>(v); return v; }
DI float sum8(float v) { v = sum4(v); v += dppf<HMIR>(v); return v; }
DI float sum16(float v) { v = sum8(v); v += dppf<ROR8>(v); return v; }
DI float wave_sum(float v) {
#pragma unroll
    for (int o = 1; o < 64; o <<= 1) v += __shfl_xor(v, o);
    return v;
}
DI int crow(int i, int h) { return (i & 3) + 8 * (i >> 2) + 4 * h; }

#define XB_TMO      128
#define XB_XCNT(j)  (256  + 64 * (j))
#define XB_XSUB(j)  (1280 + 64 * (j))
#define XB_XGEN(j)  (2304 + 64 * (j))
#define XB_TOP      3328
#define XB_TOPGEN   3392
#define XCD_BAR_WORDS 3456
#define XB_SPIN_CAP (1u << 18)

__device__ __forceinline__ unsigned xb_ld(unsigned* p)              { return __hip_atomic_load(p, __ATOMIC_RELAXED, __HIP_MEMORY_SCOPE_AGENT); }
__device__ __forceinline__ unsigned xb_add(unsigned* p, unsigned v) { return __hip_atomic_fetch_add(p, v, __ATOMIC_RELAXED, __HIP_MEMORY_SCOPE_AGENT); }
__device__ __forceinline__ unsigned xb_xcc_id() { return (unsigned)__builtin_amdgcn_s_getreg((3 << 11) | 20) & 0xFu; }
#define XB_SPIN(cond, bar) do { unsigned _sp = 0; while (cond) { __builtin_amdgcn_s_sleep(1); \
    if ((++_sp & 255u) == 0u) { if (xb_ld(&(bar)[XB_TMO])) break; if (_sp > XB_SPIN_CAP) { atomicAdd(&(bar)[XB_TMO], 1u); break; } } } } while (0)

struct XcdBarrier { unsigned* bar; unsigned x; volatile LAS unsigned* st; };

__device__ __forceinline__ XcdBarrier xcd_barrier_post(unsigned* bar, volatile LAS unsigned* st) {
    XcdBarrier b; b.bar = bar; b.x = xb_xcc_id(); b.st = st;
    if (threadIdx.x == 0) (void)xb_add(&bar[XB_XCNT(b.x)], 1u);
    return b;
}
__device__ __forceinline__ void xcd_barrier_complete(unsigned* bar, unsigned x, unsigned& nloc, unsigned& nx) {
    const unsigned G = gridDim.x * gridDim.y * gridDim.z;
    unsigned sum, cnt, mine, sp = 0u;
    for (;;) {
        sum = 0u; cnt = 0u; mine = 0u;
#pragma unroll
        for (unsigned j = 0; j < 16; ++j) { const unsigned c = xb_ld(&bar[XB_XCNT(j)]); sum += c; cnt += (c > 0u) ? 1u : 0u; mine = (j == x) ? c : mine; }
        if (sum == G) break;
        __builtin_amdgcn_s_sleep(1);
        if ((++sp & 255u) == 0u) { if (xb_ld(&bar[XB_TMO])) break; if (sp > XB_SPIN_CAP) { atomicAdd(&bar[XB_TMO], 1u); break; } }
    }
    nloc = mine > 0u ? mine : 1u; nx = cnt > 0u ? cnt : 1u;
}
__device__ __forceinline__ void xcd_barrier(const XcdBarrier& b) {
    asm volatile("s_waitcnt vmcnt(0)" ::: "memory");
    __syncthreads();
    if (threadIdx.x == 0) {
        unsigned* bar = b.bar;
        __builtin_amdgcn_s_waitcnt(0);
        unsigned nloc = b.st[0], nx = b.st[1];
        if (nloc == 0u) { xcd_barrier_complete(bar, b.x, nloc, nx); b.st[0] = nloc; b.st[1] = nx; }
        const unsigned old = xb_add(&bar[XB_XSUB(b.x)], 1u);
        const unsigned gen = old / nloc;
        if (old + 1u == (gen + 1u) * nloc) {
            __builtin_amdgcn_fence(__ATOMIC_RELEASE, "agent");
            asm volatile("s_waitcnt vmcnt(0)" ::: "memory");
            const unsigned og = xb_add(&bar[XB_TOP], 1u);
            const unsigned tg = og / nx;
            if (og + 1u == (tg + 1u) * nx) xb_add(&bar[XB_TOPGEN], 1u);
            else XB_SPIN(xb_ld(&bar[XB_TOPGEN]) == tg, bar);
            __builtin_amdgcn_fence(__ATOMIC_ACQUIRE, "agent");
            xb_add(&bar[XB_XGEN(b.x)], 1u);
            asm volatile("s_waitcnt vmcnt(0)" ::: "memory");
        } else {
            XB_SPIN(xb_ld(&bar[XB_XGEN(b.x)]) == gen, bar);
            __builtin_amdgcn_fence(__ATOMIC_ACQUIRE, "agent");
            asm volatile("s_waitcnt vmcnt(0)" ::: "memory");
        }
    }
    __syncthreads();
}

struct Frame {
    LAS unsigned char* lds;
    volatile LAS unsigned* MISC;
    gu32* ctl;
    int tid, lane, wave, G, bid;
    GAS float* out;
    GAS unsigned char* ws;
    unsigned long long ka;
};
#define LAUNDER(F) do { asm volatile("" : "+s"((F).ws)); asm volatile("" : "+s"((F).out)); asm volatile("" : "+s"((F).ka)); asm volatile("" : "+s"((F).bid)); asm volatile("" : "+s"((F).G)); asm volatile("" : "+v"((F).tid)); (F).lane = (F).tid & 63; (F).wave = __builtin_amdgcn_readfirstlane((F).tid >> 6); } while (0)
#define WSP(T, off) ((T*)(F.ws + (off)))
#define OUTF ((float*)F.out)
struct Args { const float* in[N_IN]; float* out; unsigned char* ws; int ph_lo, ph_hi; };
struct KArgs { const GAS float* in[N_IN]; GAS float* out; GAS unsigned char* ws; int ph_lo, ph_hi; };
#define KIN(i) ((const float*)(((const __attribute__((address_space(4))) KArgs*)(F.ka))->in[i]))

template <class SRC> DI void tr_item(const SRC& src, int K, int N, bf16* WT, LAS float* scr, int item, int lane) {
    const int nblk = N / 32, kb = item / nblk, nb = item % nblk, k0 = 64 * kb, n0 = 32 * nb;
#pragma unroll 8
    for (int i = 0; i < 32; ++i) { const int kk = 2 * i + (lane >> 5); scr[kk * 33 + (lane & 31)] = src(k0 + kk, n0 + (lane & 31)); }
    LDS_WAIT(); asm volatile("" ::: "memory");
    const int c = lane & 7;
#pragma unroll
    for (int j = 0; j < 4; ++j) { const int n = (lane >> 3) + 8 * j; const LAS float* s = scr + (8 * c) * 33 + n;
        v4u o; o.x = pk2(s[0 * 33], s[1 * 33]); o.y = pk2(s[2 * 33], s[3 * 33]); o.z = pk2(s[4 * 33], s[5 * 33]); o.w = pk2(s[6 * 33], s[7 * 33]);
        *(v4u*)(WT + (size_t)(n0 + n) * K + k0 + 8 * c) = o; }
    LDS_WAIT(); asm volatile("" ::: "memory");
}
struct SrcPlain { const float* W; int N; DI float operator()(int k, int n) const { return W[(size_t)k * N + n]; } };
struct SrcWie { const float* W; DI float operator()(int k, int n) const {
    int c; if (n < 1280) c = n; else if (n < 3072) c = n + 24; else if (n < 3096) c = n - 3072 + 1280; else c = -1;
    return c < 0 ? 0.f : W[(size_t)k * NE_ORIG + c]; } };
struct SrcPhi { const float* W; DI float operator()(int k, int n) const {
    const int kv = n >> 8, r = (n >> 7) & 1, e = n & 127; return W[(size_t)kv * 262144 + (size_t)r * 131072 + (size_t)k * 128 + e]; } };
struct SrcLora { const float *w2, *a2, *g2; DI float operator()(int k, int n) const {
    const int seg = n >> 9, c = n & 511;
    if (seg == 0) return k < 64 ? w2[k * 512 + c] : 0.f;
    if (seg == 1) return (k >= 64 && k < 128) ? a2[(k - 64) * 512 + c] : 0.f;
    return k >= 128 ? g2[(k - 128) * 512 + c] : 0.f; } };

DI void rms_row_to_bf16(const float* xrow, const float* gain, bf16* orow, int lane) {
    const f32x4* xr = (const f32x4*)xrow + lane; const f32x4* gr = (const f32x4*)gain + lane;
    f32x4 v[4]; float s = 0.f;
#pragma unroll
    for (int j = 0; j < 4; ++j) { v[j] = xr[64 * j]; s += (v[j].x * v[j].x + v[j].y * v[j].y) + (v[j].z * v[j].z + v[j].w * v[j].w); }
    const float rinv = 1.0f / sqrtf(wave_sum(s) * (1.f / DM) + RMS_EPS);
    v2u* o8 = (v2u*)orow + lane;
#pragma unroll
    for (int j = 0; j < 4; ++j) { const f32x4 g = gr[64 * j]; v2u o; o.x = pk2(v[j].x * rinv * g.x, v[j].y * rinv * g.y); o.y = pk2(v[j].z * rinv * g.z, v[j].w * rinv * g.w); o8[64 * j] = o; }
}
DI const float* xin_row(Frame& F, int row) { return row < MP ? KIN(I_XP) + (size_t)row * DM : KIN(I_XS) + (size_t)(row - MP) * DM; }

DI void p0_prologue(Frame& F) {
    LAS float* scr = (LAS float*)(F.lds + RING_OFF + F.wave * 16384);
    const int gw = F.bid * NWAVES + F.wave, NGW = F.G * NWAVES, lane = F.lane;
    constexpr int I_WIE = 16 * (NE / 32), I_SQ = 16 * 32, I_WIO = 16 * (NO / 32), I_UP = 16 * (NUP / 32), I_DN = (DFF / 64) * 32, I_PHI = 16 * 16, I_LORA = 4 * (NLORA / 32);
    constexpr int NITEMS = 2 * I_WIE + 2 * I_SQ + 2 * I_WIO + 2 * I_SQ + 4 * I_UP + 4 * I_DN + 2 * I_PHI + 2 * I_LORA;
    for (int it = gw; it < NITEMS; it += NGW) {
        int r = it;
        if (r < 2 * I_WIE) { const int li = r / I_WIE; SrcWie s{KIN(I_WINE) + (size_t)li * DM * NE_ORIG}; tr_item(s, DM, NE, WSP(bf16, WS_WIE) + (size_t)li * NE * DM, scr, r % I_WIE, lane); continue; } r -= 2 * I_WIE;
        if (r < 2 * I_SQ) { const int li = r / I_SQ; SrcPlain s{KIN(I_WOUTE) + (size_t)li * DM * DM, DM}; tr_item(s, DM, DM, WSP(bf16, WS_WOE) + (size_t)li * DM * DM, scr, r % I_SQ, lane); continue; } r -= 2 * I_SQ;
        if (r < 2 * I_WIO) { const int li = r / I_WIO; SrcPlain s{KIN(I_WINO) + (size_t)li * DM * NO, NO}; tr_item(s, DM, NO, WSP(bf16, WS_WIO) + (size_t)li * NO * DM, scr, r % I_WIO, lane); continue; } r -= 2 * I_WIO;
        if (r < 2 * I_SQ) { const int li = r / I_SQ; SrcPlain s{KIN(I_WOUTO) + (size_t)li * DM * DM, DM}; tr_item(s, DM, DM, WSP(bf16, WS_WOO) + (size_t)li * DM * DM, scr, r % I_SQ, lane); continue; } r -= 2 * I_SQ;
        if (r < 4 * I_UP) { const int l = r / I_UP; SrcPlain s{KIN(I_FUP) + (size_t)l * DM * NUP, NUP}; tr_item(s, DM, NUP, WSP(bf16, WS_WUP) + (size_t)l * NUP * DM, scr, r % I_UP, lane); continue; } r -= 4 * I_UP;
        if (r < 4 * I_DN) { const int l = r / I_DN; SrcPlain s{KIN(I_FDOWN) + (size_t)l * DFF * DM, DM}; tr_item(s, DFF, DM, WSP(bf16, WS_WDN) + (size_t)l * DM * DFF, scr, r % I_DN, lane); continue; } r -= 4 * I_DN;
        if (r < 2 * I_PHI) { const int li = r / I_PHI; SrcPhi s{KIN(I_PW1) + (size_t)li * 2 * 262144}; tr_item(s, 1024, 512, WSP(bf16, WS_PHI1) + (size_t)li * 512 * 1024, scr, r % I_PHI, lane); continue; } r -= 2 * I_PHI;
        { const int li = r / I_LORA; SrcLora s{KIN(I_W2) + (size_t)li * 64 * 512, KIN(I_A2) + (size_t)li * 64 * 512, KIN(I_G2) + (size_t)li * 128 * 512};
          tr_item(s, KLORA, NLORA, WSP(bf16, WS_LORA) + (size_t)li * NLORA * KLORA, scr, r % I_LORA, lane); }
    }
    if (gw < 8) { const int lk = gw >> 1, e = (gw & 1) * 64 + lane; const float* pe = KIN(I_PPE) + (size_t)lk * 2048; const float* w1 = KIN(I_PW1) + (size_t)lk * 262144;
        float a = 0.f; for (int jd = 0; jd < 2048; ++jd) a += pe[jd] * w1[(size_t)jd * 128 + e];
        WSP(float, WS_PEC)[lk * 128 + e] = a; }
    for (int m = gw; m < MT; m += NGW) rms_row_to_bf16(xin_row(F, m), KIN(I_NMIX), WSP(bf16, WS_XN) + (size_t)m * DM, lane);
}
DI void norm_phase(Frame& F, const float* gain) {
    const int gw = F.bid * NWAVES + F.wave, NGW = F.G * NWAVES;
    for (int m = gw; m < MT; m += NGW) rms_row_to_bf16(OUTF + (size_t)m * DM, gain, WSP(bf16, WS_XN) + (size_t)m * DM, F.lane);
}

DI void store8f(float* p, const float (&v)[8]) { *(f32x4*)p = (f32x4){v[0], v[1], v[2], v[3]}; *(f32x4*)(p + 4) = (f32x4){v[4], v[5], v[6], v[7]}; }
DI void ld8bf(const bf16* p, float (&v)[8]) { const v4u w = *(const v4u*)p; v[0] = bflo(w.x); v[1] = bfhi(w.x); v[2] = bflo(w.y); v[3] = bfhi(w.y); v[4] = bflo(w.z); v[5] = bfhi(w.z); v[6] = bflo(w.w); v[7] = bfhi(w.w); }
DI void ld8f(const float* p, float (&v)[8]) { const f32x4 a = *(const f32x4*)p, b = *(const f32x4*)(p + 4); v[0] = a.x; v[1] = a.y; v[2] = a.z; v[3] = a.w; v[4] = b.x; v[5] = b.y; v[6] = b.z; v[7] = b.w; }

DI void post_even_tile(Frame& F, int tt, int li) {
    const bool samp = tt >= 256;
    const int w = F.wave, lane = F.lane;
    int b, tbase, row0, blk = 0;
    if (!samp) { b = tt >> 5; blk = tt & 31; tbase = blk * 64 + 8 * w; row0 = b * SEQ + tbase; }
    else { b = (tt - 256) * 8 + w; tbase = 0; row0 = MP + b * DT; }
    LAS bf16* vts = (LAS bf16*)(F.lds + RING_OFF);
    LAS bf16* vtw = vts + 2 * 64 * 66;
    const bf16* ZB = WSP(bf16, WS_ZB);
    float qg[8], kkw[8], mu[4][8], kn1[4], kn2[4];
    ld8f(KIN(I_QN) + li * 64 + (lane & 7) * 8, qg);
    ld8f(KIN(I_KKW) + li * 512 + lane * 8, kkw);
#pragma unroll
    for (int p = 0; p < 4; ++p) { if (p < 3 || lane < 32) ld8f(KIN(I_MU) + li * RWP + p * 512 + lane * 8, mu[p]); else { for (int i = 0; i < 8; ++i) mu[p][i] = 0.f; } }
    { const f32x4 a = *(const f32x4*)(KIN(I_KN) + (li * 3 + 1) * 64 + (lane & 15) * 4), c = *(const f32x4*)(KIN(I_KN) + (li * 3 + 2) * 64 + (lane & 15) * 4);
      kn1[0] = a.x; kn1[1] = a.y; kn1[2] = a.z; kn1[3] = a.w; kn2[0] = c.x; kn2[1] = c.y; kn2[2] = c.z; kn2[3] = c.w; }
    float zp[4][8];
#pragma unroll
    for (int p = 0; p < 4; ++p) {
        const bool act = (p < 3 || lane < 32);
        if (!act) { for (int i = 0; i < 8; ++i) zp[p][i] = 0.f; }
        else if (tbase == 0) { if (samp) ld8f(KIN(I_SSHIFT) + (size_t)(b * 2 + li) * RWP + p * 512 + lane * 8, zp[p]); else { for (int i = 0; i < 8; ++i) zp[p][i] = 0.f; } }
        else ld8bf(ZB + (size_t)(row0 - 1) * NE + 1280 + p * 512 + lane * 8, zp[p]);
    }
    float* SC = WSP(float, WS_SC);
    for (int i8 = 0; i8 < 8; ++i8) {
        const int t = tbase + i8, row = row0 + i8;
        const bf16* zr = ZB + (size_t)row * NE;
        { float x[8]; ld8bf(zr + lane * 8, x); float ss = 0.f;
#pragma unroll
          for (int i = 0; i < 8; ++i) ss += x[i] * x[i];
          ss = sum8(ss); const float rinv = 1.0f / sqrtf(ss * (1.f / 64.f) + RMS_EPS);
          v4u o; o.x = pk2(x[0] * rinv * qg[0], x[1] * rinv * qg[1]); o.y = pk2(x[2] * rinv * qg[2], x[3] * rinv * qg[3]); o.z = pk2(x[4] * rinv * qg[4], x[5] * rinv * qg[5]); o.w = pk2(x[6] * rinv * qg[6], x[7] * rinv * qg[7]);
          *(v4u*)(WSP(bf16, WS_QB) + (size_t)row * 512 + lane * 8) = o; }
#pragma unroll
        for (int c = 0; c < 3; ++c) {
            const v2u wv = *(const v2u*)(zr + 512 + c * 256 + lane * 4);
            float x[4] = {bflo(wv.x), bfhi(wv.x), bflo(wv.y), bfhi(wv.y)};
            const int g = (lane >> 4) & 1, dd = (lane & 15) * 4; const bool isv = lane >= 32;
            if (c > 0) { float ss = (x[0] * x[0] + x[1] * x[1]) + (x[2] * x[2] + x[3] * x[3]); ss = sum16(ss);
                if (!isv) { const float rinv = 1.0f / sqrtf(ss * (1.f / 64.f) + RMS_EPS);
#pragma unroll
                    for (int i = 0; i < 4; ++i) x[i] = x[i] * rinv * (c == 1 ? kn1[i] : kn2[i]); } }
            float* op = nullptr;
            if (c == 0) op = OUTF + (samp ? O_CMPS + ((size_t)(b * 2 + li) * DT + t) * 256 : O_CMPP + ((size_t)(b * 2 + li) * SEQ + t) * 256);
            else if (c == 1) op = OUTF + (samp ? O_SLCS + ((size_t)(b * 2 + li) * DT + t) * 256 : O_SLCP + ((size_t)(b * 2 + li) * SEQ + t) * 256);
            else { if (samp) op = OUTF + O_WINS + ((size_t)(b * 2 + li) * WIN + (WIN - DT) + t) * 256; else if (t >= SEQ - WIN) op = OUTF + O_WINP + ((size_t)(b * 2 + li) * WIN + (t - (SEQ - WIN))) * 256; }
            if (op) *(f32x4*)(op + lane * 4) = (f32x4){x[0], x[1], x[2], x[3]};
            if (!samp) {
                v2u pk; pk.x = pk2(x[0], x[1]); pk.y = pk2(x[2], x[3]);
                if (c == 0) { const int rw = (isv ? CS_PV : CS_PK) + (b * 2 + g) * 128 + (t >> 4);
                    *(v2u*)(WSP(bf16, WS_CSEG) + (size_t)rw * 1024 + (t & 15) * 64 + dd) = pk; }
                else if (!isv) { *(v2u*)(WSP(bf16, c == 1 ? WS_KS : WS_KW) + ((size_t)(b * 2 + g) * SEQ + t) * 64 + dd) = pk; }
                else { LAS bf16* vt = (c == 1 ? vts : vtw) + (g * 64 + dd) * 66 + (t & 63);
                    vt[0] = (bf16)(pk.x & 0xffffu); vt[66] = (bf16)(pk.x >> 16); vt[132] = (bf16)(pk.y & 0xffffu); vt[198] = (bf16)(pk.y >> 16); }
            }
        }
        if (lane < 24) WSP(float, WS_GATE)[(size_t)row * 32 + lane] = sigmoidf_(bf2f(zr[3072 + lane]));
        const bool lastt = samp ? (t == DT - 1) : (t == SEQ - 1);
#pragma unroll
        for (int p = 0; p < 4; ++p) {
            if (p < 3 || lane < 32) {
                float z[8], zz[8]; ld8bf(zr + 1280 + p * 512 + lane * 8, z);
#pragma unroll
                for (int i = 0; i < 8; ++i) { zz[i] = z[i] + (zp[p][i] - z[i]) * mu[p][i]; zp[p][i] = z[i]; }
                if (lastt) store8f(OUTF + (samp ? O_SHS : O_SHP) + (size_t)(b * 2 + li) * RWP + p * 512 + lane * 8, z);
                const int h = lane >> 3, d = (lane & 7) * 8;
                float* scb = SC + ((size_t)row * 8 + h) * 384 + d;
                if (p == 0) store8f(scb + 4 * 64, zz);
                else if (p == 2) store8f(scb + 5 * 64, zz);
                else if (p == 1) { store8f(scb + 3 * 64, zz); float kk[8]; float ss = 0.f;
#pragma unroll
                    for (int i = 0; i < 8; ++i) { kk[i] = zz[i] * kkw[i]; ss += kk[i] * kk[i]; }
                    ss = sum8(ss); const float rinv = 1.0f / sqrtf(fmaxf(ss, 1e-24f));
#pragma unroll
                    for (int i = 0; i < 8; ++i) kk[i] *= rinv;
                    store8f(scb + 1 * 64, kk); }
                else { float o[8];
#pragma unroll
                    for (int i = 0; i < 8; ++i) o[i] = lane < 8 ? tanhf_(zz[i]) : (lane < 16 ? zz[i] : sigmoidf_(zz[i]));
                    v4u pk; pk.x = pk2(o[0], o[1]); pk.y = pk2(o[2], o[3]); pk.z = pk2(o[4], o[5]); pk.w = pk2(o[6], o[7]);
                    *(v4u*)(WSP(bf16, WS_LA) + (size_t)row * 256 + lane * 8) = pk; }
            }
        }
    }
    if (!samp) {
        __syncthreads();
#pragma unroll
        for (int a = 0; a < 2; ++a) { const LAS bf16* vt = a ? vtw : vts; const int ri = F.tid >> 2, q4 = F.tid & 3;
            const LAS unsigned* s = (const LAS unsigned*)(vt + ri * 66 + q4 * 16);
            v4u o0, o1; o0.x = s[0]; o0.y = s[1]; o0.z = s[2]; o0.w = s[3]; o1.x = s[4]; o1.y = s[5]; o1.z = s[6]; o1.w = s[7];
            bf16* dst = WSP(bf16, a ? WS_VWT : WS_VST) + (((size_t)(b * 2 + (ri >> 6)) * 32 + blk) * 64 + (ri & 63)) * 64 + q4 * 16;
            *(v4u*)dst = o0; *(v4u*)(dst + 8) = o1; }
        __syncthreads();
    }
}
DI void cseg_page_unit(Frame& F, int u, int li) {
    const int b = u >> 4, p = u & 15; const int pg = ((const int*)KIN(I_PT))[b * NPAGE + p];
    const float* src = KIN(I_CCMP) + ((size_t)pg * 2 + li) * (PAGE * 256);
    bf16* CS = WSP(bf16, WS_CSEG);
#pragma unroll
    for (int k = 0; k < 8; ++k) { const int q = k * NTHREADS + F.tid; const int r = q >> 5, c = q & 31; float v[8]; ld8f(src + (size_t)r * 256 + c * 8, v);
        const int kv = c >> 4, g = (c >> 3) & 1, d0 = (c & 7) * 8;
        v4u o; o.x = pk2(v[0], v[1]); o.y = pk2(v[2], v[3]); o.z = pk2(v[4], v[5]); o.w = pk2(v[6], v[7]);
        *(v4u*)(CS + ((size_t)((kv ? CS_SV : CS_SK) + (b * 2 + g) * 128 + p * 8 + (r >> 4))) * 1024 + (r & 15) * 64 + d0) = o; }
}
DI void win_copy_unit(Frame& F, int u, int li) {
    const int b = u >> 2, q = u & 3;
    const f32x4* src = (const f32x4*)(KIN(I_CWIN) + ((size_t)(b * 2 + li) * WIN + DT + q * 126) * 256);
    f32x4* dst = (f32x4*)(OUTF + O_WINS + ((size_t)(b * 2 + li) * WIN + q * 126) * 256);
    for (int i = F.tid; i < 126 * 64; i += NTHREADS) dst[i] = src[i];
}
DI void post_even_phase(Frame& F, int li) {
    constexpr int NT = 272, NC = DB * NPAGE, NW = DB * 4;
    for (int u = F.bid; u < NT + NC + NW; u += F.G) {
        if (u < NT) post_even_tile(F, u, li);
        else if (u < NT + NC) cseg_page_unit(F, u - NT, li);
        else win_copy_unit(F, u - NT - NC, li);
    }
}

DI float gelu_tanh(float x) { const float u = 0.7978845608028654f * (x + 0.044715f * x * x * x); return 0.5f * x * (1.0f + tanhf_(u)); }
DI void compress2_unit(Frame& F, int cu, int li) {
    const int w = F.wave, lane = F.lane;
    LAS float* w2s = (LAS float*)(F.lds + RING_OFF);
    LAS float* hb = w2s + 2 * 128 * 64 + w * 128;
    for (int i = F.tid; i < 2 * 128 * 64 / 4; i += NTHREADS) ((LAS f32x4*)w2s)[i] = ((const f32x4*)(KIN(I_PW2) + (size_t)li * 2 * 128 * 64))[i];
    __syncthreads();
    const bool prm = cu >= 256; const int bg = prm ? cu - 256 : cu;
    const float* PART = WSP(float, WS_PART); const float* pec = WSP(float, WS_PEC) + li * 256;
    const float kn = KIN(I_KN)[(li * 3 + 0) * 64 + lane];
    bf16* KC = WSP(bf16, WS_KC) + (size_t)cu * 8192; bf16* VCT = WSP(bf16, WS_VCT) + (size_t)cu * 8192;
    for (int kv = 0; kv < 2; ++kv) {
        const size_t rb = (size_t)(prm ? (kv ? CS_PV : CS_PK) : (kv ? CS_SV : CS_SK)) + (size_t)bg * 128;
        const float pe0 = pec[kv * 128 + lane], pe1 = pec[kv * 128 + 64 + lane];
        for (int n = w; n < 128; n += NWAVES) {
            float o = 0.f;
            if (n < NCMP) {
                const float* p0 = PART + (rb + n) * 256; const float* p1 = PART + (rb + n + 1) * 256 + 128;
                hb[lane] = gelu_tanh(pe0 + p0[lane] + p1[lane]); hb[lane + 64] = gelu_tanh(pe1 + p0[lane + 64] + p1[lane + 64]);
                LDS_WAIT(); asm volatile("" ::: "memory");
                const LAS float* wk = w2s + kv * 8192 + lane;
#pragma unroll 8
                for (int e = 0; e < 128; ++e) o += hb[e] * wk[e * 64];
                asm volatile("" ::: "memory");
                if (kv == 0) { const float ss = wave_sum(o * o); o = o * (1.0f / sqrtf(ss * (1.f / 64.f) + RMS_EPS)) * kn; }
            }
            const bf16 ob = (bf16)(pk2(o, 0.f) & 0xffffu);
            if (kv == 0) KC[n * 64 + lane] = ob; else VCT[lane * 128 + n] = ob;
        }
    }
    __syncthreads();
}
DI void compress2_phase(Frame& F, int li) { for (int u = F.bid; u < 272; u += F.G) compress2_unit(F, u, li); }

DI void odd_mix_phase(Frame& F, int li) {
    const bf16* ZB = WSP(bf16, WS_ZB); bf16* MIX = WSP(bf16, WS_MIX);
    const float* cw = KIN(I_CONVW) + (size_t)li * 3 * DM;
    constexpr int NCG = DM / 8, NRUN = MT / 8;
    for (int it = F.bid * NTHREADS + F.tid; it < NRUN * NCG; it += F.G * NTHREADS) {
        const int run = it / NCG, ch = (it % NCG) * 8;
        const bool samp = run >= MP / 8; const int b = samp ? run - MP / 8 : run >> 8, t0 = samp ? 0 : (run & 255) * 8, row0 = run * 8;
        float w0[8], w1[8], w2[8], p2[8], p1[8];
        ld8f(cw + ch, w0); ld8f(cw + DM + ch, w1); ld8f(cw + 2 * DM + ch, w2);
        if (t0 == 0) { if (samp) { ld8f(KIN(I_SCONV) + ((size_t)(b * 2 + li) * 2 + 0) * DM + ch, p2); ld8f(KIN(I_SCONV) + ((size_t)(b * 2 + li) * 2 + 1) * DM + ch, p1); }
                       else { for (int i = 0; i < 8; ++i) { p2[i] = 0.f; p1[i] = 0.f; } } }
        else { float a[8], c[8]; ld8bf(ZB + (size_t)(row0 - 2) * NO + DM + ch, a); ld8bf(ZB + (size_t)(row0 - 2) * NO + 2 * DM + ch, c); for (int i = 0; i < 8; ++i) p2[i] = a[i] * c[i];
               ld8bf(ZB + (size_t)(row0 - 1) * NO + DM + ch, a); ld8bf(ZB + (size_t)(row0 - 1) * NO + 2 * DM + ch, c); for (int i = 0; i < 8; ++i) p1[i] = a[i] * c[i]; }
#pragma unroll
        for (int j = 0; j < 8; ++j) {
            const bf16* zr = ZB + (size_t)(row0 + j) * NO; float bgv[8], cg[8], xi[8], p[8], o[8];
            ld8bf(zr + ch, bgv); ld8bf(zr + DM + ch, cg); ld8bf(zr + 2 * DM + ch, xi);
#pragma unroll
            for (int i = 0; i < 8; ++i) { p[i] = cg[i] * xi[i]; o[i] = bgv[i] * (w0[i] * p2[i] + w1[i] * p1[i] + w2[i] * p[i]); p2[i] = p1[i]; p1[i] = p[i]; }
            v4u pk; pk.x = pk2(o[0], o[1]); pk.y = pk2(o[2], o[3]); pk.z = pk2(o[4], o[5]); pk.w = pk2(o[6], o[7]);
            *(v4u*)(MIX + (size_t)(row0 + j) * DM + ch) = pk;
            const int t = t0 + j; const int tl = samp ? DT : SEQ;
            if (t >= tl - 2) store8f(OUTF + (samp ? O_CVS : O_CVP) + ((size_t)(b * 2 + li) * 2 + (t - (tl - 2))) * DM + ch, p);
        }
    }
}
DI void ffn_act_phase(Frame& F, int l) {
    const bf16* AU = WSP(bf16, WS_ZB); bf16* H = WSP(bf16, WS_H);
    const float* cw = KIN(I_FCONV) + (size_t)l * 3 * DFF;
    constexpr int NCG = DFF / 8, NRUN = MT / 8;
    for (int it = F.bid * NTHREADS + F.tid; it < NRUN * NCG; it += F.G * NTHREADS) {
        const int run = it / NCG, ch = (it % NCG) * 8;
        const bool samp = run >= MP / 8; const int b = samp ? run - MP / 8 : run >> 8, t0 = samp ? 0 : (run & 255) * 8, row0 = run * 8;
        float w0[8], w1[8], w2[8], a2[8], a1[8];
        ld8f(cw + ch, w0); ld8f(cw + DFF + ch, w1); ld8f(cw + 2 * DFF + ch, w2);
        if (t0 == 0) { if (samp) { ld8f(KIN(I_SFFN) + ((size_t)(b * 4 + l) * 2 + 0) * DFF + ch, a2); ld8f(KIN(I_SFFN) + ((size_t)(b * 4 + l) * 2 + 1) * DFF + ch, a1); }
                       else { for (int i = 0; i < 8; ++i) { a2[i] = 0.f; a1[i] = 0.f; } } }
        else { ld8bf(AU + (size_t)(row0 - 2) * NUP + ch, a2); ld8bf(AU + (size_t)(row0 - 1) * NUP + ch, a1); }
#pragma unroll
        for (int j = 0; j < 8; ++j) {
            const bf16* zr = AU + (size_t)(row0 + j) * NUP; float a[8], uu[8], o[8];
            ld8bf(zr + ch, a); ld8bf(zr + DFF + ch, uu);
#pragma unroll
            for (int i = 0; i < 8; ++i) { const float y = w0[i] * a2[i] + w1[i] * a1[i] + w2[i] * a[i]; o[i] = y * sigmoidf_(y) * uu[i]; a2[i] = a1[i]; a1[i] = a[i]; }
            v4u pk; pk.x = pk2(o[0], o[1]); pk.y = pk2(o[2], o[3]); pk.z = pk2(o[4], o[5]); pk.w = pk2(o[6], o[7]);
            *(v4u*)(H + (size_t)(row0 + j) * DFF + ch) = pk;
            const int t = t0 + j; const int tl = samp ? DT : SEQ;
            if (t >= tl - 2) store8f(OUTF + (samp ? O_FFS : O_FFP) + ((size_t)(b * 4 + l) * 2 + (t - (tl - 2))) * DFF + ch, a);
        }
    }
}

DI int rel_bucket(int d) {
    if (d < 16) return d;
    int bkt = 16;
    bkt += (d >= 19) + (d >= 21) + (d >= 24) + (d >= 27) + (d >= 31) + (d >= 35) + (d >= 40) + (d >= 46) + (d >= 52) + (d >= 59) + (d >= 67) + (d >= 77) + (d >= 87) + (d >= 99) + (d >= 113);
    return bkt;
}
DI void fill_bias_table(Frame& F, LAS float* biasT, int g) {
    const int hq = F.tid >> 7, d = F.tid & 127;
    biasT[F.tid] = KIN(I_RELB)[rel_bucket(d) * 8 + g * 4 + hq] * LOG2E;
}
DI bf16x8 pack_p(const f32x16& p, int s) {
    v4u r; r.x = pk2(p[8 * s + 0], p[8 * s + 1]); r.y = pk2(p[8 * s + 2], p[8 * s + 3]); r.z = pk2(p[8 * s + 4], p[8 * s + 5]); r.w = pk2(p[8 * s + 6], p[8 * s + 7]);
    return __builtin_bit_cast(bf16x8, r);
}
constexpr float SC2 = 0.125f * LOG2E;
constexpr float NEG_BIG = -1e30f;

DI void softmax_pv(f32x16& s, float& m, float& l, f32x16 (&O)[2], const bf16x8 (&vf)[2][2]) {
    float mx = s[0];
#pragma unroll
    for (int i = 1; i < 16; ++i) mx = fmaxf(mx, s[i]);
    mx = fmaxf(mx, __shfl_xor(mx, 32));
    const float mn = fmaxf(m, mx), alpha = fexp2(m - mn);
    m = mn;
    float ps = 0.f;
#pragma unroll
    for (int i = 0; i < 16; ++i) { s[i] = fexp2(s[i] - mn); ps += s[i]; }
    l = l * alpha + ps;
#pragma unroll
    for (int dt = 0; dt < 2; ++dt) O[dt] = O[dt] * alpha;
    const bf16x8 p0 = pack_p(s, 0), p1 = pack_p(s, 1);
#pragma unroll
    for (int dt = 0; dt < 2; ++dt) { O[dt] = MFMA32(vf[dt][0], p0, O[dt]); O[dt] = MFMA32(vf[dt][1], p1, O[dt]); }
}

DI void cmp_branch(const bf16x8 (&qf)[4], const bf16* kc, const bf16* vct, int t, int ccur, const LAS float* biasT, int lane, LAS float* scr, f32x16 (&Oc)[2], unsigned& selmask) {
    const int kl = lane & 31, h = lane >> 5, hq = kl & 3, tl = kl >> 2;
    f32x16 S[4];
#pragma unroll
    for (int kt = 0; kt < 4; ++kt) {
#pragma unroll
        for (int i = 0; i < 16; ++i) S[kt][i] = 0.f;
#pragma unroll
        for (int ks = 0; ks < 4; ++ks) { const bf16x8 a = *(const bf16x8*)(kc + (32 * kt + kl) * 64 + 16 * ks + 8 * h); S[kt] = MFMA32(a, qf[ks], S[kt]); }
    }
    const int nmax = (t - 31) >> 4;
    float mx = NEG_BIG;
#pragma unroll
    for (int kt = 0; kt < 4; ++kt) {
        float bv[16];
#pragma unroll
        for (int i = 0; i < 16; ++i) { const int n = 32 * kt + crow(i, h); const int dist = t - (16 * n + 31); const int idx = dist < 0 ? 0 : (dist > 127 ? 127 : dist); bv[i] = biasT[hq * 128 + idx]; }
#pragma unroll
        for (int i = 0; i < 16; ++i) { const int n = 32 * kt + crow(i, h); float v = S[kt][i] * SC2 + bv[i]; v = (n <= nmax) ? v : -INFINITY; S[kt][i] = v; mx = fmaxf(mx, v); }
    }
    mx = fmaxf(mx, __shfl_xor(mx, 32));
    float sum = 0.f;
#pragma unroll
    for (int kt = 0; kt < 4; ++kt)
#pragma unroll
        for (int i = 0; i < 16; ++i) { const float e = fexp2(S[kt][i] - mx); S[kt][i] = e; sum += e; }
    sum += __shfl_xor(sum, 32);
    const float inv = sum > 0.f ? 1.0f / sum : 0.f;
#pragma unroll
    for (int kt = 0; kt < 4; ++kt) S[kt] = S[kt] * inv;
    f32x16 I;
#pragma unroll
    for (int i = 0; i < 16; ++i) { Oc[0][i] = 0.f; Oc[1][i] = 0.f; I[i] = 0.f; }
#pragma unroll
    for (int kt = 0; kt < 4; ++kt)
#pragma unroll
        for (int st = 0; st < 2; ++st) {
            const bf16x8 ph = pack_p(S[kt], st);
            f32x16 lo = S[kt];
#pragma unroll
            for (int j = 0; j < 8; ++j) { const unsigned short hb = (unsigned short)ph[j]; lo[8 * st + j] = S[kt][8 * st + j] - bf2f(hb); }
            const bf16x8 pl = pack_p(lo, st);
#pragma unroll
            for (int dt = 0; dt < 2; ++dt) { const bf16* vr = vct + (dt * 32 + kl) * 128 + 32 * kt + 16 * st + 4 * h;
                const v2u a0 = *(const v2u*)vr, a1 = *(const v2u*)(vr + 8); v4u av; av.x = a0.x; av.y = a0.y; av.z = a1.x; av.w = a1.y;
                Oc[dt] = MFMA32(__builtin_bit_cast(bf16x8, av), ph, Oc[dt]); }
            bf16x8 ov;
#pragma unroll
            for (int j = 0; j < 8; ++j) { const int n = 32 * kt + 16 * st + 8 * (j >> 2) + 4 * h + (j & 3); ov[j] = (n >= 4 * kl - 1 && n <= 4 * kl + 3) ? (short)0x3F80 : (short)0; }
            I = MFMA32(ov, ph, I); I = MFMA32(ov, pl, I);
        }
#pragma unroll
    for (int i = 0; i < 16; ++i) I[i] = sum4(I[i]);
    if (hq == 0) {
#pragma unroll
        for (int i = 0; i < 16; ++i) { const int sb = crow(i, h); scr[tl * 33 + sb] = (sb >= 1 && sb <= ccur - 2) ? I[i] : -INFINITY; }
    }
    LDS_WAIT(); asm volatile("" ::: "memory");
    float v[32];
#pragma unroll
    for (int s = 0; s < 32; ++s) v[s] = scr[tl * 33 + s];
    const int sub = hq + 4 * h;
    unsigned bits = 0u;
#pragma unroll
    for (int k = 0; k < 4; ++k) { const int sk = 4 * sub + k; const float x = scr[tl * 33 + sk]; int cnt = 0;
#pragma unroll
        for (int s = 0; s < 32; ++s) cnt += (v[s] > x || (v[s] == x && s < sk)) ? 1 : 0;
        if (sk >= 1 && sk <= ccur - 2 && cnt < 13) bits |= 1u << sk; }
    LDS_WAIT(); asm volatile("" ::: "memory");
    bits |= dppu<XOR1>(bits); bits |= dppu<XOR2>(bits); bits |= (unsigned)__shfl_xor((int)bits, 32);
    unsigned forced = 1u;
    if (ccur < 32) forced |= 1u << ccur;
    if (ccur >= 1) forced |= 1u << (ccur - 1);
    selmask = bits | forced;
}

constexpr int KV_PITCH = 72;
constexpr int AT_KBUF = 0, AT_VBUF = 2 * 64 * KV_PITCH * 2, AT_BIAS = 2 * AT_VBUF, AT_SCR = AT_BIAS + 2048, AT_OUT = AT_SCR + 8 * 8 * 33 * 4, AT_END = AT_OUT + 8 * 64 * 32 * 4;
template <int MODE>
DI void prompt_branch(Frame& F, const bf16* Kg, const bf16* Vg, int s_lo, int s_hi, int c, int t, unsigned sel, const bf16x8 (&qf)[4], const LAS float* biasT, float gate, LAS float* outw) {
    const int lane = F.lane, kl = lane & 31, h = lane >> 5, hq = kl & 3;
    LAS bf16* Kb = (LAS bf16*)(F.lds + RING_OFF + AT_KBUF); LAS bf16* Vb = (LAS bf16*)(F.lds + RING_OFF + AT_VBUF);
    const int srow = F.tid >> 3, spc = F.tid & 7;
    f32x16 O[2]; float m = NEG_BIG, l = 0.f;
#pragma unroll
    for (int i = 0; i < 16; ++i) { O[0][i] = 0.f; O[1][i] = 0.f; }
    const float bfar = biasT[hq * 128 + 127];
    v4u kr = *(const v4u*)(Kg + ((size_t)s_lo * 64 + srow) * 64 + spc * 8), vr = *(const v4u*)(Vg + ((size_t)s_lo * 64 + srow) * 64 + spc * 8);
    *(LAS v4u*)(Kb + srow * KV_PITCH + spc * 8) = kr; *(LAS v4u*)(Vb + srow * KV_PITCH + spc * 8) = vr;
    __syncthreads();
    int buf = 0;
    for (int s = s_lo; s <= s_hi; ++s) {
        if (s < s_hi) { kr = *(const v4u*)(Kg + ((size_t)(s + 1) * 64 + srow) * 64 + spc * 8); vr = *(const v4u*)(Vg + ((size_t)(s + 1) * 64 + srow) * 64 + spc * 8); }
        const bool act = (MODE == 1) ? true : (((sel >> s) & 1u) != 0u);
        if (__any(act)) {
            const LAS bf16* kb = Kb + buf * 64 * KV_PITCH; const LAS bf16* vb = Vb + buf * 64 * KV_PITCH;
            const bool near = s >= c - 2;
#pragma unroll
            for (int kt = 0; kt < 2; ++kt) {
                f32x16 S;
#pragma unroll
                for (int i = 0; i < 16; ++i) S[i] = 0.f;
#pragma unroll
                for (int ks = 0; ks < 4; ++ks) { const bf16x8 a = *(const LAS bf16x8*)(kb + (32 * kt + kl) * KV_PITCH + 16 * ks + 8 * h); S = MFMA32(a, qf[ks], S); }
                bf16x8 vf[2][2];
#pragma unroll
                for (int dt = 0; dt < 2; ++dt)
#pragma unroll
                    for (int st = 0; st < 2; ++st) { const LAS bf16* vp = vb + (dt * 32 + kl) * KV_PITCH + 32 * kt + 16 * st + 4 * h;
                        const v2u a0 = *(const LAS v2u*)vp, a1 = *(const LAS v2u*)(vp + 8); v4u av; av.x = a0.x; av.y = a0.y; av.z = a1.x; av.w = a1.y; vf[dt][st] = __builtin_bit_cast(bf16x8, av); }
                const int key0 = 64 * s + 32 * kt;
                if (near) {
                    float bv[16];
#pragma unroll
                    for (int i = 0; i < 16; ++i) { const int dist = t - (key0 + crow(i, h)); const int idx = dist < 0 ? 0 : (dist > 127 ? 127 : dist); bv[i] = biasT[hq * 128 + idx]; }
#pragma unroll
                    for (int i = 0; i < 16; ++i) { const int dist = t - (key0 + crow(i, h)); const bool ok = act && dist >= 0 && (MODE == 0 || dist < WIN); const float v = S[i] * SC2 + bv[i]; S[i] = ok ? v : -INFINITY; }
                } else {
#pragma unroll
                    for (int i = 0; i < 16; ++i) { const int dist = t - (key0 + crow(i, h)); const bool ok = act && dist >= 0 && (MODE == 0 || dist < WIN); const float v = S[i] * SC2 + bfar; S[i] = ok ? v : -INFINITY; }
                }
                softmax_pv(S, m, l, O, vf);
            }
        }
        if (s < s_hi) { *(LAS v4u*)(Kb + (buf ^ 1) * 64 * KV_PITCH + srow * KV_PITCH + spc * 8) = kr; *(LAS v4u*)(Vb + (buf ^ 1) * 64 * KV_PITCH + srow * KV_PITCH + spc * 8) = vr; }
        __syncthreads();
        buf ^= 1;
    }
    l += __shfl_xor(l, 32);
    const float sc = l > 0.f ? gate / l : 0.f;
#pragma unroll
    for (int dt = 0; dt < 2; ++dt)
#pragma unroll
        for (int i = 0; i < 16; ++i) outw[(dt * 32 + crow(i, h)) * 32 + kl] += O[dt][i] * sc;
}
DI void attn_prompt_unit(Frame& F, int b, int g, int c, int li) {
    const int w = F.wave, lane = F.lane, kl = lane & 31, h = lane >> 5, hq = kl & 3, tl = kl >> 2, hd = g * 4 + hq;
    LAS float* biasT = (LAS float*)(F.lds + RING_OFF + AT_BIAS); LAS float* scr = (LAS float*)(F.lds + RING_OFF + AT_SCR) + w * 8 * 33;
    fill_bias_table(F, biasT, g);
    const int t = 64 * c + 8 * w + tl, row = b * SEQ + t;
    bf16x8 qf[4];
#pragma unroll
    for (int ks = 0; ks < 4; ++ks) qf[ks] = *(const bf16x8*)(WSP(bf16, WS_QB) + (size_t)row * 512 + hd * 64 + 16 * ks + 8 * h);
    const float* gp = WSP(float, WS_GATE) + (size_t)row * 32 + hd * 3; const float g0 = gp[0], g1 = gp[1], g2 = gp[2];
    __syncthreads();
    unsigned sel;
    LAS float* outw = (LAS float*)(F.lds + RING_OFF + AT_OUT) + w * 2048;
    { f32x16 Oc[2];
      const int cu = 256 + b * 2 + g;
      cmp_branch(qf, WSP(bf16, WS_KC) + (size_t)cu * 8192, WSP(bf16, WS_VCT) + (size_t)cu * 8192, t, c, biasT, lane, scr, Oc, sel);
#pragma unroll
      for (int dt = 0; dt < 2; ++dt)
#pragma unroll
          for (int i = 0; i < 16; ++i) outw[(dt * 32 + crow(i, h)) * 32 + kl] = Oc[dt][i] * g0; }
    const size_t kvo = (size_t)(b * 2 + g) * SEQ * 64;
    prompt_branch<0>(F, WSP(bf16, WS_KS) + kvo, WSP(bf16, WS_VST) + kvo, 0, c, c, t, sel, qf, biasT, g1, outw);
    prompt_branch<1>(F, WSP(bf16, WS_KW) + kvo, WSP(bf16, WS_VWT) + kvo, c > 8 ? c - 8 : 0, c, c, t, sel, qf, biasT, g2, outw);
    bf16* mix = WSP(bf16, WS_MIX) + (size_t)row * DM + hd * 64;
#pragma unroll
    for (int dt = 0; dt < 2; ++dt)
#pragma unroll
        for (int a = 0; a < 4; ++a) { const LAS float* o4 = outw + (dt * 32 + 8 * a + 4 * h) * 32 + kl;
            v2u o; o.x = pk2(o4[0], o4[32]); o.y = pk2(o4[64], o4[96]); *(v2u*)(mix + dt * 32 + 8 * a + 4 * h) = o; }
}

constexpr int SA_BIAS = 0, SA_SCR = 2048, SA_ML = SA_SCR + 8 * 8 * 33 * 4, SA_OUT = SA_ML + 8 * 2 * 32 * 4, SA_RED = SA_OUT + 32 * 64 * 4, SA_END = SA_RED + 8 * 64 * 32 * 4;
template <int MODE>
DI void sample_branch(Frame& F, int b, int g, int li, int t, unsigned sel, const bf16x8 (&qf)[4], const LAS float* biasT) {
    const int w = F.wave, lane = F.lane, kl = lane & 31, h = lane >> 5, hq = kl & 3;
    const int ntile = (MODE == 0) ? 65 : 17;
    f32x16 O[2]; float m = NEG_BIG, l = 0.f;
#pragma unroll
    for (int i = 0; i < 16; ++i) { O[0][i] = 0.f; O[1][i] = 0.f; }
    const int* pt = (const int*)KIN(I_PT) + b * NPAGE;
    for (int j = w; j < ntile; j += NWAVES) {
        const bool fresh = (j == ntile - 1);
        const float* base; int pos0;
        if (MODE == 0) { if (!fresh) { base = KIN(I_CSLC) + (((size_t)pt[j >> 2] * 2 + li) * PAGE + (j & 3) * 32) * 256 + g * 64; pos0 = 32 * j; }
                         else { base = OUTF + O_SLCS + ((size_t)(b * 2 + li) * DT) * 256 + g * 64; pos0 = PAST; } }
        else { if (!fresh) { base = KIN(I_CWIN) + ((size_t)(b * 2 + li) * WIN + 32 * j) * 256 + g * 64; pos0 = PAST - WIN + 32 * j; }
               else { base = OUTF + O_WINS + ((size_t)(b * 2 + li) * WIN + (WIN - DT)) * 256 + g * 64; pos0 = PAST; } }
        const int rmask = fresh ? 7 : 31;
        f32x16 S;
#pragma unroll
        for (int i = 0; i < 16; ++i) S[i] = 0.f;
        const float* kp = base + (size_t)(kl & rmask) * 256 + 8 * h;
#pragma unroll
        for (int ks = 0; ks < 4; ++ks) { const f32x4 x0 = *(const f32x4*)(kp + 16 * ks), x1 = *(const f32x4*)(kp + 16 * ks + 4);
            v4u av; av.x = pk2(x0.x, x0.y); av.y = pk2(x0.z, x0.w); av.z = pk2(x1.x, x1.y); av.w = pk2(x1.z, x1.w);
            S = MFMA32(__builtin_bit_cast(bf16x8, av), qf[ks], S); }
        bf16x8 vf[2][2];
#pragma unroll
        for (int st = 0; st < 2; ++st) {
            float x[2][8];
#pragma unroll
            for (int jj = 0; jj < 8; ++jj) { const int kr = (16 * st + 8 * (jj >> 2) + 4 * h + (jj & 3)) & rmask; const float* vp = base + (size_t)kr * 256 + 128 + kl; x[0][jj] = vp[0]; x[1][jj] = vp[32]; }
#pragma unroll
            for (int dt = 0; dt < 2; ++dt) { v4u av; av.x = pk2(x[dt][0], x[dt][1]); av.y = pk2(x[dt][2], x[dt][3]); av.z = pk2(x[dt][4], x[dt][5]); av.w = pk2(x[dt][6], x[dt][7]); vf[dt][st] = __builtin_bit_cast(bf16x8, av); }
        }
        { float bv[16];
#pragma unroll
          for (int i = 0; i < 16; ++i) { const int dist = t - (pos0 + crow(i, h)); const int idx = dist < 0 ? 0 : (dist > 127 ? 127 : dist); bv[i] = biasT[hq * 128 + idx]; }
          const bool blk_ok = (MODE == 1) || fresh || (((sel >> ((j >> 1) & 31)) & 1u) != 0u);
#pragma unroll
          for (int i = 0; i < 16; ++i) { const int ko = crow(i, h); const int dist = t - (pos0 + ko);
            const bool ok = blk_ok && dist >= 0 && (!fresh || ko < DT) && (MODE == 0 || dist < WIN);
            const float v = S[i] * SC2 + bv[i]; S[i] = ok ? v : -INFINITY; } }
        softmax_pv(S, m, l, O, vf);
    }
    l += __shfl_xor(l, 32);
    LAS float* ml = (LAS float*)(F.lds + RING_OFF + SA_ML); LAS float* red = (LAS float*)(F.lds + RING_OFF + SA_RED) + w * 2048;
    if (h == 0) { ml[(w * 2 + 0) * 32 + kl] = m; ml[(w * 2 + 1) * 32 + kl] = l; }
#pragma unroll
    for (int dt = 0; dt < 2; ++dt)
#pragma unroll
        for (int i = 0; i < 16; ++i) red[(dt * 32 + crow(i, h)) * 32 + kl] = O[dt][i];
}
DI void sample_combine(Frame& F, int b, int g, int gi) {
    const LAS float* ml = (const LAS float*)(F.lds + RING_OFF + SA_ML); const LAS float* red = (const LAS float*)(F.lds + RING_OFF + SA_RED);
    LAS float* outF = (LAS float*)(F.lds + RING_OFF + SA_OUT);
    const int q = F.tid & 31, d0 = (F.tid >> 5) * 4;
    float M = NEG_BIG;
#pragma unroll
    for (int w = 0; w < 8; ++w) M = fmaxf(M, ml[(w * 2) * 32 + q]);
    float L = 0.f, o[4] = {0.f, 0.f, 0.f, 0.f};
#pragma unroll
    for (int w = 0; w < 8; ++w) { const float f = fexp2(ml[(w * 2) * 32 + q] - M); L += ml[(w * 2 + 1) * 32 + q] * f;
#pragma unroll
        for (int k = 0; k < 4; ++k) o[k] += red[w * 2048 + (d0 + k) * 32 + q] * f; }
    const int row = MP + b * DT + (q >> 2), hd = g * 4 + (q & 3);
    const float gate = WSP(float, WS_GATE)[(size_t)row * 32 + hd * 3 + gi];
    const float sc = L > 0.f ? gate / L : 0.f;
#pragma unroll
    for (int k = 0; k < 4; ++k) outF[q * 64 + d0 + k] += o[k] * sc;
}
DI void attn_sample_unit(Frame& F, int b, int g, int li) {
    const int w = F.wave, lane = F.lane, kl = lane & 31, h = lane >> 5, hq = kl & 3, tl = kl >> 2, hd = g * 4 + hq;
    LAS float* biasT = (LAS float*)(F.lds + RING_OFF + SA_BIAS); LAS float* scr = (LAS float*)(F.lds + RING_OFF + SA_SCR) + w * 8 * 33;
    LAS float* outF = (LAS float*)(F.lds + RING_OFF + SA_OUT);
    fill_bias_table(F, biasT, g);
    const int t = PAST + tl, row = MP + b * DT + tl;
    bf16x8 qf[4];
#pragma unroll
    for (int ks = 0; ks < 4; ++ks) qf[ks] = *(const bf16x8*)(WSP(bf16, WS_QB) + (size_t)row * 512 + hd * 64 + 16 * ks + 8 * h);
    __syncthreads();
    f32x16 Oc[2]; unsigned sel;
    const int cu = b * 2 + g;
    cmp_branch(qf, WSP(bf16, WS_KC) + (size_t)cu * 8192, WSP(bf16, WS_VCT) + (size_t)cu * 8192, t, 32, biasT, lane, scr, Oc, sel);
    if (w == 0) { const float g0 = WSP(float, WS_GATE)[(size_t)row * 32 + hd * 3];
#pragma unroll
        for (int dt = 0; dt < 2; ++dt)
#pragma unroll
            for (int i = 0; i < 16; ++i) outF[kl * 64 + dt * 32 + crow(i, h)] = Oc[dt][i] * g0; }
    sample_branch<0>(F, b, g, li, t, sel, qf, biasT);
    __syncthreads();
    sample_combine(F, b, g, 1);
    __syncthreads();
    sample_branch<1>(F, b, g, li, t, sel, qf, biasT);
    __syncthreads();
    sample_combine(F, b, g, 2);
    __syncthreads();
    { const int q = F.tid >> 4, d4 = (F.tid & 15) * 4; const LAS float* s = outF + q * 64 + d4;
      v2u o; o.x = pk2(s[0], s[1]); o.y = pk2(s[2], s[3]);
      *(v2u*)(WSP(bf16, WS_MIX) + (size_t)(MP + b * DT + (q >> 2)) * DM + (g * 4 + (q & 3)) * 64 + d4) = o; }
    __syncthreads();
}

constexpr int SCN_STEPS = 32, SCN_CH = SCN_STEPS * 384 * 4  , SCN_Y = 2 * SCN_CH, SCN_END = SCN_Y + SCN_STEPS * 64 * 4;
DI void scan_post(Frame& F, const LAS float* ch, const LAS float* yb, int row0, int h, int li, int nsteps) {
    const int tok = F.tid >> 4, i0 = (F.tid & 15) * 4;
    if (tok < nsteps) {
        const LAS float* c = ch + tok * 384;
        const f32x4 y = *(const LAS f32x4*)(yb + tok * 64 + i0);
        const float mu = sum16((y.x + y.y) + (y.z + y.w)) * (1.f / 64.f);
        const f32x4 dv = y - mu;
        const float var = sum16((dv.x * dv.x + dv.y * dv.y) + (dv.z * dv.z + dv.w * dv.w)) * (1.f / 64.f);
        const float rs = 1.0f / sqrtf(var + GN_EPS);
        const f32x4 r = *(const LAS f32x4*)(c + 4 * 64 + i0), km = *(const LAS f32x4*)(c + 3 * 64 + i0), v = *(const LAS f32x4*)(c + 5 * 64 + i0);
        const f32x4 rk = *(const f32x4*)(KIN(I_RK) + (size_t)(li * 8 + h) * 64 + i0);
        const float bon = sum16((r.x * km.x * rk.x + r.y * km.y * rk.y) + (r.z * km.z * rk.z + r.w * km.w * rk.w));
        const f32x4 lw = *(const f32x4*)(KIN(I_LNW) + (size_t)li * 512 + h * 64 + i0), lb = *(const f32x4*)(KIN(I_LNB) + (size_t)li * 512 + h * 64 + i0);
        const int row = row0 + tok;
        const f32x4 gg = *(const f32x4*)(WSP(float, WS_G) + (size_t)row * 512 + h * 64 + i0);
        const f32x4 o = (dv * rs * lw + lb + v * bon) * gg;
        v2u pk; pk.x = pk2(o.x, o.y); pk.y = pk2(o.z, o.w);
        *(v2u*)(WSP(bf16, WS_MIX) + (size_t)row * DM + 512 + h * 64 + i0) = pk;
    }
}
DI const f32x4* scan_src(const float* SC, int b, int h, int t0, int tid, int k) { const int q = tid + NTHREADS * k; const int tk = q / 96, pc = q % 96;
    return (const f32x4*)(SC + ((size_t)(b * SEQ + t0 + tk) * 8 + h) * 384) + pc; }
DI void scan_prompt_unit(Frame& F, int b, int h, int li) {
    const int w = F.wave, lane = F.lane, ri = lane >> 3, cj = lane & 7, irow = 8 * w + ri;
    LAS float* chb = (LAS float*)(F.lds + RING_OFF); LAS float* yb = (LAS float*)(F.lds + RING_OFF + SCN_Y);
    const float* SC = WSP(float, WS_SC);
    float s[8];
#pragma unroll
    for (int j = 0; j < 8; ++j) s[j] = 0.f;
    f32x4 pre[6];
#pragma unroll
    for (int k = 0; k < 6; ++k) pre[k] = *scan_src(SC, b, h, 0, F.tid, k);
#pragma unroll
    for (int k = 0; k < 6; ++k) ((LAS f32x4*)chb)[F.tid + NTHREADS * k] = pre[k];
    __syncthreads();
    constexpr int NCH = SEQ / SCN_STEPS;
    for (int cix = 0; cix < NCH; ++cix) {
        const LAS float* ch = chb + (cix & 1) * (SCN_CH / 4);
        if (cix + 1 < NCH) {
#pragma unroll
            for (int k = 0; k < 6; ++k) pre[k] = *scan_src(SC, b, h, (cix + 1) * SCN_STEPS, F.tid, k);
        }
        for (int st = 0; st < SCN_STEPS; ++st) {
            const LAS float* c = ch + st * 384 + cj * 8;
            const f32x4 w0 = *(const LAS f32x4*)(c), w1 = *(const LAS f32x4*)(c + 4);
            const f32x4 k0 = *(const LAS f32x4*)(c + 64), k1 = *(const LAS f32x4*)(c + 68);
            const f32x4 b0 = *(const LAS f32x4*)(c + 128), b1 = *(const LAS f32x4*)(c + 132);
            const f32x4 m0 = *(const LAS f32x4*)(c + 192), m1 = *(const LAS f32x4*)(c + 196);
            const f32x4 r0 = *(const LAS f32x4*)(c + 256), r1 = *(const LAS f32x4*)(c + 260);
            const float v = ch[st * 384 + 320 + irow];
            float sa = (s[0] * k0.x + s[1] * k0.y) + (s[2] * k0.z + s[3] * k0.w) + (s[4] * k1.x + s[5] * k1.y) + (s[6] * k1.z + s[7] * k1.w);
            sa = -sum8(sa);
            s[0] = s[0] * w0.x + sa * b0.x + v * m0.x; s[1] = s[1] * w0.y + sa * b0.y + v * m0.y; s[2] = s[2] * w0.z + sa * b0.z + v * m0.z; s[3] = s[3] * w0.w + sa * b0.w + v * m0.w;
            s[4] = s[4] * w1.x + sa * b1.x + v * m1.x; s[5] = s[5] * w1.y + sa * b1.y + v * m1.y; s[6] = s[6] * w1.z + sa * b1.z + v * m1.z; s[7] = s[7] * w1.w + sa * b1.w + v * m1.w;
            float y = (s[0] * r0.x + s[1] * r0.y) + (s[2] * r0.z + s[3] * r0.w) + (s[4] * r1.x + s[5] * r1.y) + (s[6] * r1.z + s[7] * r1.w);
            y = sum8(y);
            if (cj == 0) yb[st * 64 + irow] = y;
        }
        __syncthreads();
        scan_post(F, ch, yb, b * SEQ + cix * SCN_STEPS, h, li, SCN_STEPS);
        if (cix + 1 < NCH) {
#pragma unroll
            for (int k = 0; k < 6; ++k) ((LAS f32x4*)(chb + ((cix + 1) & 1) * (SCN_CH / 4)))[F.tid + NTHREADS * k] = pre[k];
        }
        __syncthreads();
    }
    float* so = OUTF + O_WKVP + ((size_t)((b * 2 + li) * 8 + h) * 64 + irow) * 64 + cj * 8;
    *(f32x4*)so = (f32x4){s[0], s[1], s[2], s[3]}; *(f32x4*)(so + 4) = (f32x4){s[4], s[5], s[6], s[7]};
}
DI void scan_sample_unit(Frame& F, int b, int li) {
    const int h = F.wave, lane = F.lane;
    LAS float* ch = (LAS float*)(F.lds + RING_OFF) + h * (DT * 384);
    LAS float* yb = (LAS float*)(F.lds + RING_OFF + 8 * DT * 384 * 4) + h * (DT * 64);
    const float* SC = WSP(float, WS_SC);
    for (int k = 0; k < DT * 96 / 64; ++k) { const int q = lane + 64 * k; const int tk = q / 96, pc = q % 96;
        ((LAS f32x4*)ch)[q] = ((const f32x4*)(SC + ((size_t)(MP + b * DT + tk) * 8 + h) * 384))[pc]; }
    float s[64];
    const float* s0 = KIN(I_SWKV) + ((size_t)((b * 2 + li) * 8 + h) * 64 + lane) * 64;
#pragma unroll
    for (int j = 0; j < 16; ++j) { const f32x4 x = ((const f32x4*)s0)[j]; s[4 * j] = x.x; s[4 * j + 1] = x.y; s[4 * j + 2] = x.z; s[4 * j + 3] = x.w; }
    LDS_WAIT(); asm volatile("" ::: "memory");
    for (int st = 0; st < DT; ++st) {
        const LAS float* c = ch + st * 384;
        float sa = 0.f;
#pragma unroll
        for (int j = 0; j < 64; ++j) sa += s[j] * c[64 + j];
        sa = -sa;
        const float v = c[320 + lane];
        float y = 0.f;
#pragma unroll
        for (int j = 0; j < 64; ++j) { s[j] = s[j] * c[j] + sa * c[128 + j] + v * c[192 + j]; y += s[j] * c[256 + j]; }
        yb[st * 64 + lane] = y;
    }
    float* so = OUTF + O_WKVS + ((size_t)((b * 2 + li) * 8 + h) * 64 + lane) * 64;
#pragma unroll
    for (int j = 0; j < 16; ++j) ((f32x4*)so)[j] = (f32x4){s[4 * j], s[4 * j + 1], s[4 * j + 2], s[4 * j + 3]};
    LDS_WAIT(); asm volatile("" ::: "memory");
#pragma unroll
    for (int ps = 0; ps < 2; ++ps) {
        const int tok = ps * 4 + (lane >> 4), i0 = (lane & 15) * 4;
        const LAS float* c = ch + tok * 384;
        const f32x4 y = *(const LAS f32x4*)(yb + tok * 64 + i0);
        const float mu = sum16((y.x + y.y) + (y.z + y.w)) * (1.f / 64.f);
        const f32x4 dv = y - mu;
        const float var = sum16((dv.x * dv.x + dv.y * dv.y) + (dv.z * dv.z + dv.w * dv.w)) * (1.f / 64.f);
        const float rs = 1.0f / sqrtf(var + GN_EPS);
        const f32x4 r = *(const LAS f32x4*)(c + 4 * 64 + i0), km = *(const LAS f32x4*)(c + 3 * 64 + i0), v = *(const LAS f32x4*)(c + 5 * 64 + i0);
        const f32x4 rk = *(const f32x4*)(KIN(I_RK) + (size_t)(li * 8 + h) * 64 + i0);
        const float bon = sum16((r.x * km.x * rk.x + r.y * km.y * rk.y) + (r.z * km.z * rk.z + r.w * km.w * rk.w));
        const f32x4 lw = *(const f32x4*)(KIN(I_LNW) + (size_t)li * 512 + h * 64 + i0), lb = *(const f32x4*)(KIN(I_LNB) + (size_t)li * 512 + h * 64 + i0);
        const int row = MP + b * DT + tok;
        const f32x4 gg = *(const f32x4*)(WSP(float, WS_G) + (size_t)row * 512 + h * 64 + i0);
        const f32x4 o = (dv * rs * lw + lb + v * bon) * gg;
        v2u pk; pk.x = pk2(o.x, o.y); pk.y = pk2(o.z, o.w);
        *(v2u*)(WSP(bf16, WS_MIX) + (size_t)row * DM + 512 + h * 64 + i0) = pk;
    }
    __syncthreads();
}

extern __shared__ __attribute__((aligned(16))) unsigned char g_lds[];
DI int take_ticket(Frame& F, int word) {
    volatile LAS unsigned* tk = F.MISC + 16;
    __syncthreads();
    if (F.tid == 0) tk[0] = __hip_atomic_fetch_add((unsigned*)(F.ctl + word), 1u, RLX_AGENT);
    __syncthreads();
    return __builtin_amdgcn_readfirstlane((int)tk[0]);
}
DI void mix_even_phase(Frame& F, int li) {
    const int qw = CW_QUEUE + 256 * li;
    for (;;) { const int u = take_ticket(F, qw); if (u >= 64) break; LAUNDER(F); scan_prompt_unit(F, u >> 3, u & 7, li); }
    for (;;) { const int u = take_ticket(F, qw + 64); if (u >= DB) break; LAUNDER(F); scan_sample_unit(F, u, li); }
    for (;;) { const int u = take_ticket(F, qw + 128); if (u >= 512) break; LAUNDER(F); const int p = u >> 1, bg = p >> 4, cp = p & 15;
        attn_prompt_unit(F, bg >> 1, bg & 1, (u & 1) ? cp : 31 - cp, li); }
    for (;;) { const int u = take_ticket(F, qw + 192); if (u >= 2 * DB) break; LAUNDER(F); attn_sample_unit(F, u >> 1, u & 1, li); }
}

struct EpiStoreBf16 {
    static constexpr bool PERM = true, AFTER_DRAIN = false;
    bf16* O; int ldc;
    DI void operator()(const f32x4 (&acc)[2][2][4][2], const pg8::Unit& u, int wr, int wc, int fr, int fq) const {
        const int row0 = u.pm * 256 + wr * 64 + fr, col0 = u.pn * 256 + wc * 32 + 8 * fq;
#pragma unroll
        for (int ai = 0; ai < 2; ++ai)
#pragma unroll
            for (int m = 0; m < 4; ++m) { bf16* rowp = O + (size_t)(row0 + ai * 128 + m * 16) * ldc + col0;
#pragma unroll
                for (int bj = 0; bj < 2; ++bj) { const f32x4 v0 = acc[ai][bj][m][0], v1 = acc[ai][bj][m][1];
                    v4u w; w.x = pk2(v0[0], v0[1]); w.y = pk2(v0[2], v0[3]); w.z = pk2(v1[0], v1[1]); w.w = pk2(v1[2], v1[3]);
                    *(v4u*)(rowp + bj * 128) = w; } }
    }
};
struct EpiPart {
    static constexpr bool PERM = false, AFTER_DRAIN = false;
    float* C;
    DI void operator()(const f32x4 (&acc)[2][2][4][2], const pg8::Unit& u, int wr, int wc, int fr, int fq) const {
        const int row0 = u.pm * 256 + wr * 64 + fr, col0 = wc * 32 + 4 * fq;
#pragma unroll
        for (int ai = 0; ai < 2; ++ai)
#pragma unroll
            for (int m = 0; m < 4; ++m) { float* rowp = C + (size_t)(row0 + ai * 128 + m * 16) * 256 + col0;
#pragma unroll
                for (int bj = 0; bj < 2; ++bj)
#pragma unroll
                    for (int n = 0; n < 2; ++n) *(f32x4*)(rowp + bj * 128 + n * 16) = acc[ai][bj][m][n]; }
    }
};
struct EpiResid {
    static constexpr bool PERM = false, AFTER_DRAIN = false;
    const float* baseP; const float* baseS; float* X;
    DI void operator()(const f32x4 (&acc)[2][2][4][2], const pg8::Unit& u, int wr, int wc, int fr, int fq) const {
        const int row0 = u.pm * 256 + wr * 64 + fr, col0 = u.pn * 256 + wc * 32 + 4 * fq;
        const float* base = (u.pm < MP / 256) ? baseP : baseS - (size_t)MP * DM;
#pragma unroll
        for (int ai = 0; ai < 2; ++ai)
#pragma unroll
            for (int m = 0; m < 4; ++m) { const size_t off = (size_t)(row0 + ai * 128 + m * 16) * DM + col0;
#pragma unroll
                for (int bj = 0; bj < 2; ++bj)
#pragma unroll
                    for (int n = 0; n < 2; ++n) { const f32x4 bs = *(const f32x4*)(base + off + bj * 128 + n * 16); *(f32x4*)(X + off + bj * 128 + n * 16) = bs + acc[ai][bj][m][n]; } }
    }
};
struct EpiLora {
    static constexpr bool PERM = false, AFTER_DRAIN = false;
    float* SC; float* G; const float *w0, *a0, *ka;
    DI void operator()(const f32x4 (&acc)[2][2][4][2], const pg8::Unit& u, int wr, int wc, int fr, int fq) const {
        const int row0 = u.pm * 256 + wr * 64 + fr, seg = u.pn >> 1, cb = (u.pn & 1) * 256 + wc * 32 + 4 * fq;
#pragma unroll
        for (int bj = 0; bj < 2; ++bj)
#pragma unroll
            for (int n = 0; n < 2; ++n) {
                const int colh = cb + bj * 128 + n * 16, h = colh >> 6, d = colh & 63;
                f32x4 c0 = (f32x4){0.f, 0.f, 0.f, 0.f}, c1 = c0;
                if (seg == 0) c0 = *(const f32x4*)(w0 + colh); else if (seg == 1) { c0 = *(const f32x4*)(a0 + colh); c1 = *(const f32x4*)(ka + colh); }
#pragma unroll
                for (int ai = 0; ai < 2; ++ai)
#pragma unroll
                    for (int m = 0; m < 4; ++m) { const int row = row0 + ai * 128 + m * 16; const f32x4 a = acc[ai][bj][m][n];
                        float* scb = SC + ((size_t)row * 8 + h) * 384 + d;
                        if (seg == 0) { f32x4 o;
#pragma unroll
                            for (int i = 0; i < 4; ++i) { const float y = -(c0[i] + a[i]); const float sp = fmaxf(y, 0.f) + __logf(1.0f + __expf(-fabsf(y))); o[i] = __expf(-__expf(-sp - 0.5f)); }
                            *(f32x4*)(scb) = o; }
                        else if (seg == 1) { const f32x4 k = *(const f32x4*)(scb + 3 * 64), kk = *(const f32x4*)(scb + 1 * 64); f32x4 km, bb;
#pragma unroll
                            for (int i = 0; i < 4; ++i) { const float av = sigmoidf_(c0[i] + a[i]); km[i] = k[i] * (1.0f + (av - 1.0f) * c1[i]); bb[i] = kk[i] * av; }
                            *(f32x4*)(scb + 3 * 64) = km; *(f32x4*)(scb + 2 * 64) = bb; }
                        else *(f32x4*)(G + (size_t)row * 512 + colh) = a;
                        if (m & 1) asm volatile("" ::: "memory");
                    }
            }
    }
};
struct CmpOrder {
    int G, c;
    DI bool next(int i, pg8::Unit& u) const { const int L = i * G + c; if (L >= CS_ROWS / 256) return false; u.pm = L; u.pn = (L < 128) ? 0 : (L < 256 ? 1 : (L < 264 ? 0 : 1)); return true; }
    DI void a_ready(const pg8::Unit&) const {}
    DI void done(const pg8::Unit&) const {}
};

#ifndef MK_PER_PHASE
#define MK_PER_PHASE 0
#endif
constexpr int PH_PER_LAYER = 11, N_PHASES = 1 + DEPTH * PH_PER_LAYER;
__global__ void __launch_bounds__(NTHREADS, 2) mk_fwd(Args args) {
    Frame F;
    F.lds = (LAS unsigned char*)g_lds;
    F.MISC = (volatile LAS unsigned*)(F.lds + MISC_OFF);
    F.tid = threadIdx.x; F.lane = F.tid & 63; F.wave = __builtin_amdgcn_readfirstlane(F.tid >> 6);
    F.G = gridDim.x; F.bid = blockIdx.x;
    F.out = (GAS float*)args.out; F.ws = (GAS unsigned char*)args.ws; F.ctl = (gu32*)(args.ws + WS_CTL); F.ka = (unsigned long long)__builtin_amdgcn_kernarg_segment_ptr();
    for (int u = F.tid; u < (LDS_BYTES - LDSCTL_OFF) / 4; u += NTHREADS) ((LAS unsigned*)(F.lds + LDSCTL_OFF))[u] = 0u;
    __syncthreads();
    XcdBarrier bar; bar.bar = (unsigned*)(F.ctl + CW_BAR); bar.x = 0; bar.st = nullptr;
    if (!MK_PER_PHASE) bar = xcd_barrier_post((unsigned*)(F.ctl + CW_BAR), F.MISC + 8);
    const int lo = args.ph_lo, hi = args.ph_hi;
#define IN(k) (lo <= (k) && (k) < hi)
#define SEAM(k) do { if (IN((k) + 1)) { if (MK_PER_PHASE) { if (F.tid == 0) __hip_atomic_store(F.ctl + CW_TMO, 0xBADBA0u, RLX_AGENT); } else { asm volatile("" : "+s"(bar.bar)); asm volatile("" : "+s"(bar.x)); xcd_barrier(bar); } } } while (0)
    LAS unsigned char* ring = F.lds + RING_OFF;

    if (IN(0)) { LAUNDER(F); p0_prologue(F); SEAM(0); }

    for (int l = 0; l < DEPTH; ++l) {
        const int li = l >> 1; const bool even = (l & 1) == 0; const int pb = 1 + l * PH_PER_LAYER;
        if (IN(pb + 0)) { LAUNDER(F);
            const int N = even ? NE : NO;
            pg8::Gemm g{WSP(bf16, WS_XN), even ? WSP(bf16, WS_WIE) + (size_t)li * NE * DM : WSP(bf16, WS_WIO) + (size_t)li * NO * DM, MT, N, DM};
            pg8::StaticOrder S; S.init(MT, N, F.G, F.bid);
            EpiStoreBf16 E{WSP(bf16, WS_ZB), N};
            pg8::gemm_phase<EpiStoreBf16, pg8::StaticOrder, true, true>(ring, g, S, E);
            SEAM(pb + 0);
        }
        if (IN(pb + 1)) { LAUNDER(F); if (even) post_even_phase(F, li); else odd_mix_phase(F, li); SEAM(pb + 1); }
        if (even) {
            if (IN(pb + 2)) { LAUNDER(F);
                { pg8::Gemm g{WSP(bf16, WS_CSEG), WSP(bf16, WS_PHI1) + (size_t)li * 512 * 1024, CS_ROWS, 512, 1024};
                  CmpOrder S{F.G, F.bid}; EpiPart E{WSP(float, WS_PART)};
                  pg8::gemm_phase<EpiPart, CmpOrder, true, true>(ring, g, S, E); }
                __syncthreads(); LAUNDER(F);
                { int kdim = KLORA; asm volatile("" : "+s"(kdim));
                  pg8::Gemm g{WSP(bf16, WS_LA), WSP(bf16, WS_LORA) + (size_t)li * NLORA * KLORA, MT, NLORA, kdim};
                  pg8::StaticOrder S; S.init(MT, NLORA, F.G, (F.bid + 104) % F.G);
                  EpiLora E{WSP(float, WS_SC), WSP(float, WS_G), KIN(I_W0) + li * 512, KIN(I_A0) + li * 512, KIN(I_KA) + li * 512};
                  pg8::gemm_phase<EpiLora, pg8::StaticOrder, true, true>(ring, g, S, E); }
                SEAM(pb + 2);
            }
            if (IN(pb + 3)) { LAUNDER(F); compress2_phase(F, li); SEAM(pb + 3); }
            if (IN(pb + 4)) { LAUNDER(F); mix_even_phase(F, li); SEAM(pb + 4); }
        }
        if (IN(pb + 5)) { LAUNDER(F);
            pg8::Gemm g{WSP(bf16, WS_MIX), even ? WSP(bf16, WS_WOE) + (size_t)li * DM * DM : WSP(bf16, WS_WOO) + (size_t)li * DM * DM, MT, DM, DM};
            pg8::StaticOrder S; S.init(MT, DM, F.G, F.bid);
            EpiResid E{l == 0 ? KIN(I_XP) : OUTF, l == 0 ? KIN(I_XS) : OUTF + (size_t)MP * DM, OUTF};
            pg8::gemm_phase<EpiResid, pg8::StaticOrder, true, true>(ring, g, S, E);
            SEAM(pb + 5);
        }
        if (IN(pb + 6)) { LAUNDER(F); norm_phase(F, KIN(I_NFFN) + l * DM); SEAM(pb + 6); }
        if (IN(pb + 7)) { LAUNDER(F);
            pg8::Gemm g{WSP(bf16, WS_XN), WSP(bf16, WS_WUP) + (size_t)l * NUP * DM, MT, NUP, DM};
            pg8::StaticOrder S; S.init(MT, NUP, F.G, F.bid);
            EpiStoreBf16 E{WSP(bf16, WS_ZB), NUP};
            pg8::gemm_phase<EpiStoreBf16, pg8::StaticOrder, true, true>(ring, g, S, E);
            SEAM(pb + 7);
        }
        if (IN(pb + 8)) { LAUNDER(F); ffn_act_phase(F, l); SEAM(pb + 8); }
        if (IN(pb + 9)) { LAUNDER(F);
            pg8::Gemm g{WSP(bf16, WS_H), WSP(bf16, WS_WDN) + (size_t)l * DM * DFF, MT, DM, DFF};
            pg8::StaticOrder S; S.init(MT, DM, F.G, F.bid);
            EpiResid E{OUTF, OUTF + (size_t)MP * DM, OUTF};
            pg8::gemm_phase<EpiResid, pg8::StaticOrder, true, true>(ring, g, S, E);
            if (l + 1 < DEPTH) SEAM(pb + 9);
        }
        if (IN(pb + 10) && l + 1 < DEPTH) { LAUNDER(F); norm_phase(F, KIN(I_NMIX) + (l + 1) * DM); SEAM(pb + 10); }
    }
#undef IN
#undef SEAM
}

extern "C" void kernel_launch(void* const* d_in, const int* in_sizes, int n_in, void* d_out, int out_size, void* d_ws, size_t ws_size, hipStream_t stream) {
    static int grid = 0;
    if (grid == 0) {
        if (n_in != N_IN || (size_t)out_size != O_END || ws_size < WS_END) { fprintf(stderr, "kernel_launch: unexpected shapes: n_in %d out %d ws %zu (need %zu)\n", n_in, out_size, ws_size, (size_t)WS_END); grid = -1; return; }
        int dev = 0, cus = 0, per_cu = 0;
        if (hipGetDevice(&dev) != hipSuccess || hipDeviceGetAttribute(&cus, hipDeviceAttributeMultiprocessorCount, dev) != hipSuccess) { grid = -1; return; }
        if (hipFuncSetAttribute((const void*)mk_fwd, hipFuncAttributeMaxDynamicSharedMemorySize, LDS_BYTES) != hipSuccess) { fprintf(stderr, "kernel_launch: hipFuncSetAttribute failed\n"); grid = -1; return; }
        if (hipOccupancyMaxActiveBlocksPerMultiprocessor(&per_cu, (const void*)mk_fwd, NTHREADS, LDS_BYTES) != hipSuccess || per_cu < 1) { fprintf(stderr, "kernel_launch: occupancy query says %d\n", per_cu); }
        (void)hipGetLastError();
        grid = cus;
    }
    if (grid < 0) return;
    if (hipMemsetAsync((char*)d_ws + WS_CTL, 0, CTL_ZERO_BYTES, stream) != hipSuccess) return;
    Args a{};
    for (int i = 0; i < N_IN; ++i) a.in[i] = (const float*)d_in[i];
    a.out = (float*)d_out; a.ws = (unsigned char*)d_ws;
#if MK_PER_PHASE
    for (int p = 0; p < N_PHASES; ++p) {
        if (p > 0) { const int l = (p - 1) / PH_PER_LAYER, q = (p - 1) % PH_PER_LAYER; if ((l & 1) && q >= 2 && q <= 4) continue; if (l == DEPTH - 1 && q == 10) continue; }
        a.ph_lo = p; a.ph_hi = p + 1;
        hipLaunchKernelGGL(mk_fwd, dim3(grid), dim3(NTHREADS), LDS_BYTES, stream, a);
    }
#else
    a.ph_lo = 0; a.ph_hi = N_PHASES;
    hipLaunchKernelGGL(mk_fwd, dim3(grid), dim3(NTHREADS), LDS_BYTES, stream, a);
#endif
    const hipError_t le = hipPeekAtLastError();
    if (le != hipSuccess) fprintf(stderr, "kernel_launch: launch failed: %s\n", hipGetErrorName(le));
}
```

```cpp
#include <hip/hip_runtime.h>
#include <cstdio>
#include <cstdint>

namespace pg8 {
#define PG8_LAS __attribute__((address_space(3)))
typedef unsigned short bf16_t;
typedef short bf16x8 __attribute__((ext_vector_type(8)));
typedef float f32x4 __attribute__((ext_vector_type(4)));
typedef unsigned u32x4 __attribute__((ext_vector_type(4)));
constexpr int BM = 256, BK = 64, HALF = 128, HTB = HALF * BK * 2  , STAGE_BYTES = 8 * HTB, NXCD = 8, WGM = 8;

__host__ __device__ __forceinline__ int lds_byte(int r, int c) { const int st = (r >> 4) * 2 + (c >> 5), rr = r & 15, cc = c & 31, ob = rr * 64 + cc * 2; return st * 1024 + (ob ^ (((ob >> 9) & 1) << 5)); }
__host__ __device__ __forceinline__ void stage_rc(int b, int& R, int& C) { const int st = b / 1024, sb = b % 1024, swz = sb ^ (((sb >> 9) & 1) << 5); R = (st >> 1) * 16 + swz / 64; C = (st & 1) * 32 + (swz % 64) / 2; }
__host__ __device__ __forceinline__ int perm32(int rho) { const int n = rho >> 4, i = rho & 15; return 8 * (i >> 2) + 4 * n + (i & 3); }

struct Unit { int pm, pn; };
struct Gemm { const bf16_t* A; const bf16_t* Bt; int M, N, K; };

struct StaticOrder {
    int nM, nN, nwg, G, c;
    __host__ __device__ void init(int M, int N, int G_, int c_) { nM = M / BM; nN = N / BM; nwg = nM * nN; G = G_; c = c_; }
    __host__ __device__ bool next(int i, Unit& u) const {
        const long L = (long)i * G + c; if (L >= nwg) return false;
        int wgid = (int)L; { const int q = nwg / NXCD, r = nwg % NXCD, xcd = wgid % NXCD, off = wgid / NXCD; wgid = (xcd < r ? xcd * (q + 1) : r * (q + 1) + (xcd - r) * q) + off; }
        const int nig = WGM * nN, gid = wgid / nig, fm = gid * WGM, gsz = (nM - fm) < WGM ? (nM - fm) : WGM;
        u.pm = fm + ((wgid % nig) % gsz); u.pn = (wgid % nig) / gsz; return true;
    }
    __device__ __forceinline__ void a_ready(const Unit&) const {}
    __device__ __forceinline__ void done(const Unit&) const {}
};

__device__ __forceinline__ unsigned cvt_pk_bf16(float lo, float hi) { unsigned r; asm volatile("v_cvt_pk_bf16_f32 %0, %1, %2" : "=v"(r) : "v"(lo), "v"(hi)); return r; }
template <class Epi, class Sched, bool ALIGN_EPI = false, bool SP2 = false>
__device__ __forceinline__ void gemm_phase(PG8_LAS unsigned char* lds, const Gemm g, const Sched& S, const Epi& E) {
    int tid_ = threadIdx.x; asm volatile("" : "+v"(tid_));
    const int tid = tid_, wid = __builtin_amdgcn_readfirstlane(tid >> 6), lane = tid & 63, wr = wid >> 2, wc = wid & 3, fr = lane & 15, fq = lane >> 4;
    const int K = g.K, nt = K / BK;
    unsigned voffA[2], voffB[2];
#pragma unroll
    for (int i = 0; i < 2; ++i) { int R, C; stage_rc(tid * 16 + i * 8192, R, C); const int Rb = Epi::PERM ? ((R & ~31) + perm32(R & 31)) : R;
        voffA[i] = (unsigned)(R * K + C) * 2u; voffB[i] = (unsigned)(Rb * K + C) * 2u; }
    const size_t kstep = (size_t)(BK * 2);
    const size_t hstep = (size_t)HALF * K * 2;
    const size_t tstep = 2 * hstep;
    const unsigned ldsw = (unsigned)wid * 1024u;
    const int aoff = lds_byte(wr * 64 + fr, fq * 8), boff = lds_byte(wc * 32 + fr, fq * 8);
#define PG8_SA(b, h) (((b) * 2 + (h)) * HTB)
#define PG8_SB(b, h) ((4 + (b) * 2 + (h)) * HTB)
#define PG8_STAGE(bufoff, gbase, voff) do { _Pragma("unroll") for (int _i = 0; _i < 2; ++_i) \
        __builtin_amdgcn_global_load_lds((const unsigned*)((const char*)(gbase) + (voff)[_i]), (PG8_LAS unsigned*)(lds + (bufoff) + ldsw + _i * 8192), 16, 0, 0); } while (0)
#define PG8_LDA(dst, b, h) do { _Pragma("unroll") for (int m = 0; m < 4; ++m) _Pragma("unroll") for (int k = 0; k < 2; ++k) dst[m][k] = *(const PG8_LAS bf16x8*)(lds + PG8_SA(b, h) + aoff + m * 2048 + k * 1024); } while (0)
#define PG8_LDB(dst, b, h) do { _Pragma("unroll") for (int n = 0; n < 2; ++n) _Pragma("unroll") for (int k = 0; k < 2; ++k) dst[n][k] = *(const PG8_LAS bf16x8*)(lds + PG8_SB(b, h) + boff + n * 2048 + k * 1024); } while (0)
#define PG8_MMA(ai, bj, At, Bt) do { __builtin_amdgcn_s_setprio(1); _Pragma("unroll") for (int m = 0; m < 4; ++m) _Pragma("unroll") for (int n = 0; n < 2; ++n) _Pragma("unroll") for (int k = 0; k < 2; ++k) \
        acc[ai][bj][m][n] = __builtin_amdgcn_mfma_f32_16x16x32_bf16(Bt[n][k], At[m][k], acc[ai][bj][m][n], 0, 0, 0); __builtin_amdgcn_s_setprio(0); } while (0)
#define PG8_WAIT_V(n) asm volatile("s_waitcnt vmcnt(" #n ")" ::: "memory")
#define PG8_WAIT_L(n) asm volatile("s_waitcnt lgkmcnt(" #n ")" ::: "memory")
#define PG8_BAR __builtin_amdgcn_s_barrier()
#define PG8_SCHED __builtin_amdgcn_sched_barrier(0)
    Unit cur, nxt; int ui = 0;
    if (!S.next(0, cur)) return;
    f32x4 acc[2][2][4][2];
#pragma unroll
    for (int a = 0; a < 2; ++a)
#pragma unroll
        for (int b = 0; b < 2; ++b)
#pragma unroll
            for (int m = 0; m < 4; ++m)
#pragma unroll
                for (int n = 0; n < 2; ++n) acc[a][b][m][n] = (f32x4){0.f, 0.f, 0.f, 0.f};
    bf16x8 At[4][2], B0[2][2], B1[2][2];
    const char* cA = (const char*)g.A + (size_t)cur.pm * tstep; const char* cB = (const char*)g.Bt + (size_t)cur.pn * tstep;
    S.a_ready(cur);
    if constexpr (SP2) {
        PG8_STAGE(PG8_SB(0, 0), cB, voffB); PG8_STAGE(PG8_SB(0, 1), cB + hstep, voffB); PG8_STAGE(PG8_SA(0, 0), cA, voffA); PG8_STAGE(PG8_SA(0, 1), cA + hstep, voffA);
        if (wr == 1) PG8_BAR;
        PG8_WAIT_V(2); PG8_BAR;
        PG8_STAGE(PG8_SB(1, 0), cB + kstep, voffB); PG8_STAGE(PG8_SA(1, 0), cA + kstep, voffA); PG8_STAGE(PG8_SB(1, 1), cB + hstep + kstep, voffB);
        PG8_WAIT_V(6); PG8_BAR;
    } else {
        PG8_STAGE(PG8_SB(0, 0), cB, voffB); PG8_STAGE(PG8_SA(0, 0), cA, voffA); PG8_STAGE(PG8_SB(0, 1), cB + hstep, voffB); PG8_STAGE(PG8_SA(0, 1), cA + hstep, voffA);
        if (wr == 1) PG8_BAR;
        PG8_WAIT_V(4); PG8_BAR;
        PG8_STAGE(PG8_SB(1, 0), cB + kstep, voffB); PG8_STAGE(PG8_SA(1, 0), cA + kstep, voffA); PG8_STAGE(PG8_SB(1, 1), cB + hstep + kstep, voffB);
        PG8_WAIT_V(6); PG8_BAR;
    }
    for (;;) {
        const bool has_next = S.next(ui + 1, nxt);
        const char* nA = has_next ? (const char*)g.A + (size_t)nxt.pm * tstep : cA; const char* nB = has_next ? (const char*)g.Bt + (size_t)nxt.pn * tstep : cB;
        for (int t = 0; t < nt; t += 2) {
            const bool last = (t == nt - 2);
            const char* a1 = cA + (size_t)(t + 1) * kstep;
            const char* a2 = last ? nA : cA + (size_t)(t + 2) * kstep; const char* b2 = last ? nB : cB + (size_t)(t + 2) * kstep;
            const char* a3 = a2 + kstep; const char* b3 = b2 + kstep;
            if (last && has_next) S.a_ready(nxt);
            if constexpr (SP2) {
            PG8_LDB(B0, 0, 0); PG8_LDB(B1, 0, 1); PG8_SCHED; PG8_LDA(At, 0, 0); PG8_STAGE(PG8_SA(1, 1), a1 + hstep, voffA);
            PG8_WAIT_V(8); PG8_WAIT_L(0); PG8_BAR; PG8_MMA(0, 0, At, B0); PG8_MMA(0, 1, At, B1); PG8_BAR; PG8_SCHED;
            PG8_LDA(At, 0, 1); PG8_STAGE(PG8_SB(0, 0), b2, voffB); PG8_STAGE(PG8_SB(0, 1), b2 + hstep, voffB); PG8_STAGE(PG8_SA(0, 0), a2, voffA);
            PG8_WAIT_V(8); PG8_WAIT_L(0); PG8_BAR; PG8_MMA(1, 0, At, B0); PG8_MMA(1, 1, At, B1); PG8_BAR; PG8_SCHED;
            PG8_LDB(B0, 1, 0); PG8_LDB(B1, 1, 1); PG8_SCHED; PG8_LDA(At, 1, 0); PG8_STAGE(PG8_SA(0, 1), a2 + hstep, voffA);
            PG8_WAIT_V(8); PG8_WAIT_L(0); PG8_BAR; PG8_MMA(0, 0, At, B0); PG8_MMA(0, 1, At, B1); PG8_BAR; PG8_SCHED;
            PG8_LDA(At, 1, 1); PG8_STAGE(PG8_SB(1, 0), b3, voffB); PG8_STAGE(PG8_SB(1, 1), b3 + hstep, voffB); PG8_STAGE(PG8_SA(1, 0), a3, voffA);
            PG8_WAIT_V(8); PG8_WAIT_L(0); PG8_BAR; PG8_MMA(1, 0, At, B0); PG8_MMA(1, 1, At, B1); PG8_BAR; PG8_SCHED;
            } else {
            PG8_LDB(B0, 0, 0); PG8_SCHED; PG8_LDA(At, 0, 0); PG8_STAGE(PG8_SA(1, 1), a1 + hstep, voffA);
            PG8_WAIT_L(8); PG8_BAR; PG8_WAIT_L(0); PG8_MMA(0, 0, At, B0); PG8_BAR; PG8_SCHED;
            PG8_LDB(B1, 0, 1); PG8_STAGE(PG8_SB(0, 0), b2, voffB);
            PG8_BAR; PG8_WAIT_L(0); PG8_MMA(0, 1, At, B1); PG8_BAR;
            PG8_LDA(At, 0, 1); PG8_STAGE(PG8_SA(0, 0), a2, voffA);
            PG8_BAR; PG8_WAIT_L(0); PG8_MMA(1, 0, At, B0); PG8_BAR; PG8_SCHED;
            PG8_STAGE(PG8_SB(0, 1), b2 + hstep, voffB);
            PG8_WAIT_V(6); PG8_BAR; PG8_MMA(1, 1, At, B1); PG8_BAR;
            PG8_LDB(B0, 1, 0); PG8_SCHED; PG8_LDA(At, 1, 0); PG8_STAGE(PG8_SA(0, 1), a2 + hstep, voffA);
            PG8_WAIT_L(8); PG8_BAR; PG8_WAIT_L(0); PG8_MMA(0, 0, At, B0); PG8_BAR; PG8_SCHED;
            PG8_LDB(B1, 1, 1); PG8_STAGE(PG8_SB(1, 0), b3, voffB);
            PG8_BAR; PG8_WAIT_L(0); PG8_MMA(0, 1, At, B1); PG8_BAR;
            PG8_LDA(At, 1, 1); PG8_STAGE(PG8_SA(1, 0), a3, voffA);
            PG8_BAR; PG8_WAIT_L(0); PG8_MMA(1, 0, At, B0); PG8_BAR; PG8_SCHED;
            PG8_STAGE(PG8_SB(1, 1), b3 + hstep, voffB);
            PG8_WAIT_V(6); PG8_BAR; PG8_MMA(1, 1, At, B1); PG8_BAR;
            }
        }
        if constexpr (ALIGN_EPI) { if (wr == 0) PG8_BAR; }
#if defined(PROBE_ID) && (PROBE_ID >= 16 && PROBE_ID <= 20)
        unsigned long long pt0_ = 0; if (PROBE_ID == Epi::PID) { __builtin_amdgcn_s_barrier(); pt0_ = __builtin_amdgcn_s_memrealtime(); }
#endif
        if constexpr (!Epi::AFTER_DRAIN) { E(acc, cur, wr, wc, fr, fq); S.done(cur); }
#if defined(PROBE_ID) && (PROBE_ID >= 16 && PROBE_ID <= 20)
        if (PROBE_ID == Epi::PID) { asm volatile("s_waitcnt vmcnt(0)" ::: "memory"); __builtin_amdgcn_s_barrier(); if (threadIdx.x == 0) ((volatile PG8_LAS unsigned*)(lds + 131072 + 320))[20] += (unsigned)(__builtin_amdgcn_s_memrealtime() - pt0_); }
#endif
        if (!has_next) break;
#pragma unroll
        for (int a = 0; a < 2; ++a)
#pragma unroll
            for (int b = 0; b < 2; ++b)
#pragma unroll
                for (int m = 0; m < 4; ++m)
#pragma unroll
                    for (int n = 0; n < 2; ++n) acc[a][b][m][n] = (f32x4){0.f, 0.f, 0.f, 0.f};
        cur = nxt; cA = nA; cB = nB; ++ui;
        if constexpr (ALIGN_EPI) { if (wr == 1) PG8_BAR; }
    }
    PG8_WAIT_V(0);
    if constexpr (!ALIGN_EPI) { if (wr == 0) PG8_BAR; }
    PG8_BAR;
    if constexpr (Epi::AFTER_DRAIN) { E.fused(acc, cur, wr, wc, fr, fq, lds, wid, lane); S.done(cur); }
#undef PG8_SA
#undef PG8_SB
#undef PG8_STAGE
#undef PG8_LDA
#undef PG8_LDB
#undef PG8_MMA
#undef PG8_WAIT_V
#undef PG8_WAIT_L
#undef PG8_BAR
#undef PG8_SCHED
}
}

constexpr int DM = 1024, NB = 8, SEQ = 2048, DEPTH = 4, DB = 128, DT = 8, PAST = 2048, PAGE = 128, NPAGE = 16, NPOOL = 2560;
constexpr int HD = 64, NCMP = 127, WIN = 512;
constexpr int MP = NB * SEQ, MS = DB * DT, MT = MP + MS;
constexpr int NE_ORIG = 3096, NE = 3328, RWP = 1792, NO = 3072, DFF = 2816, NUP = 2 * DFF;
constexpr int NLORA = 1536, KLORA = 256;
constexpr float RMS_EPS = 1e-6f, GN_EPS = 64e-5f, LOG2E = 1.4426950408889634f;
constexpr int NWAVES = 8, NTHREADS = 512;

enum { I_XP = 0, I_XS, I_CCMP, I_CSLC, I_CWIN, I_SWKV, I_SSHIFT, I_SCONV, I_SFFN, I_PT, I_NMIX, I_NFFN, I_RELB, I_WINE, I_WOUTE, I_QN, I_KN,
       I_PPE, I_PW1, I_PW2, I_MU, I_W0, I_W2, I_A0, I_A2, I_G2, I_KKW, I_KA, I_RK, I_LNW, I_LNB, I_WINO, I_CONVW, I_WOUTO, I_FUP, I_FCONV, I_FDOWN, N_IN };

constexpr size_t O_YP = 0, O_YS = O_YP + (size_t)MP * DM, O_CMPP = O_YS + (size_t)MS * DM, O_CMPS = O_CMPP + (size_t)NB * 2 * SEQ * 256,
    O_SLCP = O_CMPS + (size_t)DB * 2 * DT * 256, O_SLCS = O_SLCP + (size_t)NB * 2 * SEQ * 256, O_WINP = O_SLCS + (size_t)DB * 2 * DT * 256,
    O_WINS = O_WINP + (size_t)NB * 2 * WIN * 256, O_WKVP = O_WINS + (size_t)DB * 2 * WIN * 256, O_WKVS = O_WKVP + (size_t)NB * 2 * 8 * 4096,
    O_SHP = O_WKVS + (size_t)DB * 2 * 8 * 4096, O_SHS = O_SHP + (size_t)NB * 2 * RWP, O_CVP = O_SHS + (size_t)DB * 2 * RWP, O_CVS = O_CVP + (size_t)NB * 2 * 2 * DM,
    O_FFP = O_CVS + (size_t)DB * 2 * 2 * DM, O_FFS = O_FFP + (size_t)NB * 4 * 2 * DFF, O_END = O_FFS + (size_t)DB * 4 * 2 * DFF;

constexpr size_t al256(size_t x) { return (x + 255) & ~(size_t)255; }
constexpr size_t WS_CTL = 0, CTL_ZERO_BYTES = 1u << 20, CTL_RESERVED = 2u << 20;
constexpr size_t WS_WIE = CTL_RESERVED;
constexpr size_t WS_WOE = WS_WIE + (size_t)2 * NE * DM * 2;
constexpr size_t WS_WIO = WS_WOE + (size_t)2 * DM * DM * 2;
constexpr size_t WS_WOO = WS_WIO + (size_t)2 * NO * DM * 2;
constexpr size_t WS_WUP = WS_WOO + (size_t)2 * DM * DM * 2;
constexpr size_t WS_WDN = WS_WUP + (size_t)4 * NUP * DM * 2;
constexpr size_t WS_PHI1 = WS_WDN + (size_t)4 * DM * DFF * 2;
constexpr size_t WS_LORA = WS_PHI1 + (size_t)2 * 512 * 1024 * 2;
constexpr size_t WS_PEC = WS_LORA + (size_t)2 * NLORA * KLORA * 2;
constexpr size_t WS_XN = al256(WS_PEC + 4 * 128 * 4);
constexpr size_t WS_ZB = WS_XN + (size_t)MT * DM * 2;
constexpr size_t WS_QB = WS_ZB + (size_t)MT * NUP * 2;
constexpr size_t WS_CSEG = WS_QB + (size_t)MT * 512 * 2;
constexpr int CS_SK = 0, CS_SV = 32768, CS_PK = 65536, CS_PV = 67584, CS_ROWS = 69632;
constexpr size_t WS_PART = WS_CSEG + (size_t)CS_ROWS * 1024 * 2;
constexpr size_t WS_KC = WS_PART + (size_t)CS_ROWS * 256 * 4;
constexpr size_t WS_VCT = WS_KC + (size_t)272 * 128 * 64 * 2;
constexpr size_t WS_KS = WS_VCT + (size_t)272 * 128 * 64 * 2;
constexpr size_t WS_KW = WS_KS + (size_t)NB * 2 * SEQ * 64 * 2;
constexpr size_t WS_VST = WS_KW + (size_t)NB * 2 * SEQ * 64 * 2;
constexpr size_t WS_VWT = WS_VST + (size_t)NB * 2 * SEQ * 64 * 2;
constexpr size_t WS_GATE = WS_VWT + (size_t)NB * 2 * SEQ * 64 * 2;
constexpr size_t WS_SC = WS_GATE + (size_t)MT * 32 * 4;
constexpr int SCR_BYTES = 896, SCR_KK = 256, SCR_A = 384, SCR_K = 512, SCR_R = 640, SCR_V = 768;
#define SCREC(row, h) ((unsigned char*)(F.ws + WS_SC + ((size_t)(row) * 8 + (h)) * SCR_BYTES))
constexpr size_t WS_G = WS_SC + (size_t)MT * 8 * 6 * 64 * 4;
constexpr size_t WS_LA = WS_G + (size_t)MT * 512 * 4;
constexpr size_t WS_MIX = WS_LA + (size_t)MT * 256 * 2;
constexpr size_t WS_H = WS_MIX + (size_t)MT * DM * 2;
constexpr size_t WS_YRAW = WS_H + (size_t)MT * DFF * 2;
constexpr size_t WS_HALO = WS_YRAW + (size_t)MP * 512 * 4;
constexpr size_t WS_PECP = WS_HALO + (size_t)256 * 6 * DFF * 4;
constexpr size_t WS_END = WS_PECP + (size_t)32 * 512 * 4;

constexpr int CW_TMO = 0, CW_CODE = 1;
constexpr int CW_QUEUE = 64;
constexpr int CW_BAR = 4096;
constexpr size_t CTL_SSQ_BYTE = 65536; constexpr float SSQ_SCALE = 1048576.f;
static_assert(CTL_SSQ_BYTE + (size_t)8 * MT * 8 <= CTL_ZERO_BYTES * 2, "SSQ inside the memset region");
#define SSQP(k) ((unsigned long long*)(F.ws + WS_CTL + CTL_SSQ_BYTE) + (size_t)(k) * MT)


constexpr int RING_OFF = 0, RING_BYTES = 131072;
constexpr int LDSCTL_OFF = RING_BYTES, MISC_OFF = LDSCTL_OFF + 320;
constexpr int LDS_BYTES = 147456;

#define GAS __attribute__((address_space(1)))
#define LAS __attribute__((address_space(3)))
typedef unsigned short bf16;
typedef unsigned v4u __attribute__((ext_vector_type(4)));
typedef unsigned v2u __attribute__((ext_vector_type(2)));
typedef float f32x4 __attribute__((ext_vector_type(4)));
typedef float f32x2 __attribute__((ext_vector_type(2)));
typedef float f32x16 __attribute__((ext_vector_type(16)));
typedef short bf16x8 __attribute__((ext_vector_type(8)));
typedef GAS unsigned gu32;
#define RLX_AGENT __ATOMIC_RELAXED, __HIP_MEMORY_SCOPE_AGENT
#define LDS_WAIT() asm volatile("s_waitcnt lgkmcnt(0)" ::: "memory")
#define VM_WAIT() asm volatile("s_waitcnt vmcnt(0)" ::: "memory")
#define DI __device__ __forceinline__
#define MFMA32(a, b, c) __builtin_amdgcn_mfma_f32_32x32x16_bf16((a), (b), (c), 0, 0, 0)

DI float bf2f(unsigned b) { return __builtin_bit_cast(float, b << 16); }
DI float bflo(unsigned w) { return __builtin_bit_cast(float, w << 16); }
DI float bfhi(unsigned w) { return __builtin_bit_cast(float, w & 0xffff0000u); }
DI unsigned pk2(float lo, float hi) {
    typedef __bf16 bf2v __attribute__((ext_vector_type(2)));
    f32x2 v = {lo, hi}; bf2v r = __builtin_convertvector(v, bf2v); return __builtin_bit_cast(unsigned, r);
}
DI float rbf(float x) { return bflo(pk2(x, 0.f) & 0xffffu); }
DI float fexp2(float x) { return __builtin_amdgcn_exp2f(x); }
DI float fexp(float x) { return __builtin_amdgcn_exp2f(x * LOG2E); }
DI float frcp(float x) { return __builtin_amdgcn_rcpf(x); }
DI float sigmoidf_(float x) { return __builtin_amdgcn_rcpf(1.0f + __expf(-x)); }
DI float tanhf_(float x) { const float e = __expf(2.0f * x); return 1.0f - 2.0f * __builtin_amdgcn_rcpf(e + 1.0f); }
template <int CTRL> DI float dppf(float x) { return __builtin_bit_cast(float, __builtin_amdgcn_mov_dpp(__builtin_bit_cast(int, x), CTRL, 0xf, 0xf, true)); }
template <int CTRL> DI unsigned dppu(unsigned x) { return (unsigned)__builtin_amdgcn_mov_dpp((int)x, CTRL, 0xf, 0xf, true); }
constexpr int XOR1 = 0xB1, XOR2 = 0x4E, HMIR = 0x141, ROR8 = 0x128;
DI float sum4(float v) { v += dppf<XOR1>(v); v += dppf<XOR2>(v); return v; }
DI float sum8(float v) { v = sum4(v); v += dppf<HMIR>(v); return v; }
DI float sum16(float v) { v = sum8(v); v += dppf<ROR8>(v); return v; }
DI float wave_sum(float v) {
#pragma unroll
    for (int o = 1; o < 64; o <<= 1) v += __shfl_xor(v, o);
    return v;
}
DI float rinv_of(const unsigned long long* ssq, int row) { return __builtin_amdgcn_rsqf((float)ssq[row] * (1.f / (SSQ_SCALE * DM)) + RMS_EPS); }
DI int crow(int i, int h) { return (i & 3) + 8 * (i >> 2) + 4 * h; }

#define XB_TMO      128
#define XB_XCNT(j)  (256  + 64 * (j))
#define XB_XSUB(j)  (1280 + 64 * (j))
#define XB_XGEN(j)  (2304 + 64 * (j))
#define XB_TOP      3328
#define XB_TOPGEN   3392
#define XCD_BAR_WORDS 3456
#define XB_SPIN_CAP (1u << 18)

__device__ __forceinline__ unsigned xb_ld(unsigned* p)              { return __hip_atomic_load(p, __ATOMIC_RELAXED, __HIP_MEMORY_SCOPE_AGENT); }
__device__ __forceinline__ unsigned xb_add(unsigned* p, unsigned v) { return __hip_atomic_fetch_add(p, v, __ATOMIC_RELAXED, __HIP_MEMORY_SCOPE_AGENT); }
__device__ __forceinline__ unsigned xb_xcc_id() { return (unsigned)__builtin_amdgcn_s_getreg((3 << 11) | 20) & 0xFu; }
#define XB_SPIN(cond, bar) do { unsigned _sp = 0; while (cond) { __builtin_amdgcn_s_sleep(1); \
    if ((++_sp & 255u) == 0u) { if (xb_ld(&(bar)[XB_TMO])) break; if (_sp > XB_SPIN_CAP) { atomicAdd(&(bar)[XB_TMO], 1u); break; } } } } while (0)

struct XcdBarrier { unsigned* bar; unsigned x; volatile LAS unsigned* st; };

__device__ __forceinline__ XcdBarrier xcd_barrier_post(unsigned* bar, volatile LAS unsigned* st) {
    XcdBarrier b; b.bar = bar; b.x = xb_xcc_id(); b.st = st;
    if (threadIdx.x == 0) (void)xb_add(&bar[XB_XCNT(b.x)], 1u);
    return b;
}
__device__ __forceinline__ void xcd_barrier_complete(unsigned* bar, unsigned x, unsigned& nloc, unsigned& nx) {
    const unsigned G = gridDim.x * gridDim.y * gridDim.z;
    unsigned sum, cnt, mine, sp = 0u;
    for (;;) {
        sum = 0u; cnt = 0u; mine = 0u;
#pragma unroll
        for (unsigned j = 0; j < 16; ++j) { const unsigned c = xb_ld(&bar[XB_XCNT(j)]); sum += c; cnt += (c > 0u) ? 1u : 0u; mine = (j == x) ? c : mine; }
        if (sum == G) break;
        __builtin_amdgcn_s_sleep(1);
        if ((++sp & 255u) == 0u) { if (xb_ld(&bar[XB_TMO])) break; if (sp > XB_SPIN_CAP) { atomicAdd(&bar[XB_TMO], 1u); break; } }
    }
    nloc = mine > 0u ? mine : 1u; nx = cnt > 0u ? cnt : 1u;
}
__device__ __forceinline__ void xcd_barrier(const XcdBarrier& b) {
    asm volatile("s_waitcnt vmcnt(0)" ::: "memory");
    __syncthreads();
    if (threadIdx.x == 0) {
        unsigned* bar = b.bar;
        __builtin_amdgcn_s_waitcnt(0);
        unsigned nloc = b.st[0], nx = b.st[1];
        if (nloc == 0u) { xcd_barrier_complete(bar, b.x, nloc, nx); b.st[0] = nloc; b.st[1] = nx; }
        const unsigned old = xb_add(&bar[XB_XSUB(b.x)], 1u);
        const unsigned gen = old / nloc;
        if (old + 1u == (gen + 1u) * nloc) {
            __builtin_amdgcn_fence(__ATOMIC_RELEASE, "agent");
            asm volatile("s_waitcnt vmcnt(0)" ::: "memory");
            const unsigned og = xb_add(&bar[XB_TOP], 1u);
            const unsigned tg = og / nx;
            if (og + 1u == (tg + 1u) * nx) xb_add(&bar[XB_TOPGEN], 1u);
            else XB_SPIN(xb_ld(&bar[XB_TOPGEN]) == tg, bar);
            __builtin_amdgcn_fence(__ATOMIC_ACQUIRE, "agent");
            xb_add(&bar[XB_XGEN(b.x)], 1u);
            asm volatile("s_waitcnt vmcnt(0)" ::: "memory");
        } else {
            XB_SPIN(xb_ld(&bar[XB_XGEN(b.x)]) == gen, bar);
            __builtin_amdgcn_fence(__ATOMIC_ACQUIRE, "agent");
            asm volatile("s_waitcnt vmcnt(0)" ::: "memory");
        }
    }
    __syncthreads();
}

struct Frame {
    LAS unsigned char* lds;
    volatile LAS unsigned* MISC;
    gu32* ctl;
    int tid, lane, wave, G, bid;
    GAS float* out;
    GAS unsigned char* ws;
    unsigned long long ka;
};
#define LAUNDER(F) do { asm volatile("" : "+s"((F).ws)); asm volatile("" : "+s"((F).out)); asm volatile("" : "+s"((F).ka)); asm volatile("" : "+s"((F).bid)); asm volatile("" : "+s"((F).G)); asm volatile("" : "+v"((F).tid)); (F).lane = (F).tid & 63; (F).wave = __builtin_amdgcn_readfirstlane((F).tid >> 6); } while (0)
#define WSP(T, off) ((T*)(F.ws + (off)))
#define OUTF ((float*)F.out)
struct Args { const float* in[N_IN]; float* out; unsigned char* ws; int ph_lo, ph_hi; };
struct KArgs { const GAS float* in[N_IN]; GAS float* out; GAS unsigned char* ws; int ph_lo, ph_hi; };
#define KIN(i) ((const float*)(((const __attribute__((address_space(4))) KArgs*)(F.ka))->in[i]))

#ifndef PROBE_ID
#define PROBE_ID 0
#endif
#ifndef PROBE_MUL
#define PROBE_MUL 8
#endif
#define PROBE_T0(id) unsigned long long _pt0_##id = 0; if (PROBE_ID == (id)) { __syncthreads(); _pt0_##id = __builtin_amdgcn_s_memrealtime(); }
#define PROBE_T1(id) if (PROBE_ID == (id)) { __syncthreads(); if (F.tid == 0) F.MISC[20] += (unsigned)(__builtin_amdgcn_s_memrealtime() - _pt0_##id); }
template <class SRC> DI void tr_load(const SRC& src, int N, int item, int lane, float (&tv)[32]) {
    const int nblk = N / 32, kb = item / nblk, nb = item % nblk, k0 = 64 * kb, n0 = 32 * nb;
#pragma unroll
    for (int i = 0; i < 32; ++i) tv[i] = src(k0 + 2 * i + (lane >> 5), n0 + (lane & 31));
}
DI void tr_store(const float (&tv)[32], int K, int N, bf16* WT, LAS float* scr, int item, int lane) {
    const int nblk = N / 32, kb = item / nblk, nb = item % nblk, k0 = 64 * kb, n0 = 32 * nb;
#pragma unroll
    for (int i = 0; i < 32; ++i) scr[(2 * i + (lane >> 5)) * 33 + (lane & 31)] = tv[i];
    LDS_WAIT(); asm volatile("" ::: "memory");
    const int c = lane & 7;
#pragma unroll
    for (int j = 0; j < 4; ++j) { const int n = (lane >> 3) + 8 * j; const LAS float* s = scr + (8 * c) * 33 + n;
        v4u o; o.x = pk2(s[0 * 33], s[1 * 33]); o.y = pk2(s[2 * 33], s[3 * 33]); o.z = pk2(s[4 * 33], s[5 * 33]); o.w = pk2(s[6 * 33], s[7 * 33]);
        *(v4u*)(WT + (size_t)(n0 + n) * K + k0 + 8 * c) = o; }
    LDS_WAIT(); asm volatile("" ::: "memory");
}
template <class SRC> DI void tr_item(const SRC& src, int K, int N, bf16* WT, LAS float* scr, int item, int lane) { float tv[32]; tr_load(src, N, item, lane, tv); tr_store(tv, K, N, WT, scr, item, lane); }
template <class SRC> DI void tr_matrix(const SRC& src, int K, int N, bf16* WT, LAS float* scr, int first, int stride, int count, int lane) {
    if (first >= count) return;
    float cur[32], nxt[32]; tr_load(src, N, first, lane, cur);
    for (int it = first; it < count; it += stride) {
        const bool more = it + stride < count;
        if (more) tr_load(src, N, it + stride, lane, nxt);
        tr_store(cur, K, N, WT, scr, it, lane);
        if (more) {
#pragma unroll
            for (int i = 0; i < 32; ++i) cur[i] = nxt[i]; }
    }
}
struct SrcPlain { const float* W; int N; DI float operator()(int k, int n) const { return W[(size_t)k * N + n]; } };
struct SrcGain { const float* W; int N; const float* g; DI float operator()(int k, int n) const { return W[(size_t)k * N + n] * g[k]; } };
struct SrcWie { const float* W; const float* g; DI float operator()(int k, int n) const {
    int c; if (n < 1280) c = n; else if (n < 3072) c = n + 24; else if (n < 3096) c = n - 3072 + 1280; else c = -1;
    return c < 0 ? 0.f : W[(size_t)k * NE_ORIG + c] * g[k]; } };
struct SrcUp { const float* W; const float* g; DI float operator()(int k, int n) const {
    const int c = ((n >> 7) & 1) * DFF + (n >> 8) * 128 + (n & 127); return W[(size_t)k * NUP + c] * g[k]; } };
struct SrcPhi { const float* W; DI float operator()(int k, int n) const {
    const int kv = n >> 8, r = (n >> 7) & 1, e = n & 127; return W[(size_t)kv * 262144 + (size_t)r * 131072 + (size_t)k * 128 + e]; } };
struct SrcLora { const float *w2, *a2, *g2; DI float operator()(int k, int n) const {
    const int seg = n >> 9, c = n & 511;
    if (seg == 0) return k < 64 ? w2[k * 512 + c] : 0.f;
    if (seg == 1) return (k >= 64 && k < 128) ? a2[(k - 64) * 512 + c] : 0.f;
    return k >= 128 ? g2[(k - 128) * 512 + c] : 0.f; } };

DI void row_to_bf16_ssq(const float* xrow, bf16* orow, unsigned long long* ssq, int lane) {
    const f32x4* xr = (const f32x4*)xrow + lane;
    f32x4 v[4]; float s = 0.f;
#pragma unroll
    for (int j = 0; j < 4; ++j) { v[j] = xr[64 * j]; s += (v[j].x * v[j].x + v[j].y * v[j].y) + (v[j].z * v[j].z + v[j].w * v[j].w); }
    s = wave_sum(s);
    v2u* o8 = (v2u*)orow + lane;
#pragma unroll
    for (int j = 0; j < 4; ++j) { v2u o; o.x = pk2(v[j].x, v[j].y); o.y = pk2(v[j].z, v[j].w); o8[64 * j] = o; }
    if (lane == 0) *ssq = (unsigned long long)(s * SSQ_SCALE + 0.5f);
}
DI const float* xin_row(Frame& F, int row) { return row < MP ? KIN(I_XP) + (size_t)row * DM : KIN(I_XS) + (size_t)(row - MP) * DM; }

DI void p0_prologue(Frame& F) {
    LAS float* scr = (LAS float*)(F.lds + RING_OFF + F.wave * 16384);
    const int gw = F.bid * NWAVES + F.wave, NGW = F.G * NWAVES, lane = F.lane;
    constexpr int I_WIE = 16 * (NE / 32), I_SQ = 16 * 32, I_WIO = 16 * (NO / 32), I_UP = 16 * (NUP / 32), I_DN = (DFF / 64) * 32, I_PHI = 16 * 16, I_LORA = 4 * (NLORA / 32);
    int rot = 0;
#define TR_MAT(srcexpr, K_, N_, dst, cnt) do { auto s_ = srcexpr; const int f_ = (gw + NGW - (rot % NGW)) % NGW; tr_matrix(s_, K_, N_, dst, scr, f_, NGW, cnt, lane); rot += (cnt); } while (0)
    for (int li = 0; li < 2; ++li) TR_MAT((SrcWie{KIN(I_WINE) + (size_t)li * DM * NE_ORIG, KIN(I_NMIX) + (2 * li) * DM}), DM, NE, WSP(bf16, WS_WIE) + (size_t)li * NE * DM, I_WIE);
    for (int li = 0; li < 2; ++li) TR_MAT((SrcPlain{KIN(I_WOUTE) + (size_t)li * DM * DM, DM}), DM, DM, WSP(bf16, WS_WOE) + (size_t)li * DM * DM, I_SQ);
    for (int li = 0; li < 2; ++li) TR_MAT((SrcGain{KIN(I_WINO) + (size_t)li * DM * NO, NO, KIN(I_NMIX) + (2 * li + 1) * DM}), DM, NO, WSP(bf16, WS_WIO) + (size_t)li * NO * DM, I_WIO);
    for (int li = 0; li < 2; ++li) TR_MAT((SrcPlain{KIN(I_WOUTO) + (size_t)li * DM * DM, DM}), DM, DM, WSP(bf16, WS_WOO) + (size_t)li * DM * DM, I_SQ);
    for (int l = 0; l < 4; ++l) TR_MAT((SrcUp{KIN(I_FUP) + (size_t)l * DM * NUP, KIN(I_NFFN) + l * DM}), DM, NUP, WSP(bf16, WS_WUP) + (size_t)l * NUP * DM, I_UP);
    for (int l = 0; l < 4; ++l) TR_MAT((SrcPlain{KIN(I_FDOWN) + (size_t)l * DFF * DM, DM}), DFF, DM, WSP(bf16, WS_WDN) + (size_t)l * DM * DFF, I_DN);
    for (int li = 0; li < 2; ++li) TR_MAT((SrcPhi{KIN(I_PW1) + (size_t)li * 2 * 262144}), 1024, 512, WSP(bf16, WS_PHI1) + (size_t)li * 512 * 1024, I_PHI);
    for (int li = 0; li < 2; ++li) TR_MAT((SrcLora{KIN(I_W2) + (size_t)li * 64 * 512, KIN(I_A2) + (size_t)li * 64 * 512, KIN(I_G2) + (size_t)li * 128 * 512}), KLORA, NLORA, WSP(bf16, WS_LORA) + (size_t)li * NLORA * KLORA, I_LORA);
#undef TR_MAT
    if (F.wave == NWAVES - 1 && F.bid < 256) { const int q = F.bid, jc = q >> 3, lk = (q >> 1) & 3, e = (q & 1) * 64 + lane; const float* pe = KIN(I_PPE) + (size_t)lk * 2048 + jc * 64; const float* w1 = KIN(I_PW1) + (size_t)lk * 262144 + (size_t)jc * 64 * 128;
        float a = 0.f;
#pragma unroll 16
        for (int jd = 0; jd < 64; ++jd) a += pe[jd] * w1[(size_t)jd * 128 + e];
        WSP(float, WS_PECP)[(jc * 4 + lk) * 128 + e] = a; }
    for (int m = gw; m < MT; m += NGW) row_to_bf16_ssq(xin_row(F, m), WSP(bf16, WS_XN) + (size_t)m * DM, SSQP(0) + m, lane);
}

DI void store8f(float* p, const float (&v)[8]) { *(f32x4*)p = (f32x4){v[0], v[1], v[2], v[3]}; *(f32x4*)(p + 4) = (f32x4){v[4], v[5], v[6], v[7]}; }
DI void ld8bf(const bf16* p, float (&v)[8]) { const v4u w = *(const v4u*)p; v[0] = bflo(w.x); v[1] = bfhi(w.x); v[2] = bflo(w.y); v[3] = bfhi(w.y); v[4] = bflo(w.z); v[5] = bfhi(w.z); v[6] = bflo(w.w); v[7] = bfhi(w.w); }
DI void ld8f(const float* p, float (&v)[8]) { const f32x4 a = *(const f32x4*)p, b = *(const f32x4*)(p + 4); v[0] = a.x; v[1] = a.y; v[2] = a.z; v[3] = a.w; v[4] = b.x; v[5] = b.y; v[6] = b.z; v[7] = b.w; }

struct RowRawA { v4u q; v2u kv[3]; unsigned gate; unsigned long long sq; };
struct RowRawB { v4u z[4]; unsigned long long sq; };
DI RowRawA load_row_a(const bf16* zr, const unsigned long long* sq, int lane) { RowRawA r; r.sq = *sq; r.q = *(const v4u*)(zr + lane * 8);
#pragma unroll
    for (int c = 0; c < 3; ++c) r.kv[c] = *(const v2u*)(zr + 512 + c * 256 + lane * 4);
    r.gate = zr[3072 + lane]; return r; }
DI RowRawB load_row_b(const bf16* zr, const unsigned long long* sq, int lane) { RowRawB r; r.sq = *sq;
#pragma unroll
    for (int p = 0; p < 4; ++p) r.z[p] = *(const v4u*)(zr + 1280 + p * 512 + lane * 8);
    return r; }
DI void unpk8(const v4u w, float (&v)[8]) { v[0] = bflo(w.x); v[1] = bfhi(w.x); v[2] = bflo(w.y); v[3] = bfhi(w.y); v[4] = bflo(w.z); v[5] = bfhi(w.z); v[6] = bflo(w.w); v[7] = bfhi(w.w); }
DI void post_even_run(Frame& F, int li, int l, bool samp, int b, int tbase, int row0, int ntok) {
    const int lane = F.lane;
    LAS bf16* vts = (LAS bf16*)(F.lds + RING_OFF);
    LAS bf16* vtw = vts + 2 * 64 * 66;
    const bf16* ZB = WSP(bf16, WS_ZB);
    float kn1[4], kn2[4];
    { const f32x4 a = *(const f32x4*)(KIN(I_KN) + (li * 3 + 1) * 64 + (lane & 15) * 4), c = *(const f32x4*)(KIN(I_KN) + (li * 3 + 2) * 64 + (lane & 15) * 4);
      kn1[0] = a.x; kn1[1] = a.y; kn1[2] = a.z; kn1[3] = a.w; kn2[0] = c.x; kn2[1] = c.y; kn2[2] = c.z; kn2[3] = c.w; }
    const unsigned long long* ssq = SSQP(2 * l);
    float qg[8]; ld8f(KIN(I_QN) + li * 64 + (lane & 7) * 8, qg);
    RowRawA nx = load_row_a(ZB + (size_t)row0 * NE, ssq + row0, lane);
    for (int i8 = 0; i8 < ntok; ++i8) {
        const int t = tbase + i8, row = row0 + i8;
        const RowRawA cu = nx;
        if (i8 < ntok - 1) nx = load_row_a(ZB + (size_t)(row + 1) * NE, ssq + row + 1, lane);
        const float rin = __builtin_amdgcn_rsqf((float)cu.sq * (1.f / (SSQ_SCALE * DM)) + RMS_EPS);
        { float x[8]; unpk8(cu.q, x); float ss = 0.f;
#pragma unroll
          for (int i = 0; i < 8; ++i) x[i] *= rin;
#pragma unroll
          for (int i = 0; i < 8; ++i) ss += x[i] * x[i];
          ss = sum8(ss); const float rinv = 1.0f / sqrtf(ss * (1.f / 64.f) + RMS_EPS);
          v4u o; o.x = pk2(x[0] * rinv * qg[0], x[1] * rinv * qg[1]); o.y = pk2(x[2] * rinv * qg[2], x[3] * rinv * qg[3]); o.z = pk2(x[4] * rinv * qg[4], x[5] * rinv * qg[5]); o.w = pk2(x[6] * rinv * qg[6], x[7] * rinv * qg[7]);
          *(v4u*)(WSP(bf16, WS_QB) + (size_t)row * 512 + lane * 8) = o; }
#pragma unroll
        for (int c = 0; c < 3; ++c) {
            const v2u wv = cu.kv[c];
            float x[4] = {bflo(wv.x) * rin, bfhi(wv.x) * rin, bflo(wv.y) * rin, bfhi(wv.y) * rin};
            const int g = (lane >> 4) & 1, dd = (lane & 15) * 4; const bool isv = lane >= 32;
            if (c > 0) { float ss = (x[0] * x[0] + x[1] * x[1]) + (x[2] * x[2] + x[3] * x[3]); ss = sum16(ss);
                if (!isv) { const float rinv = 1.0f / sqrtf(ss * (1.f / 64.f) + RMS_EPS);
#pragma unroll
                    for (int i = 0; i < 4; ++i) x[i] = x[i] * rinv * (c == 1 ? kn1[i] : kn2[i]); } }
            float* op = nullptr;
            if (c == 0) op = OUTF + (samp ? O_CMPS + ((size_t)(b * 2 + li) * DT + t) * 256 : O_CMPP + ((size_t)(b * 2 + li) * SEQ + t) * 256);
            else if (c == 1) op = OUTF + (samp ? O_SLCS + ((size_t)(b * 2 + li) * DT + t) * 256 : O_SLCP + ((size_t)(b * 2 + li) * SEQ + t) * 256);
            else { if (samp) op = OUTF + O_WINS + ((size_t)(b * 2 + li) * WIN + (WIN - DT) + t) * 256; else if (t >= SEQ - WIN) op = OUTF + O_WINP + ((size_t)(b * 2 + li) * WIN + (t - (SEQ - WIN))) * 256; }
            if (op) *(f32x4*)(op + lane * 4) = (f32x4){x[0], x[1], x[2], x[3]};
            if (!samp) {
                v2u pk; pk.x = pk2(x[0], x[1]); pk.y = pk2(x[2], x[3]);
                if (c == 0) { const int rw = (isv ? CS_PV : CS_PK) + (b * 2 + g) * 128 + (t >> 4);
                    *(v2u*)(WSP(bf16, WS_CSEG) + (size_t)rw * 1024 + (t & 15) * 64 + dd) = pk; }
                else if (!isv) { *(v2u*)(WSP(bf16, c == 1 ? WS_KS : WS_KW) + ((size_t)(b * 2 + g) * SEQ + t) * 64 + dd) = pk; }
                else { LAS bf16* vt = (c == 1 ? vts : vtw) + (g * 64 + dd) * 66 + (t & 63);
                    vt[0] = (bf16)(pk.x & 0xffffu); vt[66] = (bf16)(pk.x >> 16); vt[132] = (bf16)(pk.y & 0xffffu); vt[198] = (bf16)(pk.y >> 16); }
            }
        }
        if (lane < 24) WSP(float, WS_GATE)[(size_t)row * 32 + lane] = sigmoidf_(bf2f(cu.gate) * rin);
    }
    float zp[4][8];
#pragma unroll
    for (int p = 0; p < 4; ++p) {
        const bool act = (p < 3 || lane < 32);
        if (!act) { for (int i = 0; i < 8; ++i) zp[p][i] = 0.f; }
        else if (tbase == 0) { if (samp) ld8f(KIN(I_SSHIFT) + (size_t)(b * 2 + li) * RWP + p * 512 + lane * 8, zp[p]); else { for (int i = 0; i < 8; ++i) zp[p][i] = 0.f; } }
        else { ld8bf(ZB + (size_t)(row0 - 1) * NE + 1280 + p * 512 + lane * 8, zp[p]); const float rp = rinv_of(ssq, row0 - 1);
#pragma unroll
            for (int i = 0; i < 8; ++i) zp[p][i] *= rp; }
    }
    float mu[4][8], kkw[8]; ld8f(KIN(I_KKW) + li * 512 + lane * 8, kkw);
#pragma unroll
    for (int p = 0; p < 4; ++p) { if (p < 3 || lane < 32) ld8f(KIN(I_MU) + li * RWP + p * 512 + lane * 8, mu[p]); else { for (int i = 0; i < 8; ++i) mu[p][i] = 0.f; } }
    RowRawB nb = load_row_b(ZB + (size_t)row0 * NE, ssq + row0, lane);
    for (int i8 = 0; i8 < ntok; ++i8) {
        const int t = tbase + i8, row = row0 + i8;
        const RowRawB cu = nb;
        if (i8 < ntok - 1) nb = load_row_b(ZB + (size_t)(row + 1) * NE, ssq + row + 1, lane);
        const float rin = __builtin_amdgcn_rsqf((float)cu.sq * (1.f / (SSQ_SCALE * DM)) + RMS_EPS);
        const bool lastt = samp ? (t == DT - 1) : (t == SEQ - 1);
#pragma unroll
        for (int p = 0; p < 4; ++p) {
            if (p < 3 || lane < 32) {
                float z[8], zz[8]; unpk8(cu.z[p], z);
#pragma unroll
                for (int i = 0; i < 8; ++i) z[i] *= rin;

#pragma unroll
                for (int i = 0; i < 8; ++i) { zz[i] = z[i] + (zp[p][i] - z[i]) * mu[p][i]; zp[p][i] = z[i]; }
                if (lastt) store8f(OUTF + (samp ? O_SHS : O_SHP) + (size_t)(b * 2 + li) * RWP + p * 512 + lane * 8, z);
                const int h = lane >> 3, d = (lane & 7) * 8;
                unsigned char* scb = (unsigned char*)SCREC(row, h) + d * 2;
                v4u zb; zb.x = pk2(zz[0], zz[1]); zb.y = pk2(zz[2], zz[3]); zb.z = pk2(zz[4], zz[5]); zb.w = pk2(zz[6], zz[7]);
                if (p == 0) *(v4u*)(scb + SCR_R) = zb;
                else if (p == 2) *(v4u*)(scb + SCR_V) = zb;
                else if (p == 1) { *(v4u*)(scb + SCR_K) = zb; float kk[8]; float ss = 0.f;
#pragma unroll
                    for (int i = 0; i < 8; ++i) { kk[i] = zz[i] * kkw[i]; ss += kk[i] * kk[i]; }
                    ss = sum8(ss); const float rinv = 1.0f / sqrtf(fmaxf(ss, 1e-24f));
#pragma unroll
                    for (int i = 0; i < 8; ++i) kk[i] *= rinv;
                    v4u kb; kb.x = pk2(kk[0], kk[1]); kb.y = pk2(kk[2], kk[3]); kb.z = pk2(kk[4], kk[5]); kb.w = pk2(kk[6], kk[7]); *(v4u*)(scb + SCR_KK) = kb; }
                else { float o[8];
#pragma unroll
                    for (int i = 0; i < 8; ++i) o[i] = lane < 8 ? tanhf_(zz[i]) : (lane < 16 ? zz[i] : sigmoidf_(zz[i]));
                    v4u pk; pk.x = pk2(o[0], o[1]); pk.y = pk2(o[2], o[3]); pk.z = pk2(o[4], o[5]); pk.w = pk2(o[6], o[7]);
                    *(v4u*)(WSP(bf16, WS_LA) + (size_t)row * 256 + lane * 8) = pk; }
            }
        }
    }
}
DI void post_even_tile(Frame& F, int tt, int li, int l) {
    const int w = F.wave, b = tt >> 5, blk = tt & 31;
    post_even_run(F, li, l, false, b, blk * 64 + 8 * w, b * SEQ + blk * 64 + 8 * w, 8);
    if (w < 4) { const int st = tt * 4 + w; post_even_run(F, li, l, true, st >> 3, st & 7, MP + st, 1); }
    LAS bf16* vts = (LAS bf16*)(F.lds + RING_OFF); LAS bf16* vtw = vts + 2 * 64 * 66;
    {
        __syncthreads();
#pragma unroll
        for (int a = 0; a < 2; ++a) { const LAS bf16* vt = a ? vtw : vts; const int ri = F.tid >> 2, q4 = F.tid & 3;
            const LAS unsigned* s = (const LAS unsigned*)(vt + ri * 66 + q4 * 16);
            v4u o0, o1; o0.x = s[0]; o0.y = s[1]; o0.z = s[2]; o0.w = s[3]; o1.x = s[4]; o1.y = s[5]; o1.z = s[6]; o1.w = s[7];
            bf16* dst = WSP(bf16, a ? WS_VWT : WS_VST) + (((size_t)(b * 2 + (ri >> 6)) * 32 + blk) * 64 + (ri & 63)) * 64 + q4 * 16;
            *(v4u*)dst = o0; *(v4u*)(dst + 8) = o1; }
        __syncthreads();
    }
}
DI void cseg_page_load(Frame& F, int u, int li, f32x4 (&v)[8][2]) {
    const int b = u >> 4, p = u & 15; const int pg = ((const int*)KIN(I_PT))[b * NPAGE + p];
    const float* src = KIN(I_CCMP) + ((size_t)pg * 2 + li) * (PAGE * 256);
#pragma unroll
    for (int k = 0; k < 8; ++k) { const int q = k * NTHREADS + F.tid; const f32x4* sp = (const f32x4*)(src + (size_t)(q >> 5) * 256 + (q & 31) * 8);
        v[k][0] = __builtin_nontemporal_load(sp); v[k][1] = __builtin_nontemporal_load(sp + 1); }
}
DI void cseg_page_store(Frame& F, int u, const f32x4 (&v)[8][2]) {
    const int b = u >> 4, p = u & 15; bf16* CS = WSP(bf16, WS_CSEG);
#pragma unroll
    for (int k = 0; k < 8; ++k) { const int q = k * NTHREADS + F.tid; const int r = q >> 5, c = q & 31;
        const int kv = c >> 4, g = (c >> 3) & 1, d0 = (c & 7) * 8;
        v4u o; o.x = pk2(v[k][0].x, v[k][0].y); o.y = pk2(v[k][0].z, v[k][0].w); o.z = pk2(v[k][1].x, v[k][1].y); o.w = pk2(v[k][1].z, v[k][1].w);
        *(v4u*)(CS + ((size_t)((kv ? CS_SV : CS_SK) + (b * 2 + g) * 128 + p * 8 + (r >> 4))) * 1024 + (r & 15) * 64 + d0) = o; }
}
DI void cseg_page_unit(Frame& F, int u, int li) { f32x4 v[8][2]; cseg_page_load(F, u, li, v); cseg_page_store(F, u, v); }
DI void win_copy_unit(Frame& F, int u, int li) {
    const int b = u / 9, q = u % 9;
    const f32x4* src = (const f32x4*)(KIN(I_CWIN) + ((size_t)(b * 2 + li) * WIN + DT + q * 56) * 256) + F.tid;
    f32x4* dst = (f32x4*)(OUTF + O_WINS + ((size_t)(b * 2 + li) * WIN + q * 56) * 256) + F.tid;
    f32x4 v[7];
#pragma unroll
    for (int k = 0; k < 7; ++k) v[k] = __builtin_nontemporal_load(src + k * NTHREADS);
#pragma unroll
    for (int k = 0; k < 7; ++k) __builtin_nontemporal_store(v[k], dst + k * NTHREADS);
}
DI void bg_units(Frame& F, int li, int max_tickets) {
    constexpr int NTK = (DB * NPAGE + DB * 9) / 4;
    volatile LAS unsigned* tk = F.MISC + 17;
    for (int n = 0; n < max_tickets; ++n) {
        __syncthreads();
        if (F.tid == 0) tk[0] = __hip_atomic_fetch_add((unsigned*)(F.ctl + CW_QUEUE + 16 + 32 * li), 1u, RLX_AGENT);
        __syncthreads();
        const int t4 = __builtin_amdgcn_readfirstlane((int)tk[0]);
        if (t4 >= NTK) break;
#pragma unroll 1
        for (int k = 0; k < 4; ++k) { LAUNDER(F); const int u = t4 * 4 + k; if (u < DB * NPAGE) cseg_page_unit(F, u, li); else win_copy_unit(F, u - DB * NPAGE, li); }
    }
}
DI void post_even_phase(Frame& F, int li, int l) {
    for (int u = F.bid; u < 256; u += F.G) post_even_tile(F, u, li, l);
    bg_units(F, li, 1 << 30);
}

DI float gelu_tanh(float x) { const float u = 0.7978845608028654f * (x + 0.044715f * x * x * x); return 0.5f * x * (1.0f + tanhf_(u)); }
DI void compress2_stage_w2(Frame& F, int li) {
    LAS bf16* w2t = (LAS bf16*)(F.lds + RING_OFF);
    const float* w2 = KIN(I_PW2) + (size_t)li * 2 * 128 * 64;
    for (int i = F.tid; i < 2 * 128 * 64; i += NTHREADS) { const int kv = i >> 13, e = (i >> 6) & 127, d = i & 63; w2t[(kv * 64 + d) * 136 + e] = (bf16)(pk2(w2[i], 0.f) & 0xffffu); }
    if (F.tid < 256) { float a = 0.f; const float* pp = WSP(float, WS_PECP) + li * 256 + F.tid;
#pragma unroll 8
        for (int jc = 0; jc < 32; ++jc) a += pp[jc * 512];
        ((LAS float*)(F.lds + RING_OFF + 36864))[F.tid] = a; }
    __syncthreads();
}
DI void compress2_unit(Frame& F, int cu, int li) {
    const int w = F.wave, lane = F.lane, kl = lane & 31, h = lane >> 5, kv = w >> 2, n = (w & 3) * 32 + kl;
    const LAS bf16* w2t = (const LAS bf16*)(F.lds + RING_OFF) + kv * 64 * 136;
    const bool prm = cu >= 256; const int bg = prm ? cu - 256 : cu;
    const size_t rb = (size_t)(prm ? (kv ? CS_PV : CS_PK) : (kv ? CS_SV : CS_SK)) + (size_t)bg * 128;
    const float* p0 = WSP(float, WS_PART) + (rb + n) * 256 + 8 * h; const float* p1 = p0 + 256 + 128; const LAS float* pec = (const LAS float*)(F.lds + RING_OFF + 36864) + kv * 128 + 8 * h;
    f32x16 C[2];
#pragma unroll
    for (int i = 0; i < 16; ++i) { C[0][i] = 0.f; C[1][i] = 0.f; }
#pragma unroll
    for (int ks = 0; ks < 8; ++ks) {
        float x0[8], x1[8], pc[8]; ld8f(p0 + 16 * ks, x0); ld8f(p1 + 16 * ks, x1);
#pragma unroll
        for (int j = 0; j < 8; ++j) pc[j] = pec[16 * ks + j];
        v4u bv; bv.x = pk2(gelu_tanh(pc[0] + x0[0] + x1[0]), gelu_tanh(pc[1] + x0[1] + x1[1])); bv.y = pk2(gelu_tanh(pc[2] + x0[2] + x1[2]), gelu_tanh(pc[3] + x0[3] + x1[3]));
        bv.z = pk2(gelu_tanh(pc[4] + x0[4] + x1[4]), gelu_tanh(pc[5] + x0[5] + x1[5])); bv.w = pk2(gelu_tanh(pc[6] + x0[6] + x1[6]), gelu_tanh(pc[7] + x0[7] + x1[7]));
        const bf16x8 bf = __builtin_bit_cast(bf16x8, bv);
#pragma unroll
        for (int dt = 0; dt < 2; ++dt) { const bf16x8 a = *(const LAS bf16x8*)(w2t + (dt * 32 + kl) * 136 + 16 * ks + 8 * h); C[dt] = MFMA32(a, bf, C[dt]); }
    }
    const bool valid = n < NCMP;
    if (kv == 0) {
        float ss = 0.f;
#pragma unroll
        for (int dt = 0; dt < 2; ++dt)
#pragma unroll
            for (int i = 0; i < 16; ++i) ss += C[dt][i] * C[dt][i];
        ss += __shfl_xor(ss, 32);
        const float rinv = valid ? 1.0f / sqrtf(ss * (1.f / 64.f) + RMS_EPS) : 0.f;
        bf16* KC = WSP(bf16, WS_KC) + (size_t)cu * 8192 + n * 64; const float* kn = KIN(I_KN) + (li * 3 + 0) * 64;
#pragma unroll
        for (int dt = 0; dt < 2; ++dt)
#pragma unroll
            for (int a = 0; a < 4; ++a) { const int d0 = dt * 32 + 8 * a + 4 * h; const f32x4 g = *(const f32x4*)(kn + d0);
                v2u o; o.x = pk2(C[dt][4 * a] * rinv * g.x, C[dt][4 * a + 1] * rinv * g.y); o.y = pk2(C[dt][4 * a + 2] * rinv * g.z, C[dt][4 * a + 3] * rinv * g.w); if (!valid) { o.x = 0u; o.y = 0u; } *(v2u*)(KC + d0) = o; }
    } else {
        bf16* VCT = WSP(bf16, WS_VCT) + (size_t)cu * 8192 + n;
#pragma unroll
        for (int dt = 0; dt < 2; ++dt)
#pragma unroll
            for (int i = 0; i < 16; ++i) VCT[(dt * 32 + crow(i, h)) * 128] = (bf16)(pk2(valid ? C[dt][i] : 0.f, 0.f) & 0xffffu);
    }
}
DI void compress2_phase(Frame& F, int li) { compress2_stage_w2(F, li); for (int u = F.bid; u < 272; u += F.G) compress2_unit(F, u, li); __syncthreads(); }

DI void odd_mix_phase(Frame& F, int li, int l) {
    const unsigned long long* ssq = SSQP(2 * l);
    const bf16* ZB = WSP(bf16, WS_ZB); bf16* MIX = WSP(bf16, WS_MIX);
    const float* cw = KIN(I_CONVW) + (size_t)li * 3 * DM;
    constexpr int NCG = DM / 8, NRUN = MT / 8;
    for (int it = F.bid * NTHREADS + F.tid; it < NRUN * NCG; it += F.G * NTHREADS) {
        const int run = it / NCG, ch = (it % NCG) * 8;
        const bool samp = run >= MP / 8; const int b = samp ? run - MP / 8 : run >> 8, t0 = samp ? 0 : (run & 255) * 8, row0 = run * 8;
        v4u rb[8], rc[10], rx[10]; unsigned long long sq[10];
        const bool halo = t0 != 0;
#pragma unroll
        for (int j = 0; j < 10; ++j) { const int rr = halo ? row0 - 2 + j : (j < 2 ? row0 : row0 - 2 + j); const bf16* zr = ZB + (size_t)rr * NO;
            rc[j] = *(const v4u*)(zr + DM + ch); rx[j] = *(const v4u*)(zr + 2 * DM + ch); sq[j] = ssq[rr]; if (j >= 2) rb[j - 2] = *(const v4u*)(zr + ch); }
        float w0[8], w1[8], w2[8], p2[8], p1[8];
        ld8f(cw + ch, w0); ld8f(cw + DM + ch, w1); ld8f(cw + 2 * DM + ch, w2);
        if (!halo) { if (samp) { ld8f(KIN(I_SCONV) + ((size_t)(b * 2 + li) * 2 + 0) * DM + ch, p2); ld8f(KIN(I_SCONV) + ((size_t)(b * 2 + li) * 2 + 1) * DM + ch, p1); }
                     else { for (int i = 0; i < 8; ++i) { p2[i] = 0.f; p1[i] = 0.f; } } }
        else { float a[8], c[8]; float rr = __builtin_amdgcn_rsqf((float)sq[0] * (1.f / (SSQ_SCALE * DM)) + RMS_EPS); rr *= rr; unpk8(rc[0], a); unpk8(rx[0], c); for (int i = 0; i < 8; ++i) p2[i] = a[i] * c[i] * rr;
               rr = __builtin_amdgcn_rsqf((float)sq[1] * (1.f / (SSQ_SCALE * DM)) + RMS_EPS); rr *= rr; unpk8(rc[1], a); unpk8(rx[1], c); for (int i = 0; i < 8; ++i) p1[i] = a[i] * c[i] * rr; }
#pragma unroll
        for (int j = 0; j < 8; ++j) {
            float bgv[8], cg[8], xi[8], p[8], o[8]; unpk8(rb[j], bgv); unpk8(rc[j + 2], cg); unpk8(rx[j + 2], xi);
            const float rin = __builtin_amdgcn_rsqf((float)sq[j + 2] * (1.f / (SSQ_SCALE * DM)) + RMS_EPS), rin2 = rin * rin;
#pragma unroll
            for (int i = 0; i < 8; ++i) { p[i] = cg[i] * xi[i] * rin2; o[i] = bgv[i] * rin * (w0[i] * p2[i] + w1[i] * p1[i] + w2[i] * p[i]); p2[i] = p1[i]; p1[i] = p[i]; }
            v4u pk; pk.x = pk2(o[0], o[1]); pk.y = pk2(o[2], o[3]); pk.z = pk2(o[4], o[5]); pk.w = pk2(o[6], o[7]);
            *(v4u*)(MIX + (size_t)(row0 + j) * DM + ch) = pk;
            const int t = t0 + j; const int tl = samp ? DT : SEQ;
            if (t >= tl - 2) store8f(OUTF + (samp ? O_CVS : O_CVP) + ((size_t)(b * 2 + li) * 2 + (t - (tl - 2))) * DM + ch, p);
        }
    }
}
DI void ffn_act_phase(Frame& F, int l) {
    const unsigned long long* ssq = SSQP(2 * l + 1);
    const bf16* AU = WSP(bf16, WS_ZB); bf16* H = WSP(bf16, WS_H);
    const float* cw = KIN(I_FCONV) + (size_t)l * 3 * DFF;
    constexpr int NCG = DFF / 8, NRUN = MT / 8;
    for (int it = F.bid * NTHREADS + F.tid; it < NRUN * NCG; it += F.G * NTHREADS) {
        const int run = it / NCG, ch = (it % NCG) * 8;
        const bool samp = run >= MP / 8; const int b = samp ? run - MP / 8 : run >> 8, t0 = samp ? 0 : (run & 255) * 8, row0 = run * 8;
        float w0[8], w1[8], w2[8], a2[8], a1[8];
        ld8f(cw + ch, w0); ld8f(cw + DFF + ch, w1); ld8f(cw + 2 * DFF + ch, w2);
        if (t0 == 0) { if (samp) { ld8f(KIN(I_SFFN) + ((size_t)(b * 4 + l) * 2 + 0) * DFF + ch, a2); ld8f(KIN(I_SFFN) + ((size_t)(b * 4 + l) * 2 + 1) * DFF + ch, a1); }
                       else { for (int i = 0; i < 8; ++i) { a2[i] = 0.f; a1[i] = 0.f; } } }
        else { ld8bf(AU + (size_t)(row0 - 2) * NUP + ch, a2); ld8bf(AU + (size_t)(row0 - 1) * NUP + ch, a1); const float r2 = rinv_of(ssq, row0 - 2), r1 = rinv_of(ssq, row0 - 1); for (int i = 0; i < 8; ++i) { a2[i] *= r2; a1[i] *= r1; } }
#pragma unroll
        for (int j = 0; j < 8; ++j) {
            const bf16* zr = AU + (size_t)(row0 + j) * NUP; float a[8], uu[8], o[8];
            ld8bf(zr + ch, a); ld8bf(zr + DFF + ch, uu);
            const float rin = rinv_of(ssq, row0 + j);
#pragma unroll
            for (int i = 0; i < 8; ++i) { a[i] *= rin; const float y = w0[i] * a2[i] + w1[i] * a1[i] + w2[i] * a[i]; o[i] = y * sigmoidf_(y) * uu[i] * rin; a2[i] = a1[i]; a1[i] = a[i]; }
            v4u pk; pk.x = pk2(o[0], o[1]); pk.y = pk2(o[2], o[3]); pk.z = pk2(o[4], o[5]); pk.w = pk2(o[6], o[7]);
            *(v4u*)(H + (size_t)(row0 + j) * DFF + ch) = pk;
            const int t = t0 + j; const int tl = samp ? DT : SEQ;
            if (t >= tl - 2) store8f(OUTF + (samp ? O_FFS : O_FFP) + ((size_t)(b * 4 + l) * 2 + (t - (tl - 2))) * DFF + ch, a);
        }
    }
}

DI int rel_bucket(int d) {
    if (d < 16) return d;
    int bkt = 16;
    bkt += (d >= 19) + (d >= 21) + (d >= 24) + (d >= 27) + (d >= 31) + (d >= 35) + (d >= 40) + (d >= 46) + (d >= 52) + (d >= 59) + (d >= 67) + (d >= 77) + (d >= 87) + (d >= 99) + (d >= 113);
    return bkt;
}
DI void fill_bias_table(Frame& F, LAS float* biasT, int g) {
    const int hq = F.tid >> 7, d = F.tid & 127;
    biasT[F.tid] = KIN(I_RELB)[rel_bucket(d) * 8 + g * 4 + hq] * LOG2E;
}
DI bf16x8 pack_p(const f32x16& p, int s) {
    v4u r; r.x = pk2(p[8 * s + 0], p[8 * s + 1]); r.y = pk2(p[8 * s + 2], p[8 * s + 3]); r.z = pk2(p[8 * s + 4], p[8 * s + 5]); r.w = pk2(p[8 * s + 6], p[8 * s + 7]);
    return __builtin_bit_cast(bf16x8, r);
}
DI float xhalf_max(float x) { return fmaxf(x, __shfl_xor(x, 32)); }
DI float xhalf_sum(float x) { return x + __shfl_xor(x, 32); }
constexpr float SC2 = 0.125f * LOG2E;
constexpr float NEG_BIG = -1e30f;

constexpr float SREF = 8.0f;
DI void softmax_pv(f32x16& s, float& l, f32x16 (&O)[2], const bf16x8 (&vf)[2][2]) {
    float ps0 = 0.f, ps1 = 0.f;
#pragma unroll
    for (int i = 0; i < 16; i += 2) { s[i] = fexp2(s[i]); s[i + 1] = fexp2(s[i + 1]); ps0 += s[i]; ps1 += s[i + 1]; }
    l += ps0 + ps1;
    const bf16x8 p0 = pack_p(s, 0), p1 = pack_p(s, 1);
#pragma unroll
    for (int dt = 0; dt < 2; ++dt) { O[dt] = MFMA32(vf[dt][0], p0, O[dt]); O[dt] = MFMA32(vf[dt][1], p1, O[dt]); }
}

DI void cmp_branch(const bf16x8 (&qf)[4], const bf16* kc, const bf16* vct, int t, int ccur, const LAS float* biasT, int lane, LAS float* scr, f32x16 (&Oc)[2], unsigned& selmask) {
    const int kl = lane & 31, h = lane >> 5, hq = kl & 3, tl = kl >> 2;
    f32x16 S[4];
#pragma unroll
    for (int kt = 0; kt < 4; ++kt) {
#pragma unroll
        for (int i = 0; i < 16; ++i) S[kt][i] = 0.f;
#pragma unroll
        for (int ks = 0; ks < 4; ++ks) { const bf16x8 a = *(const bf16x8*)(kc + (32 * kt + kl) * 64 + 16 * ks + 8 * h); S[kt] = MFMA32(a, qf[ks], S[kt]); }
    }
    const int nmax = (t - 31) >> 4;
    float mx = NEG_BIG;
#pragma unroll
    for (int kt = 0; kt < 4; ++kt) {
        float bv[16];
#pragma unroll
        for (int i = 0; i < 16; ++i) { const int n = 32 * kt + crow(i, h); const int dist = t - (16 * n + 31); const int idx = dist < 0 ? 0 : (dist > 127 ? 127 : dist); bv[i] = biasT[hq * 128 + idx]; }
#pragma unroll
        for (int i = 0; i < 16; ++i) { const int n = 32 * kt + crow(i, h); float v = S[kt][i] * SC2 + bv[i]; v = (n <= nmax) ? v : -INFINITY; S[kt][i] = v; mx = fmaxf(mx, v); }
    }
    mx = xhalf_max(mx);
    float sum = 0.f;
#pragma unroll
    for (int kt = 0; kt < 4; ++kt)
#pragma unroll
        for (int i = 0; i < 16; ++i) { const float e = fexp2(S[kt][i] - mx); S[kt][i] = e; sum += e; }
    sum = xhalf_sum(sum);
    const float inv = sum > 0.f ? 1.0f / sum : 0.f;
#pragma unroll
    for (int kt = 0; kt < 4; ++kt) S[kt] = S[kt] * inv;
    f32x16 I;
#pragma unroll
    for (int i = 0; i < 16; ++i) { Oc[0][i] = 0.f; Oc[1][i] = 0.f; I[i] = 0.f; }
#pragma unroll
    for (int kt = 0; kt < 4; ++kt)
#pragma unroll
        for (int st = 0; st < 2; ++st) {
            const bf16x8 ph = pack_p(S[kt], st);
            f32x16 lo = S[kt];
#pragma unroll
            for (int j = 0; j < 8; ++j) { const unsigned short hb = (unsigned short)ph[j]; lo[8 * st + j] = S[kt][8 * st + j] - bf2f(hb); }
            const bf16x8 pl = pack_p(lo, st);
#pragma unroll
            for (int dt = 0; dt < 2; ++dt) { const bf16* vr = vct + (dt * 32 + kl) * 128 + 32 * kt + 16 * st + 4 * h;
                const v2u a0 = *(const v2u*)vr, a1 = *(const v2u*)(vr + 8); v4u av; av.x = a0.x; av.y = a0.y; av.z = a1.x; av.w = a1.y;
                Oc[dt] = MFMA32(__builtin_bit_cast(bf16x8, av), ph, Oc[dt]); }
            bf16x8 ov;
#pragma unroll
            for (int j = 0; j < 8; ++j) { const int n = 32 * kt + 16 * st + 8 * (j >> 2) + 4 * h + (j & 3); ov[j] = (n >= 4 * kl - 1 && n <= 4 * kl + 3) ? (short)0x3F80 : (short)0; }
            I = MFMA32(ov, ph, I); I = MFMA32(ov, pl, I);
        }
#pragma unroll
    for (int i = 0; i < 16; ++i) I[i] = sum4(I[i]);
    if (hq == 0) {
#pragma unroll
        for (int i = 0; i < 16; ++i) { const int sb = crow(i, h); scr[tl * 33 + sb] = (sb >= 1 && sb <= ccur - 2) ? I[i] : -INFINITY; }
    }
    LDS_WAIT(); asm volatile("" ::: "memory");
    float v[32];
#pragma unroll
    for (int s = 0; s < 32; ++s) v[s] = scr[tl * 33 + s];
    const int sub = hq + 4 * h;
    unsigned bits = 0u;
#pragma unroll
    for (int k = 0; k < 4; ++k) { const int sk = 4 * sub + k; const float x = scr[tl * 33 + sk]; int cnt = 0;
#pragma unroll
        for (int s = 0; s < 32; ++s) cnt += (v[s] > x || (v[s] == x && s < sk)) ? 1 : 0;
        if (sk >= 1 && sk <= ccur - 2 && cnt < 13) bits |= 1u << sk; }
    LDS_WAIT(); asm volatile("" ::: "memory");
    bits |= dppu<XOR1>(bits); bits |= dppu<XOR2>(bits); bits |= (unsigned)__shfl_xor((int)bits, 32);
    unsigned forced = 1u;
    if (ccur < 32) forced |= 1u << ccur;
    if (ccur >= 1) forced |= 1u << (ccur - 1);
    selmask = bits | forced;
}

constexpr int KV_PITCH = 72;
constexpr int AT_KBUF = 0, AT_VBUF = 2 * 64 * KV_PITCH * 2, AT_BIAS = 2 * AT_VBUF, AT_SCR = AT_BIAS + 2048, AT_OUT = AT_SCR + 8 * 8 * 33 * 4, AT_END = AT_OUT + 8 * 64 * 32 * 4;
template <int MODE>
DI void prompt_branch(Frame& F, const bf16* Kg, const bf16* Vg, int s_lo, int s_hi, int c, int t, unsigned sel, const bf16x8 (&qf)[4], const LAS float* biasT, float gate, LAS float* outw) {
    const int lane = F.lane, kl = lane & 31, h = lane >> 5, hq = kl & 3;
    LAS bf16* Kb = (LAS bf16*)(F.lds + RING_OFF + AT_KBUF); LAS bf16* Vb = (LAS bf16*)(F.lds + RING_OFF + AT_VBUF);
    const int srow = F.tid >> 3, spc = F.tid & 7;
    f32x16 O[2]; float l = 0.f;
#pragma unroll
    for (int i = 0; i < 16; ++i) { O[0][i] = 0.f; O[1][i] = 0.f; }
    const float bfar = biasT[hq * 128 + 127] - SREF;
    v4u kr = *(const v4u*)(Kg + ((size_t)s_lo * 64 + srow) * 64 + spc * 8), vr = *(const v4u*)(Vg + ((size_t)s_lo * 64 + srow) * 64 + spc * 8);
    *(LAS v4u*)(Kb + srow * KV_PITCH + spc * 8) = kr; *(LAS v4u*)(Vb + srow * KV_PITCH + spc * 8) = vr;
    __syncthreads();
    int buf = 0;
    for (int s = s_lo; s <= s_hi; ++s) {
        if (s < s_hi) { kr = *(const v4u*)(Kg + ((size_t)(s + 1) * 64 + srow) * 64 + spc * 8); vr = *(const v4u*)(Vg + ((size_t)(s + 1) * 64 + srow) * 64 + spc * 8); }
        const bool act = (MODE == 1) ? true : (((sel >> s) & 1u) != 0u);
        if (__any(act)) {
            const LAS bf16* kb = Kb + buf * 64 * KV_PITCH; const LAS bf16* vb = Vb + buf * 64 * KV_PITCH;
            const bool near = s >= c - 2;
#pragma unroll
            for (int kt = 0; kt < 2; ++kt) {
                f32x16 S;
#pragma unroll
                for (int i = 0; i < 16; ++i) S[i] = 0.f;
#pragma unroll
                for (int ks = 0; ks < 4; ++ks) { const bf16x8 a = *(const LAS bf16x8*)(kb + (32 * kt + kl) * KV_PITCH + 16 * ks + 8 * h); S = MFMA32(a, qf[ks], S); }
                bf16x8 vf[2][2];
#pragma unroll
                for (int dt = 0; dt < 2; ++dt)
#pragma unroll
                    for (int st = 0; st < 2; ++st) { const LAS bf16* vp = vb + (dt * 32 + kl) * KV_PITCH + 32 * kt + 16 * st + 4 * h;
                        const v2u a0 = *(const LAS v2u*)vp, a1 = *(const LAS v2u*)(vp + 8); v4u av; av.x = a0.x; av.y = a0.y; av.z = a1.x; av.w = a1.y; vf[dt][st] = __builtin_bit_cast(bf16x8, av); }
                const int key0 = 64 * s + 32 * kt;
                if (near) {
                    float bv[16];
#pragma unroll
                    for (int i = 0; i < 16; ++i) { const int dist = t - (key0 + crow(i, h)); const int idx = dist < 0 ? 0 : (dist > 127 ? 127 : dist); bv[i] = biasT[hq * 128 + idx]; }
#pragma unroll
                    for (int i = 0; i < 16; ++i) { const int dist = t - (key0 + crow(i, h)); const bool ok = act && dist >= 0 && (MODE == 0 || dist < WIN); const float v = S[i] * SC2 + (bv[i] - SREF); S[i] = ok ? v : -INFINITY; }
                } else if (MODE == 1 && s == c - 8) {
#pragma unroll
                    for (int i = 0; i < 16; ++i) { const int dist = t - (key0 + crow(i, h)); const float v = S[i] * SC2 + bfar; S[i] = dist < WIN ? v : -INFINITY; }
                } else {
                    const float addc = act ? bfar : -INFINITY;
#pragma unroll
                    for (int i = 0; i < 16; ++i) S[i] = S[i] * SC2 + addc;
                }
                softmax_pv(S, l, O, vf);
            }
        }
        if (s < s_hi) { *(LAS v4u*)(Kb + (buf ^ 1) * 64 * KV_PITCH + srow * KV_PITCH + spc * 8) = kr; *(LAS v4u*)(Vb + (buf ^ 1) * 64 * KV_PITCH + srow * KV_PITCH + spc * 8) = vr; }
        __syncthreads();
        buf ^= 1;
    }
    l = xhalf_sum(l);
    const float sc = l > 0.f ? gate / l : 0.f;
#pragma unroll
    for (int dt = 0; dt < 2; ++dt)
#pragma unroll
        for (int i = 0; i < 16; ++i) outw[(dt * 32 + crow(i, h)) * 32 + kl] += O[dt][i] * sc;
}
DI void attn_prompt_unit(Frame& F, int b, int g, int c, int li) {
    const int w = F.wave, lane = F.lane, kl = lane & 31, h = lane >> 5, hq = kl & 3, tl = kl >> 2, hd = g * 4 + hq;
    LAS float* biasT = (LAS float*)(F.lds + RING_OFF + AT_BIAS); LAS float* scr = (LAS float*)(F.lds + RING_OFF + AT_SCR) + w * 8 * 33;
    fill_bias_table(F, biasT, g);
    const int t = 64 * c + 8 * w + tl, row = b * SEQ + t;
    bf16x8 qf[4];
#pragma unroll
    for (int ks = 0; ks < 4; ++ks) qf[ks] = *(const bf16x8*)(WSP(bf16, WS_QB) + (size_t)row * 512 + hd * 64 + 16 * ks + 8 * h);
    const float* gp = WSP(float, WS_GATE) + (size_t)row * 32 + hd * 3; const float g0 = gp[0], g1 = gp[1], g2 = gp[2];
    __syncthreads();
    unsigned sel;
    LAS float* outw = (LAS float*)(F.lds + RING_OFF + AT_OUT) + w * 2048;
    { f32x16 Oc[2];
      const int cu = 256 + b * 2 + g;
      cmp_branch(qf, WSP(bf16, WS_KC) + (size_t)cu * 8192, WSP(bf16, WS_VCT) + (size_t)cu * 8192, t, c, biasT, lane, scr, Oc, sel);
#pragma unroll
      for (int dt = 0; dt < 2; ++dt)
#pragma unroll
          for (int i = 0; i < 16; ++i) outw[(dt * 32 + crow(i, h)) * 32 + kl] = Oc[dt][i] * g0; }
    const size_t kvo = (size_t)(b * 2 + g) * SEQ * 64;
    prompt_branch<0>(F, WSP(bf16, WS_KS) + kvo, WSP(bf16, WS_VST) + kvo, 0, c, c, t, sel, qf, biasT, g1, outw);
    prompt_branch<1>(F, WSP(bf16, WS_KW) + kvo, WSP(bf16, WS_VWT) + kvo, c > 8 ? c - 8 : 0, c, c, t, sel, qf, biasT, g2, outw);
    bf16* mix = WSP(bf16, WS_MIX) + (size_t)row * DM + hd * 64;
#pragma unroll
    for (int dt = 0; dt < 2; ++dt)
#pragma unroll
        for (int a = 0; a < 4; ++a) { const LAS float* o4 = outw + (dt * 32 + 8 * a + 4 * h) * 32 + kl;
            v2u o; o.x = pk2(o4[0], o4[32]); o.y = pk2(o4[64], o4[96]); *(v2u*)(mix + dt * 32 + 8 * a + 4 * h) = o; }
}

constexpr int SA_BIAS = 0, SA_SCR = 2048, SA_ML = SA_SCR + 8 * 8 * 33 * 4, SA_OUT = SA_ML + 8 * 2 * 32 * 4, SA_RED = SA_OUT + 32 * 64 * 4, SA_END = SA_RED + 8 * 64 * 32 * 4;
struct SampTile { float v[2][2][8]; };
template <int MODE> DI const float* samp_tile_base(Frame& F, const int* pt, int b, int g, int li, int j, int ntile) {
    const bool fresh = (j == ntile - 1);
    if (MODE == 0) return fresh ? OUTF + O_SLCS + ((size_t)(b * 2 + li) * DT) * 256 + g * 64 : KIN(I_CSLC) + (((size_t)pt[j >> 2] * 2 + li) * PAGE + (j & 3) * 32) * 256 + g * 64;
    return fresh ? OUTF + O_WINS + ((size_t)(b * 2 + li) * WIN + (WIN - DT)) * 256 + g * 64 : KIN(I_CWIN) + ((size_t)(b * 2 + li) * WIN + 32 * j) * 256 + g * 64;
}
DI void samp_tile_load(SampTile& T, const float* base, int rmask, int kl, int h) {
#pragma unroll
    for (int st = 0; st < 2; ++st)
#pragma unroll
        for (int jj = 0; jj < 8; ++jj) { const int kr = (16 * st + 8 * (jj >> 2) + 4 * h + (jj & 3)) & rmask; const float* vp = base + (size_t)kr * 256 + 128 + kl; T.v[st][0][jj] = vp[0]; T.v[st][1][jj] = vp[32]; }
}
template <int MODE>
DI void sample_branch(Frame& F, int b, int g, int li, int t, unsigned sel, const bf16x8 (&qf)[4], const LAS float* biasT) {
    const int w = F.wave, lane = F.lane, kl = lane & 31, h = lane >> 5, hq = kl & 3;
    const int ntile = (MODE == 0) ? 65 : 17;
    f32x16 O[2]; float l = 0.f;
#pragma unroll
    for (int i = 0; i < 16; ++i) { O[0][i] = 0.f; O[1][i] = 0.f; }
    const int* pt = (const int*)KIN(I_PT) + b * NPAGE;
    SampTile T;
    samp_tile_load(T, samp_tile_base<MODE>(F, pt, b, g, li, w, ntile), (w == ntile - 1) ? 7 : 31, kl, h);
    for (int j = w; j < ntile; j += NWAVES) {
        const bool fresh = (j == ntile - 1);
        const int pos0 = fresh ? PAST : (MODE == 0 ? 32 * j : PAST - WIN + 32 * j);
        bf16x8 kf[4], vf[2][2];
        { const float* kp = samp_tile_base<MODE>(F, pt, b, g, li, j, ntile) + (size_t)(kl & (fresh ? 7 : 31)) * 256 + 8 * h;
#pragma unroll
          for (int ks = 0; ks < 4; ++ks) { const f32x4 x0 = *(const f32x4*)(kp + 16 * ks), x1 = *(const f32x4*)(kp + 16 * ks + 4); v4u av; av.x = pk2(x0.x, x0.y); av.y = pk2(x0.z, x0.w); av.z = pk2(x1.x, x1.y); av.w = pk2(x1.z, x1.w); kf[ks] = __builtin_bit_cast(bf16x8, av); } }
#pragma unroll
        for (int st = 0; st < 2; ++st)
#pragma unroll
            for (int dt = 0; dt < 2; ++dt) { v4u av; av.x = pk2(T.v[st][dt][0], T.v[st][dt][1]); av.y = pk2(T.v[st][dt][2], T.v[st][dt][3]); av.z = pk2(T.v[st][dt][4], T.v[st][dt][5]); av.w = pk2(T.v[st][dt][6], T.v[st][dt][7]); vf[dt][st] = __builtin_bit_cast(bf16x8, av); }
        if (j + NWAVES < ntile) samp_tile_load(T, samp_tile_base<MODE>(F, pt, b, g, li, j + NWAVES, ntile), (j + NWAVES == ntile - 1) ? 7 : 31, kl, h);
        f32x16 S;
#pragma unroll
        for (int i = 0; i < 16; ++i) S[i] = 0.f;
#pragma unroll
        for (int ks = 0; ks < 4; ++ks) S = MFMA32(kf[ks], qf[ks], S);
        { float bv[16];
#pragma unroll
          for (int i = 0; i < 16; ++i) { const int dist = t - (pos0 + crow(i, h)); const int idx = dist < 0 ? 0 : (dist > 127 ? 127 : dist); bv[i] = biasT[hq * 128 + idx]; }
          const bool blk_ok = (MODE == 1) || fresh || (((sel >> ((j >> 1) & 31)) & 1u) != 0u);
#pragma unroll
          for (int i = 0; i < 16; ++i) { const int ko = crow(i, h); const int dist = t - (pos0 + ko);
            const bool ok = blk_ok && dist >= 0 && (!fresh || ko < DT) && (MODE == 0 || dist < WIN);
            const float v = S[i] * SC2 + (bv[i] - SREF); S[i] = ok ? v : -INFINITY; } }
        softmax_pv(S, l, O, vf);
    }
    l += __shfl_xor(l, 32);
    LAS float* ml = (LAS float*)(F.lds + RING_OFF + SA_ML); LAS float* red = (LAS float*)(F.lds + RING_OFF + SA_RED) + w * 2048;
    if (h == 0) { ml[(w * 2 + 0) * 32 + kl] = 0.f; ml[(w * 2 + 1) * 32 + kl] = l; }
#pragma unroll
    for (int dt = 0; dt < 2; ++dt)
#pragma unroll
        for (int i = 0; i < 16; ++i) red[(dt * 32 + crow(i, h)) * 32 + kl] = O[dt][i];
}
DI void sample_combine(Frame& F, int b, int g, int gi) {
    const LAS float* ml = (const LAS float*)(F.lds + RING_OFF + SA_ML); const LAS float* red = (const LAS float*)(F.lds + RING_OFF + SA_RED);
    LAS float* outF = (LAS float*)(F.lds + RING_OFF + SA_OUT);
    const int q = F.tid & 31, d0 = (F.tid >> 5) * 4;
    float M = NEG_BIG;
#pragma unroll
    for (int w = 0; w < 8; ++w) M = fmaxf(M, ml[(w * 2) * 32 + q]);
    float L = 0.f, o[4] = {0.f, 0.f, 0.f, 0.f};
#pragma unroll
    for (int w = 0; w < 8; ++w) { const float f = fexp2(ml[(w * 2) * 32 + q] - M); L += ml[(w * 2 + 1) * 32 + q] * f;
#pragma unroll
        for (int k = 0; k < 4; ++k) o[k] += red[w * 2048 + (d0 + k) * 32 + q] * f; }
    const int row = MP + b * DT + (q >> 2), hd = g * 4 + (q & 3);
    const float gate = WSP(float, WS_GATE)[(size_t)row * 32 + hd * 3 + gi];
    const float sc = L > 0.f ? gate / L : 0.f;
#pragma unroll
    for (int k = 0; k < 4; ++k) outF[q * 64 + d0 + k] += o[k] * sc;
}
DI void attn_sample_unit(Frame& F, int b, int g, int li) {
    const int w = F.wave, lane = F.lane, kl = lane & 31, h = lane >> 5, hq = kl & 3, tl = kl >> 2, hd = g * 4 + hq;
    LAS float* biasT = (LAS float*)(F.lds + RING_OFF + SA_BIAS); LAS float* scr = (LAS float*)(F.lds + RING_OFF + SA_SCR) + w * 8 * 33;
    LAS float* outF = (LAS float*)(F.lds + RING_OFF + SA_OUT);
    fill_bias_table(F, biasT, g);
    const int t = PAST + tl, row = MP + b * DT + tl;
    bf16x8 qf[4];
#pragma unroll
    for (int ks = 0; ks < 4; ++ks) qf[ks] = *(const bf16x8*)(WSP(bf16, WS_QB) + (size_t)row * 512 + hd * 64 + 16 * ks + 8 * h);
    __syncthreads();
    f32x16 Oc[2]; unsigned sel;
    const int cu = b * 2 + g;
    cmp_branch(qf, WSP(bf16, WS_KC) + (size_t)cu * 8192, WSP(bf16, WS_VCT) + (size_t)cu * 8192, t, 32, biasT, lane, scr, Oc, sel);
    if (w == 0) { const float g0 = WSP(float, WS_GATE)[(size_t)row * 32 + hd * 3];
#pragma unroll
        for (int dt = 0; dt < 2; ++dt)
#pragma unroll
            for (int i = 0; i < 16; ++i) outF[kl * 64 + dt * 32 + crow(i, h)] = Oc[dt][i] * g0; }
    sample_branch<0>(F, b, g, li, t, sel, qf, biasT);
    __syncthreads();
    sample_combine(F, b, g, 1);
    __syncthreads();
    sample_branch<1>(F, b, g, li, t, sel, qf, biasT);
    __syncthreads();
    sample_combine(F, b, g, 2);
    __syncthreads();
    { const int q = F.tid >> 4, d4 = (F.tid & 15) * 4; const LAS float* s = outF + q * 64 + d4;
      v2u o; o.x = pk2(s[0], s[1]); o.y = pk2(s[2], s[3]);
      *(v2u*)(WSP(bf16, WS_MIX) + (size_t)(MP + b * DT + (q >> 2)) * DM + (g * 4 + (q & 3)) * 64 + d4) = o; }
    __syncthreads();
}

constexpr int SCN_STEPS = 32, SCN_CH = SCN_STEPS * 384 * 4  , SCN_Y = 2 * SCN_CH, SCN_END = SCN_Y + 2 * SCN_STEPS * 32 * 4;
struct ScanOps { f32x4 w0, w1, k0, k1, b0, b1, m0, m1, r0, r1; float v; };
DI ScanOps scan_ld(const LAS float* ch, int st, int cj, int irow) { const LAS float* c = ch + st * 384 + cj * 8; ScanOps o;
    o.w0 = *(const LAS f32x4*)(c); o.w1 = *(const LAS f32x4*)(c + 4); o.k0 = *(const LAS f32x4*)(c + 64); o.k1 = *(const LAS f32x4*)(c + 68); o.b0 = *(const LAS f32x4*)(c + 128); o.b1 = *(const LAS f32x4*)(c + 132);
    o.m0 = *(const LAS f32x4*)(c + 192); o.m1 = *(const LAS f32x4*)(c + 196); o.r0 = *(const LAS f32x4*)(c + 256); o.r1 = *(const LAS f32x4*)(c + 260); o.v = ch[st * 384 + 320 + irow]; return o; }
DI float dot8(const f32x4 a0, const f32x4 a1, const f32x4 b0, const f32x4 b1) { const f32x4 p = a0 * b0 + a1 * b1; return (p.x + p.y) + (p.z + p.w); }
DI float scan_step(f32x4& s0, f32x4& s1, const ScanOps& o) {
    float sa = dot8(s0, s1, o.k0, o.k1);
    const f32x4 t0 = s0 * o.w0 + o.m0 * o.v, t1 = s1 * o.w1 + o.m1 * o.v;
    sa = sum8(sa);
    s0 = t0 - o.b0 * sa; s1 = t1 - o.b1 * sa;
    return sum8(dot8(s0, s1, o.r0, o.r1));
}
struct ScanRaw { f32x4 w; v2u b[5]; };
DI void scan_stage_load(const unsigned char* rec, int c4, ScanRaw& pre) { pre.w = *(const f32x4*)(rec + 16 * c4);
#pragma unroll
    for (int k = 0; k < 5; ++k) pre.b[k] = *(const v2u*)(rec + SCR_KK + 128 * k + 8 * c4); }
DI f32x4 unpk4(const v2u w) { return (f32x4){bflo(w.x), bfhi(w.x), bflo(w.y), bfhi(w.y)}; }
DI void scan_stage_store(LAS float* rec, int c4, const ScanRaw& pre, const f32x4 ka) { LAS float* p = rec + 4 * c4;
    const f32x4 kk = unpk4(pre.b[0]), a = unpk4(pre.b[1]), k = unpk4(pre.b[2]);
    *(LAS f32x4*)(p) = pre.w; *(LAS f32x4*)(p + 64) = kk; *(LAS f32x4*)(p + 128) = kk * a; *(LAS f32x4*)(p + 192) = k * ((a - 1.0f) * ka + 1.0f); *(LAS f32x4*)(p + 256) = unpk4(pre.b[3]); *(LAS f32x4*)(p + 320) = unpk4(pre.b[4]); }
DI void scan_prompt_unit(Frame& F, int b, int h, int half, int li) {
    const int w = F.wave, lane = F.lane, ri = lane >> 3, cj = lane & 7, lrow = (8 * w + ri) & 31, irow = half * 32 + lrow;
    LAS float* chb = (LAS float*)(F.lds + RING_OFF); LAS float* ybb = (LAS float*)(F.lds + RING_OFF + SCN_Y);
    float* YR = WSP(float, WS_YRAW);
    f32x4 s0 = (f32x4){0.f, 0.f, 0.f, 0.f}, s1 = s0;
    const int ht = F.tid & 255;
    const f32x4 kav0 = *(const f32x4*)(KIN(I_KA) + (size_t)li * 512 + h * 64 + 4 * (ht & 15));
    { ScanRaw pre; const int stk = F.tid >> 4, sc4 = F.tid & 15;
      const f32x4 kav = *(const f32x4*)(KIN(I_KA) + (size_t)li * 512 + h * 64 + 4 * sc4);
      scan_stage_load(SCREC(b * SEQ + stk, h), sc4, pre); scan_stage_store(chb + stk * 384, sc4, pre, kav); }
    __syncthreads();
    constexpr int NCH = SEQ / SCN_STEPS;
    for (int cix = 0; cix < NCH; ++cix) {
        const LAS float* ch = chb + (cix & 1) * (SCN_CH / 4);
        LAS float* yb = ybb + (cix & 1) * (SCN_STEPS * 32);
        if (w < 4) {
            ScanOps A = scan_ld(ch, 0, cj, irow);
            for (int st = 0; st < SCN_STEPS; st += 2) {
                const ScanOps B = scan_ld(ch, st + 1, cj, irow);
                const float y0 = scan_step(s0, s1, A);
                A = scan_ld(ch, st + 2 < SCN_STEPS ? st + 2 : st + 1, cj, irow);
                const float y1 = scan_step(s0, s1, B);
                if (cj == 0) { yb[st * 32 + lrow] = y0; yb[(st + 1) * 32 + lrow] = y1; }
            }
        } else {
            ScanRaw p0, p1;
            if (cix + 1 < NCH) { scan_stage_load(SCREC(b * SEQ + (cix + 1) * SCN_STEPS + (ht >> 4), h), ht & 15, p0); scan_stage_load(SCREC(b * SEQ + (cix + 1) * SCN_STEPS + 16 + (ht >> 4), h), ht & 15, p1); }
            if (cix > 0) { const LAS float* yp = ybb + ((cix - 1) & 1) * (SCN_STEPS * 32);
                const int st = ht >> 3, r4 = (ht & 7) * 4; const f32x4 yv = *(const LAS f32x4*)(yp + st * 32 + r4);
                *(f32x4*)(YR + (size_t)(b * SEQ + (cix - 1) * SCN_STEPS + st) * 512 + h * 64 + half * 32 + r4) = yv; }
            if (cix + 1 < NCH) { LAS float* nb = chb + ((cix + 1) & 1) * (SCN_CH / 4); scan_stage_store(nb + (ht >> 4) * 384, ht & 15, p0, kav0); scan_stage_store(nb + (16 + (ht >> 4)) * 384, ht & 15, p1, kav0); }
        }
        __syncthreads();
    }
    { const LAS float* yp = ybb + ((NCH - 1) & 1) * (SCN_STEPS * 32);
      const int st = F.tid >> 4, r2 = (F.tid & 15) * 2; const f32x2 yv = *(const LAS f32x2*)(yp + st * 32 + r2);
      *(f32x2*)(YR + (size_t)(b * SEQ + (NCH - 1) * SCN_STEPS + st) * 512 + h * 64 + half * 32 + r2) = yv; }
    if (w < 4) { float* so = OUTF + O_WKVP + ((size_t)((b * 2 + li) * 8 + h) * 64 + irow) * 64 + cj * 8; *(f32x4*)so = s0; *(f32x4*)(so + 4) = s1; }
}
DI void scan_post_phase(Frame& F, int li) {
    const float* YR = WSP(float, WS_YRAW);
    const int i0 = (F.tid & 15) * 4;
    for (int it0 = F.bid * (NTHREADS / 16) + (F.tid >> 4); it0 < MP * 8; it0 += 2 * F.G * (NTHREADS / 16)) {
        f32x4 y[2], r[2], kraw[2], av[2], v[2], gg[2];
#pragma unroll
        for (int q = 0; q < 2; ++q) { const int it = it0 + q * F.G * (NTHREADS / 16), row = it >> 3, h = it & 7; const unsigned char* c = SCREC(row, h) + i0 * 2;
            y[q] = *(const f32x4*)(YR + (size_t)row * 512 + h * 64 + i0); r[q] = unpk4(*(const v2u*)(c + SCR_R)); kraw[q] = unpk4(*(const v2u*)(c + SCR_K)); av[q] = unpk4(*(const v2u*)(c + SCR_A)); v[q] = unpk4(*(const v2u*)(c + SCR_V));
            gg[q] = *(const f32x4*)(WSP(float, WS_G) + (size_t)row * 512 + h * 64 + i0); }
#pragma unroll
        for (int q = 0; q < 2; ++q) { const int it = it0 + q * F.G * (NTHREADS / 16), row = it >> 3, h = it & 7;
            const float mu = sum16((y[q].x + y[q].y) + (y[q].z + y[q].w)) * (1.f / 64.f);
            const f32x4 dv = y[q] - mu;
            const float var = sum16((dv.x * dv.x + dv.y * dv.y) + (dv.z * dv.z + dv.w * dv.w)) * (1.f / 64.f);
            const float rs = __builtin_amdgcn_rsqf(var + GN_EPS);
            const f32x4 km = kraw[q] * ((av[q] - 1.0f) * *(const f32x4*)(KIN(I_KA) + (size_t)li * 512 + h * 64 + i0) + 1.0f);
            const f32x4 rk = *(const f32x4*)(KIN(I_RK) + (size_t)(li * 8 + h) * 64 + i0);
            const float bon = sum16((r[q].x * km.x * rk.x + r[q].y * km.y * rk.y) + (r[q].z * km.z * rk.z + r[q].w * km.w * rk.w));
            const f32x4 lw = *(const f32x4*)(KIN(I_LNW) + (size_t)li * 512 + h * 64 + i0), lb = *(const f32x4*)(KIN(I_LNB) + (size_t)li * 512 + h * 64 + i0);
            const f32x4 o = (dv * rs * lw + lb + v[q] * bon) * gg[q];
            v2u pk; pk.x = pk2(o.x, o.y); pk.y = pk2(o.z, o.w);
            *(v2u*)(WSP(bf16, WS_MIX) + (size_t)row * DM + 512 + h * 64 + i0) = pk; }
    }
}
DI void scan_sample_unit(Frame& F, int b, int li) {
    const int h = F.wave, lane = F.lane;
    LAS float* ch = (LAS float*)(F.lds + RING_OFF) + h * (DT * 384);
    LAS float* yb = (LAS float*)(F.lds + RING_OFF + 8 * DT * 384 * 4) + h * (DT * 64);
#pragma unroll
    for (int k = 0; k < 2; ++k) { const int it = lane + 64 * k, tk = it >> 4, c4 = it & 15; ScanRaw pre;
        scan_stage_load(SCREC(MP + b * DT + tk, h), c4, pre);
        scan_stage_store(ch + tk * 384, c4, pre, *(const f32x4*)(KIN(I_KA) + (size_t)li * 512 + h * 64 + 4 * c4)); }
    float s[64];
    const float* s0 = KIN(I_SWKV) + ((size_t)((b * 2 + li) * 8 + h) * 64 + lane) * 64;
#pragma unroll
    for (int j = 0; j < 16; ++j) { const f32x4 x = ((const f32x4*)s0)[j]; s[4 * j] = x.x; s[4 * j + 1] = x.y; s[4 * j + 2] = x.z; s[4 * j + 3] = x.w; }
    LDS_WAIT(); asm volatile("" ::: "memory");
    for (int st = 0; st < DT; ++st) {
        const LAS float* c = ch + st * 384;
        float sa = 0.f;
#pragma unroll
        for (int j = 0; j < 64; ++j) sa += s[j] * c[64 + j];
        sa = -sa;
        const float v = c[320 + lane];
        float y = 0.f;
#pragma unroll
        for (int j = 0; j < 64; ++j) { s[j] = s[j] * c[j] + sa * c[128 + j] + v * c[192 + j]; y += s[j] * c[256 + j]; }
        yb[st * 64 + lane] = y;
    }
    float* so = OUTF + O_WKVS + ((size_t)((b * 2 + li) * 8 + h) * 64 + lane) * 64;
#pragma unroll
    for (int j = 0; j < 16; ++j) ((f32x4*)so)[j] = (f32x4){s[4 * j], s[4 * j + 1], s[4 * j + 2], s[4 * j + 3]};
    LDS_WAIT(); asm volatile("" ::: "memory");
#pragma unroll
    for (int ps = 0; ps < 2; ++ps) {
        const int tok = ps * 4 + (lane >> 4), i0 = (lane & 15) * 4;
        const LAS float* c = ch + tok * 384;
        const f32x4 y = *(const LAS f32x4*)(yb + tok * 64 + i0);
        const float mu = sum16((y.x + y.y) + (y.z + y.w)) * (1.f / 64.f);
        const f32x4 dv = y - mu;
        const float var = sum16((dv.x * dv.x + dv.y * dv.y) + (dv.z * dv.z + dv.w * dv.w)) * (1.f / 64.f);
        const float rs = 1.0f / sqrtf(var + GN_EPS);
        const f32x4 r = *(const LAS f32x4*)(c + 4 * 64 + i0), km = *(const LAS f32x4*)(c + 3 * 64 + i0), v = *(const LAS f32x4*)(c + 5 * 64 + i0);
        const f32x4 rk = *(const f32x4*)(KIN(I_RK) + (size_t)(li * 8 + h) * 64 + i0);
        const float bon = sum16((r.x * km.x * rk.x + r.y * km.y * rk.y) + (r.z * km.z * rk.z + r.w * km.w * rk.w));
        const f32x4 lw = *(const f32x4*)(KIN(I_LNW) + (size_t)li * 512 + h * 64 + i0), lb = *(const f32x4*)(KIN(I_LNB) + (size_t)li * 512 + h * 64 + i0);
        const int row = MP + b * DT + tok;
        const f32x4 gg = *(const f32x4*)(WSP(float, WS_G) + (size_t)row * 512 + h * 64 + i0);
        const f32x4 o = (dv * rs * lw + lb + v * bon) * gg;
        v2u pk; pk.x = pk2(o.x, o.y); pk.y = pk2(o.z, o.w);
        *(v2u*)(WSP(bf16, WS_MIX) + (size_t)row * DM + 512 + h * 64 + i0) = pk;
    }
    __syncthreads();
}

extern __shared__ __attribute__((aligned(16))) unsigned char g_lds[];
DI int take_ticket(Frame& F, int word) {
    volatile LAS unsigned* tk = F.MISC + 16;
    __syncthreads();
    if (F.tid == 0) tk[0] = __hip_atomic_fetch_add((unsigned*)(F.ctl + word), 1u, RLX_AGENT);
    __syncthreads();
    return __builtin_amdgcn_readfirstlane((int)tk[0]);
}

struct EpiStoreBf16 { static constexpr int PID = 16;
    static constexpr bool PERM = true, AFTER_DRAIN = false;
    bf16* O; int ldc;
    DI void operator()(const f32x4 (&acc)[2][2][4][2], const pg8::Unit& u, int wr, int wc, int fr, int fq) const {
        const int row0 = u.pm * 256 + wr * 64 + fr, col0 = u.pn * 256 + wc * 32 + 8 * fq;
#pragma unroll
        for (int ai = 0; ai < 2; ++ai)
#pragma unroll
            for (int m = 0; m < 4; ++m) { bf16* rowp = O + (size_t)(row0 + ai * 128 + m * 16) * ldc + col0;
#pragma unroll
                for (int bj = 0; bj < 2; ++bj) { const f32x4 v0 = acc[ai][bj][m][0], v1 = acc[ai][bj][m][1];
                    v4u w; w.x = pk2(v0[0], v0[1]); w.y = pk2(v0[2], v0[3]); w.z = pk2(v1[0], v1[1]); w.w = pk2(v1[2], v1[3]);
                    *(v4u*)(rowp + bj * 128) = w; } }
    }
};
struct EpiPart { static constexpr int PID = 20;
    static constexpr bool PERM = false, AFTER_DRAIN = false;
    float* C;
    DI void operator()(const f32x4 (&acc)[2][2][4][2], const pg8::Unit& u, int wr, int wc, int fr, int fq) const {
        const int row0 = u.pm * 256 + wr * 64 + fr, col0 = wc * 32 + 4 * fq;
#pragma unroll
        for (int ai = 0; ai < 2; ++ai)
#pragma unroll
            for (int m = 0; m < 4; ++m) { float* rowp = C + (size_t)(row0 + ai * 128 + m * 16) * 256 + col0;
#pragma unroll
                for (int bj = 0; bj < 2; ++bj)
#pragma unroll
                    for (int n = 0; n < 2; ++n) *(f32x4*)(rowp + bj * 128 + n * 16) = acc[ai][bj][m][n]; }
    }
};
struct EpiResid { static constexpr int PID = 18;
    static constexpr bool PERM = false, AFTER_DRAIN = false;
    const float* baseF;
    bf16* XB; float* Xout;
    unsigned long long* ssq;
    DI void operator()(const f32x4 (&acc)[2][2][4][2], const pg8::Unit& u, int wr, int wc, int fr, int fq) const {
        const int row0 = u.pm * 256 + wr * 64 + fr, col0 = u.pn * 256 + wc * 32 + 4 * fq;
        if (baseF) {
#pragma unroll
            for (int ai = 0; ai < 2; ++ai)
#pragma unroll
                for (int m = 0; m < 4; ++m) { const int row = row0 + ai * 128 + m * 16; const size_t off = (size_t)row * DM + col0; float sq = 0.f;
#pragma unroll
                    for (int bj = 0; bj < 2; ++bj)
#pragma unroll
                        for (int n = 0; n < 2; ++n) { const size_t o2 = off + bj * 128 + n * 16; const f32x4 x = *(const f32x4*)(baseF + o2) + acc[ai][bj][m][n];
                            v2u o; o.x = pk2(x[0], x[1]); o.y = pk2(x[2], x[3]); *(v2u*)(XB + o2) = o; sq += (x[0] * x[0] + x[1] * x[1]) + (x[2] * x[2] + x[3] * x[3]); }
                    sq += __shfl_xor(sq, 16); sq += __shfl_xor(sq, 32); if (fq == 0) __hip_atomic_fetch_add(ssq + row, (unsigned long long)(sq * SSQ_SCALE + 0.5f), RLX_AGENT);
                    if (m & 1) asm volatile("" ::: "memory"); }
            return;
        }
        v2u bw[2][4][2][2];
#pragma unroll
        for (int ai = 0; ai < 2; ++ai)
#pragma unroll
            for (int m = 0; m < 4; ++m)
#pragma unroll
                for (int bj = 0; bj < 2; ++bj)
#pragma unroll
                    for (int n = 0; n < 2; ++n) bw[ai][m][bj][n] = *(const v2u*)(XB + (size_t)(row0 + ai * 128 + m * 16) * DM + col0 + bj * 128 + n * 16);
#pragma unroll
        for (int ai = 0; ai < 2; ++ai)
#pragma unroll
            for (int m = 0; m < 4; ++m) { const int row = row0 + ai * 128 + m * 16; const size_t off = (size_t)row * DM + col0; float sq = 0.f;
#pragma unroll
                for (int bj = 0; bj < 2; ++bj)
#pragma unroll
                    for (int n = 0; n < 2; ++n) { const size_t o2 = off + bj * 128 + n * 16; const v2u wv = bw[ai][m][bj][n];
                        const f32x4 x = (f32x4){bflo(wv.x), bfhi(wv.x), bflo(wv.y), bfhi(wv.y)} + acc[ai][bj][m][n];
                        if (Xout) *(f32x4*)(Xout + o2) = x;
                        else { v2u o; o.x = pk2(x[0], x[1]); o.y = pk2(x[2], x[3]); *(v2u*)(XB + o2) = o; sq += (x[0] * x[0] + x[1] * x[1]) + (x[2] * x[2] + x[3] * x[3]); } }
                if (!Xout) { sq += __shfl_xor(sq, 16); sq += __shfl_xor(sq, 32); if (fq == 0) __hip_atomic_fetch_add(ssq + row, (unsigned long long)(sq * SSQ_SCALE + 0.5f), RLX_AGENT); } }
    }
};
struct EpiLora { static constexpr int PID = 19;
    static constexpr bool PERM = false, AFTER_DRAIN = false;
    unsigned char* SC; float* G; const float *w0, *a0;
    DI void operator()(const f32x4 (&acc)[2][2][4][2], const pg8::Unit& u, int wr, int wc, int fr, int fq) const {
        const int row0 = u.pm * 256 + wr * 64 + fr, seg = u.pn >> 1, cb = (u.pn & 1) * 256 + wc * 32 + 4 * fq;
#pragma unroll
        for (int bj = 0; bj < 2; ++bj)
#pragma unroll
            for (int n = 0; n < 2; ++n) {
                const int colh = cb + bj * 128 + n * 16, h = colh >> 6, d = colh & 63;
                f32x4 c0 = (f32x4){0.f, 0.f, 0.f, 0.f};
                if (seg == 0) c0 = *(const f32x4*)(w0 + colh); else if (seg == 1) c0 = *(const f32x4*)(a0 + colh);
#pragma unroll
                for (int ai = 0; ai < 2; ++ai)
#pragma unroll
                    for (int m = 0; m < 4; ++m) { const int row = row0 + ai * 128 + m * 16; const f32x4 a = acc[ai][bj][m][n];
                        unsigned char* scb = SC + ((size_t)row * 8 + h) * SCR_BYTES;
                        if (seg == 0) { f32x4 o;
#pragma unroll
                            for (int i = 0; i < 4; ++i) { const float y = -(c0[i] + a[i]); const float sp = fmaxf(y, 0.f) + __logf(1.0f + __expf(-fabsf(y))); o[i] = __expf(-__expf(-sp - 0.5f)); }
                            *(f32x4*)(scb + d * 4) = o; }
                        else if (seg == 1) { f32x4 o;
#pragma unroll
                            for (int i = 0; i < 4; ++i) o[i] = sigmoidf_(c0[i] + a[i]);
                            v2u ob; ob.x = pk2(o[0], o[1]); ob.y = pk2(o[2], o[3]); *(v2u*)(scb + SCR_A + d * 2) = ob; }
                        else *(f32x4*)(G + (size_t)row * 512 + colh) = a;
                    }
            }
    }
};
template <int CTRL> DI f32x4 dpp4(const f32x4 v) { return (f32x4){dppf<CTRL>(v.x), dppf<CTRL>(v.y), dppf<CTRL>(v.z), dppf<CTRL>(v.w)}; }
template <int CTRL> DI float dppf_old(float old, float x) { return __builtin_bit_cast(float, __builtin_amdgcn_update_dpp(__builtin_bit_cast(int, old), __builtin_bit_cast(int, x), CTRL, 0xf, 0xf, false)); }
template <int CTRL> DI f32x4 dpp4_old(const f32x4 o, const f32x4 v) { return (f32x4){dppf_old<CTRL>(o.x, v.x), dppf_old<CTRL>(o.y, v.y), dppf_old<CTRL>(o.z, v.z), dppf_old<CTRL>(o.w, v.w)}; }
DI f32x4 silu4_mul(const f32x4 y, const f32x4 u) { return (f32x4){y.x * sigmoidf_(y.x) * u.x, y.y * sigmoidf_(y.y) * u.y, y.z * sigmoidf_(y.z) * u.z, y.w * sigmoidf_(y.w) * u.w}; }
struct EpiFfnAct { static constexpr int PID = 17;
    static constexpr bool PERM = false, AFTER_DRAIN = false;
    bf16* H; float* HALO; const float* cw  ; const unsigned long long* ssq; const float* state  ; float* outP; float* outS; int l;
    DI void operator()(const f32x4 (&acc)[2][2][4][2], const pg8::Unit& u, int wr, int wc, int fr, int fq) const {
        const bool samp = u.pm >= MP / 256;
        float rinv[2][4];
#pragma unroll
        for (int ai = 0; ai < 2; ++ai)
#pragma unroll
            for (int m = 0; m < 4; ++m) rinv[ai][m] = rinv_of(ssq, u.pm * 256 + ai * 128 + wr * 64 + m * 16 + fr);
#pragma unroll
        for (int n = 0; n < 2; ++n) {
            const int ch = u.pn * 128 + wc * 32 + 16 * n + 4 * fq;
            const f32x4 w0 = *(const f32x4*)(cw + ch), w1 = *(const f32x4*)(cw + DFF + ch), w2 = *(const f32x4*)(cw + 2 * DFF + ch);
#pragma unroll
            for (int ai = 0; ai < 2; ++ai) {
                f32x4 pa = (f32x4){0.f, 0.f, 0.f, 0.f};
#pragma unroll
                for (int m = 0; m < 4; ++m) {
                    const int row = u.pm * 256 + ai * 128 + wr * 64 + m * 16 + fr;
                    const float rin = rinv[ai][m];
                    const f32x4 a = acc[ai][0][m][n] * rin, uu = acc[ai][1][m][n] * rin;
                    const f32x4 r1 = dpp4<0x121>(pa), r2 = dpp4<0x122>(pa);
                    f32x4 a1 = dpp4_old<0x111>(r1, a), a2 = dpp4_old<0x112>(r2, a);
                    if (samp) { const int t = fr & 7, b = (row - MP) >> 3;
                        if (t < 2) { const float* st = state + (size_t)b * (4 * 2 * DFF) + ch; const f32x4 st0 = *(const f32x4*)st, st1 = *(const f32x4*)(st + DFF);
                            if (t == 0) { a1 = st1; a2 = st0; } else a2 = st1; }
                        if (t >= 6) *(f32x4*)(outS + ((size_t)(b * 4 + l) * 2 + (t - 6)) * DFF + ch) = a;
                    } else {
                        const int blk = row >> 6;
                        if (m == 3) { if (fr >= 14) { *(f32x4*)(HALO + ((size_t)blk * 6 + (fr - 14)) * DFF + ch) = a;
                            if ((row & (SEQ - 1)) >= SEQ - 2) *(f32x4*)(outP + ((size_t)((row >> 11) * 4 + l) * 2 + ((row & (SEQ - 1)) - (SEQ - 2))) * DFF + ch) = a; } }
                        if (m == 0) { if (fr < 2) { *(f32x4*)(HALO + ((size_t)blk * 6 + 2 + fr) * DFF + ch) = a; *(f32x4*)(HALO + ((size_t)blk * 6 + 4 + fr) * DFF + ch) = uu; } }
                    }
                    const f32x4 y = w0 * a2 + w1 * a1 + w2 * a;
                    const f32x4 hv = silu4_mul(y, uu);
                    v2u o; o.x = pk2(hv.x, hv.y); o.y = pk2(hv.z, hv.w);
                    *(v2u*)(H + (size_t)row * DFF + ch) = o;
                    pa = a;
                }
            }
        }
    }
};
DI void ffn_fix_panel(Frame& F, int l, int pm) {
    const float* HALO = WSP(float, WS_HALO); const float* cw = KIN(I_FCONV) + (size_t)l * 3 * DFF; bf16* H = WSP(bf16, WS_H);
    constexpr int NC4 = DFF / 4;
    for (int it = F.tid; it < 4 * 2 * NC4; it += NTHREADS) {
        const int ch = (it % NC4) * 4, bj = it / NC4, blk = pm * 4 + (bj >> 1), j = bj & 1; const bool s0 = (blk & 31) == 0;
        const f32x4 z = (f32x4){0.f, 0.f, 0.f, 0.f};
        const f32x4 a = *(const f32x4*)(HALO + ((size_t)blk * 6 + 2 + j) * DFF + ch), uu = *(const f32x4*)(HALO + ((size_t)blk * 6 + 4 + j) * DFF + ch);
        f32x4 a1, a2;
        if (j == 1) { a1 = *(const f32x4*)(HALO + ((size_t)blk * 6 + 2) * DFF + ch); a2 = s0 ? z : *(const f32x4*)(HALO + ((size_t)(blk - 1) * 6 + 1) * DFF + ch); }
        else { a1 = s0 ? z : *(const f32x4*)(HALO + ((size_t)(blk - 1) * 6 + 1) * DFF + ch); a2 = s0 ? z : *(const f32x4*)(HALO + ((size_t)(blk - 1) * 6 + 0) * DFF + ch); }
        const f32x4 w0 = *(const f32x4*)(cw + ch), w1 = *(const f32x4*)(cw + DFF + ch), w2 = *(const f32x4*)(cw + 2 * DFF + ch);
        const f32x4 hv = silu4_mul(w0 * a2 + w1 * a1 + w2 * a, uu);
        v2u o; o.x = pk2(hv.x, hv.y); o.y = pk2(hv.z, hv.w);
        *(v2u*)(H + (size_t)(blk * 64 + j) * DFF + ch) = o;
    }
    asm volatile("s_waitcnt vmcnt(0)" ::: "memory"); __syncthreads();
    if (F.tid == 0) { __builtin_amdgcn_fence(__ATOMIC_ACQUIRE, "agent"); asm volatile("s_waitcnt vmcnt(0)" ::: "memory"); }
    __syncthreads();
}
template <int K> DI void gemm64_sample_phase(Frame& F, const bf16* A  , const bf16* Bt  , const float* baseF  , bf16* XB, float* Xout  , unsigned long long* ssq) {
    static_assert(K % 128 == 0, "K split over 8 waves in 16-wide steps");
    constexpr int KW = K / 8, NS = KW / 16;
    const int w = F.wave, lane = F.lane, kl = lane & 31, h = lane >> 5;
    LAS float* part = (LAS float*)(F.lds + RING_OFF);
    for (int tile = F.bid; tile < 256; tile += F.G) {
        const int x = tile & 7, r = tile >> 3, tm = 4 * (x & 3) + (r & 3), tn = 8 * (x >> 2) + (r >> 2);
        const bf16* ap = A + (size_t)(tm * 64 + kl) * K + w * KW + 8 * h; const bf16* bp = Bt + (size_t)(tn * 64 + kl) * K + w * KW + 8 * h;
        f32x16 acc[2][2];
#pragma unroll
        for (int i = 0; i < 16; ++i) { acc[0][0][i] = 0.f; acc[0][1][i] = 0.f; acc[1][0][i] = 0.f; acc[1][1][i] = 0.f; }
#pragma unroll 8
        for (int s = 0; s < NS; ++s) {
            const bf16x8 a0 = *(const bf16x8*)(ap + 16 * s), a1 = *(const bf16x8*)(ap + (size_t)32 * K + 16 * s);
            const bf16x8 b0 = *(const bf16x8*)(bp + 16 * s), b1 = *(const bf16x8*)(bp + (size_t)32 * K + 16 * s);
            acc[0][0] = MFMA32(a0, b0, acc[0][0]); acc[0][1] = MFMA32(a0, b1, acc[0][1]); acc[1][0] = MFMA32(a1, b0, acc[1][0]); acc[1][1] = MFMA32(a1, b1, acc[1][1]);
        }
        __syncthreads();
#pragma unroll
        for (int rb = 0; rb < 2; ++rb)
#pragma unroll
            for (int cb = 0; cb < 2; ++cb)
#pragma unroll
                for (int i = 0; i < 16; ++i) part[w * 4096 + (rb * 32 + crow(i, h)) * 64 + cb * 32 + kl] = acc[rb][cb][i];
        __syncthreads();
        { const int r = F.tid >> 3, c0 = (F.tid & 7) * 8; float o[8];
#pragma unroll
          for (int j = 0; j < 8; ++j) o[j] = 0.f;
#pragma unroll
          for (int ww = 0; ww < 8; ++ww) { const f32x4 p0 = *(const LAS f32x4*)(part + ww * 4096 + r * 64 + c0), p1 = *(const LAS f32x4*)(part + ww * 4096 + r * 64 + c0 + 4);
              o[0] += p0.x; o[1] += p0.y; o[2] += p0.z; o[3] += p0.w; o[4] += p1.x; o[5] += p1.y; o[6] += p1.z; o[7] += p1.w; }
          const int row = tm * 64 + r; const size_t off = (size_t)row * DM + tn * 64 + c0;
          float bsv[8]; if (baseF) ld8f(baseF + off, bsv); else ld8bf(XB + off, bsv); float sq = 0.f;
#pragma unroll
          for (int j = 0; j < 8; ++j) { o[j] += bsv[j]; sq += o[j] * o[j]; }
          if (Xout) store8f(Xout + off, o);
          else { v4u pk; pk.x = pk2(o[0], o[1]); pk.y = pk2(o[2], o[3]); pk.z = pk2(o[4], o[5]); pk.w = pk2(o[6], o[7]); *(v4u*)(XB + off) = pk;
              sq = sum8(sq); if ((F.tid & 7) == 0) __hip_atomic_fetch_add(ssq + row, (unsigned long long)(sq * SSQ_SCALE + 0.5f), RLX_AGENT); }
        }
    }
    __syncthreads();
}
struct CmpOrder {
    int G, c;
    DI bool next(int i, pg8::Unit& u) const { const int L = i * G + c; if (L >= CS_ROWS / 256) return false; u.pm = L; u.pn = (L < 128) ? 0 : (L < 256 ? 1 : (L < 264 ? 0 : 1)); return true; }
    DI void a_ready(const pg8::Unit&) const {}
    DI void done(const pg8::Unit&) const {}
};

#ifndef REPSCAN
#define REPSCAN 1
#endif
#ifndef REPATP
#define REPATP 1
#endif
#ifndef REPATS
#define REPATS 1
#endif
DI void sub_barrier(Frame& F, int word, unsigned n, int mode  ) {
    asm volatile("s_waitcnt vmcnt(0)" ::: "memory");
    __syncthreads();
    if (F.tid == 0) {
        unsigned* w = (unsigned*)(F.ctl + word);
        if (mode != 1) { __builtin_amdgcn_fence(__ATOMIC_RELEASE, "agent"); asm volatile("s_waitcnt vmcnt(0)" ::: "memory"); __hip_atomic_fetch_add(w, 1u, RLX_AGENT); }
        unsigned sp = 0;
        while (mode != 2 && __hip_atomic_load(w, RLX_AGENT) < n) { __builtin_amdgcn_s_sleep(2); if (++sp > (1u << 22)) { __hip_atomic_store(F.ctl + CW_TMO, 0xDEAD0000u | (unsigned)word, RLX_AGENT); break; } }
        __builtin_amdgcn_fence(__ATOMIC_ACQUIRE, "agent");
        asm volatile("s_waitcnt vmcnt(0)" ::: "memory");
    }
    __syncthreads();
}
struct CmpOwnOrder {
    int r;
    DI bool next(int i, pg8::Unit& u) const { if (i == 0) { u.pm = r; u.pn = 0; return true; } if (i == 1) { u.pm = 128 + r; u.pn = 1; return true; }
        if (i == 2 && r < 16) { u.pm = 256 + r; u.pn = r >> 3; return true; } return false; }
    DI void a_ready(const pg8::Unit&) const {}
    DI void done(const pg8::Unit&) const {}
};
DI void mix_even_phase(Frame& F, int li, int rep) {
    const int qw = CW_QUEUE + 256 * li + 1024 * rep, sw = 2048 + 256 * (li * 2 + rep);
    const int NSC = 128;
    const int t0 = take_ticket(F, qw);
    if (t0 < NSC) { LAUNDER(F); PROBE_T0(1) scan_prompt_unit(F, t0 >> 4, (t0 >> 1) & 7, t0 & 1, li); PROBE_T1(1)
        sub_barrier(F, sw + 128, (unsigned)NSC, 2); }
    else {
        const int rank = t0 - NSC; LAUNDER(F);
        { pg8::Gemm g{WSP(bf16, WS_CSEG), WSP(bf16, WS_PHI1) + (size_t)li * 512 * 1024, CS_ROWS, 512, 1024};
          CmpOwnOrder S{rank}; EpiPart E{WSP(float, WS_PART)};
          pg8::gemm_phase<EpiPart, CmpOwnOrder, true, true>(F.lds + RING_OFF, g, S, E); }
        if (rank < 16) sub_barrier(F, sw, 16u, 2);
        asm volatile("s_waitcnt vmcnt(0)" ::: "memory"); __syncthreads();
        if (F.tid == 0) { __builtin_amdgcn_fence(__ATOMIC_ACQUIRE, "agent"); asm volatile("s_waitcnt vmcnt(0)" ::: "memory"); }
        __syncthreads(); LAUNDER(F);
        compress2_stage_w2(F, li);
        compress2_unit(F, 2 * rank, li); compress2_unit(F, 2 * rank + 1, li);
        if (rank < 16) { sub_barrier(F, sw, 16u, 1); LAUNDER(F); compress2_unit(F, 256 + rank, li); sub_barrier(F, sw + 64, 16u, 2); }
        asm volatile("s_waitcnt vmcnt(0)" ::: "memory"); __syncthreads();
        if (F.tid == 0) { __builtin_amdgcn_fence(__ATOMIC_ACQUIRE, "agent"); asm volatile("s_waitcnt vmcnt(0)" ::: "memory"); }
        __syncthreads();
        for (int g = 0; g < 2; ++g) { LAUNDER(F); PROBE_T0(4) attn_sample_unit(F, rank, g, li); PROBE_T1(4) }
    }
    for (int r2 = 0; r2 < REPSCAN; ++r2) for (;;) { const int u = take_ticket(F, qw + 64 + 2048 * r2); if (u >= DB) break; LAUNDER(F); PROBE_T0(9) scan_sample_unit(F, u, li); PROBE_T1(9) }
    sub_barrier(F, sw + 64, 16u, 1); LAUNDER(F);
    for (int r2 = 0; r2 < REPATP; ++r2) for (;;) { const int u = take_ticket(F, qw + 128 + 2048 * r2); if (u >= 512) break; LAUNDER(F);
        const int bg = u & 15, c = 31 - (u >> 4);
        PROBE_T0(3) attn_prompt_unit(F, bg >> 1, bg & 1, c, li); PROBE_T1(3) }
    sub_barrier(F, sw + 128, (unsigned)NSC, 1); LAUNDER(F);
    scan_post_phase(F, li);
}

#ifndef MK_PER_PHASE
#define MK_PER_PHASE 0
#endif
constexpr int PH_PER_LAYER = 12, N_PHASES = 1 + DEPTH * PH_PER_LAYER;
#ifndef REP0
#define REP0 1
#endif
#ifndef REP1
#define REP1 1
#endif
#ifndef REP3
#define REP3 1
#endif
#ifndef REP4
#define REP4 1
#endif
#ifndef REP6
#define REP6 1
#endif
#ifndef REP7
#define REP7 1
#endif
#ifndef REP8
#define REP8 1
#endif
__global__ void __launch_bounds__(NTHREADS, 2) mk_fwd(Args args) {
    Frame F;
    F.lds = (LAS unsigned char*)g_lds;
    F.MISC = (volatile LAS unsigned*)(F.lds + MISC_OFF);
    F.tid = threadIdx.x; F.lane = F.tid & 63; F.wave = __builtin_amdgcn_readfirstlane(F.tid >> 6);
    F.G = gridDim.x; F.bid = blockIdx.x;
    F.out = (GAS float*)args.out; F.ws = (GAS unsigned char*)args.ws; F.ctl = (gu32*)(args.ws + WS_CTL); F.ka = (unsigned long long)__builtin_amdgcn_kernarg_segment_ptr();
    for (int u = F.tid; u < (LDS_BYTES - LDSCTL_OFF) / 4; u += NTHREADS) ((LAS unsigned*)(F.lds + LDSCTL_OFF))[u] = 0u;
    __syncthreads();
    XcdBarrier bar; bar.bar = (unsigned*)(F.ctl + CW_BAR); bar.x = 0; bar.st = nullptr;
    if (!MK_PER_PHASE) bar = xcd_barrier_post((unsigned*)(F.ctl + CW_BAR), F.MISC + 8);
    const int lo = args.ph_lo, hi = args.ph_hi;
#define IN(k) (lo <= (k) && (k) < hi)
#define SEAM(k) do { if (IN((k) + 1)) { if (MK_PER_PHASE) { if (F.tid == 0) __hip_atomic_store(F.ctl + CW_TMO, 0xBADBA0u, RLX_AGENT); } else { asm volatile("" : "+s"(bar.bar)); asm volatile("" : "+s"(bar.x)); xcd_barrier(bar); } } } while (0)
    LAS unsigned char* ring = F.lds + RING_OFF;

    if (IN(0)) { LAUNDER(F); PROBE_T0(7) p0_prologue(F); SEAM(0); PROBE_T1(7) }

    for (int l = 0; l < DEPTH; ++l) {
        const int li = l >> 1; const bool even = (l & 1) == 0; const int pb = 1 + l * PH_PER_LAYER;
        if (IN(pb + 0)) for (int rep = 0; rep < REP0; ++rep) { LAUNDER(F); PROBE_T0(11)
            constexpr int NGEMM = 224, BG_QUOTA = 3;
            const int N = even ? NE : NO;
            if (F.G == 256 && l < 3 && F.bid >= NGEMM) { bg_units(F, l == 0 ? 0 : 1, BG_QUOTA); }
            else {
            const int gg = (F.G == 256 && l < 3) ? NGEMM : F.G;
            pg8::Gemm g{WSP(bf16, WS_XN), even ? WSP(bf16, WS_WIE) + (size_t)li * NE * DM : WSP(bf16, WS_WIO) + (size_t)li * NO * DM, MT, N, DM};
            pg8::StaticOrder S; S.init(MT, N, gg, F.bid);
            EpiStoreBf16 E{WSP(bf16, WS_ZB), N};
            pg8::gemm_phase<EpiStoreBf16, pg8::StaticOrder, true, true>(ring, g, S, E);
            }
            SEAM(pb + 0); PROBE_T1(11)
        }
        if (IN(pb + 1)) for (int rep = 0; rep < REP1; ++rep) { LAUNDER(F); PROBE_T0(5) PROBE_T0(10) if (even) { post_even_phase(F, li, l); SEAM(pb + 1); PROBE_T1(5) } else { odd_mix_phase(F, li, l); SEAM(pb + 1); PROBE_T1(10) } }
        if (even) {
            if (IN(pb + 2)) { LAUNDER(F); PROBE_T0(15)
                { int kdim = KLORA; asm volatile("" : "+s"(kdim));
                  pg8::Gemm g{WSP(bf16, WS_LA), WSP(bf16, WS_LORA) + (size_t)li * NLORA * KLORA, MT, NLORA, kdim};
                  pg8::StaticOrder S; S.init(MT, NLORA, F.G, F.bid);
                  EpiLora E{WSP(unsigned char, WS_SC), WSP(float, WS_G), KIN(I_W0) + li * 512, KIN(I_A0) + li * 512};
                  pg8::gemm_phase<EpiLora, pg8::StaticOrder, true, true>(ring, g, S, E); }
                SEAM(pb + 2); PROBE_T1(15)
            }
            if (IN(pb + 4)) for (int rep = 0; rep < REP4; ++rep) { LAUNDER(F); PROBE_T0(2) mix_even_phase(F, li, rep); SEAM(pb + 4); PROBE_T1(2) }
        }
        if (IN(pb + 6)) { LAUNDER(F); PROBE_T0(12)
            const bf16* Wt = even ? WSP(bf16, WS_WOE) + (size_t)li * DM * DM : WSP(bf16, WS_WOO) + (size_t)li * DM * DM;
            pg8::Gemm g{WSP(bf16, WS_MIX), Wt, MP, DM, DM};
            pg8::StaticOrder S; S.init(MP, DM, F.G, F.bid);
            EpiResid E{l == 0 ? KIN(I_XP) : nullptr, WSP(bf16, WS_XN), nullptr, SSQP(2 * l + 1)};
            pg8::gemm_phase<EpiResid, pg8::StaticOrder, true, true>(ring, g, S, E);
            __syncthreads(); LAUNDER(F);
            gemm64_sample_phase<DM>(F, WSP(bf16, WS_MIX) + (size_t)MP * DM, Wt, l == 0 ? KIN(I_XS) : nullptr, WSP(bf16, WS_XN) + (size_t)MP * DM, nullptr, SSQP(2 * l + 1) + MP);
            SEAM(pb + 6); PROBE_T1(12)
        }
        if (IN(pb + 8)) for (int rep = 0; rep < REP7; ++rep) { LAUNDER(F); PROBE_T0(13)
            pg8::Gemm g{WSP(bf16, WS_XN), WSP(bf16, WS_WUP) + (size_t)l * NUP * DM, MT, NUP, DM};
            pg8::StaticOrder S; S.init(MT, NUP, F.G, F.bid);
            EpiFfnAct E{WSP(bf16, WS_H), WSP(float, WS_HALO), KIN(I_FCONV) + (size_t)l * 3 * DFF, SSQP(2 * l + 1), KIN(I_SFFN) + (size_t)l * 2 * DFF, OUTF + O_FFP, OUTF + O_FFS, l};
            pg8::gemm_phase<EpiFfnAct, pg8::StaticOrder, true, true>(ring, g, S, E);
            SEAM(pb + 8); PROBE_T1(13)
        }
        if (IN(pb + 10)) { LAUNDER(F); PROBE_T0(14)
            pg8::Gemm g{WSP(bf16, WS_H), WSP(bf16, WS_WDN) + (size_t)l * DM * DFF, MP, DM, DFF};
            pg8::StaticOrder S; S.init(MP, DM, F.G, F.bid);
            for (int i = 0;; ++i) {
                const int nM = MP / 256, nN = DM / 256, nwg = nM * nN; const long L = (long)i * F.G + F.bid; if (L >= nwg) break;
                int wgid = (int)L; { const int q = nwg / 8, r = nwg % 8, xcd = wgid % 8, off = wgid / 8; wgid = (xcd < r ? xcd * (q + 1) : r * (q + 1) + (xcd - r) * q) + off; }
                const int nig = 8 * nN, gid = wgid / nig, fm = gid * 8, gsz = (nM - fm) < 8 ? (nM - fm) : 8;
                ffn_fix_panel(F, l, fm + ((wgid % nig) % gsz)); }
            LAUNDER(F);
            EpiResid E{nullptr, WSP(bf16, WS_XN), l + 1 < DEPTH ? nullptr : OUTF, SSQP(2 * l + 2 < 8 ? 2 * l + 2 : 0)};
            pg8::gemm_phase<EpiResid, pg8::StaticOrder, true, true>(ring, g, S, E);
            __syncthreads(); LAUNDER(F);
            gemm64_sample_phase<DFF>(F, WSP(bf16, WS_H) + (size_t)MP * DFF, WSP(bf16, WS_WDN) + (size_t)l * DM * DFF, nullptr, WSP(bf16, WS_XN) + (size_t)MP * DM, l + 1 < DEPTH ? nullptr : OUTF + (size_t)MP * DM, SSQP(2 * l + 2 < 8 ? 2 * l + 2 : 0) + MP);
            if (l + 1 < DEPTH) SEAM(pb + 10); PROBE_T1(14)
        }
    }
#undef IN
#undef SEAM
#ifdef PROBE_SUM
    if (PROBE_ID != 0) { __syncthreads(); if (F.tid == 0) __hip_atomic_fetch_add((unsigned*)(F.ctl + 40), (unsigned)F.MISC[20], RLX_AGENT);
        asm volatile("" : "+s"(bar.bar)); asm volatile("" : "+s"(bar.x)); xcd_barrier(bar);
        if (F.bid == 0 && F.tid == 0) { const unsigned long long t0 = __builtin_amdgcn_s_memrealtime(), dt = (unsigned long long)__hip_atomic_load((unsigned*)(F.ctl + 40), RLX_AGENT) * PROBE_MUL / 256;
            while (__builtin_amdgcn_s_memrealtime() - t0 < dt) __builtin_amdgcn_s_sleep(8); } }
#else
    if (PROBE_ID != 0) { __syncthreads(); if (F.tid == 0) { const unsigned long long t0 = __builtin_amdgcn_s_memrealtime(), dt = (unsigned long long)F.MISC[20] * PROBE_MUL;
        while (__builtin_amdgcn_s_memrealtime() - t0 < dt) __builtin_amdgcn_s_sleep(8); } }
#endif
}

extern "C" void kernel_launch(void* const* d_in, const int* in_sizes, int n_in, void* d_out, int out_size, void* d_ws, size_t ws_size, hipStream_t stream) {
    static int grid = 0;
    if (grid == 0) {
        if (n_in != N_IN || (size_t)out_size != O_END || ws_size < WS_END) { fprintf(stderr, "kernel_launch: unexpected shapes: n_in %d out %d ws %zu (need %zu)\n", n_in, out_size, ws_size, (size_t)WS_END); grid = -1; return; }
        int dev = 0, cus = 0, per_cu = 0;
        if (hipGetDevice(&dev) != hipSuccess || hipDeviceGetAttribute(&cus, hipDeviceAttributeMultiprocessorCount, dev) != hipSuccess) { grid = -1; return; }
        if (hipFuncSetAttribute((const void*)mk_fwd, hipFuncAttributeMaxDynamicSharedMemorySize, LDS_BYTES) != hipSuccess) { fprintf(stderr, "kernel_launch: hipFuncSetAttribute failed\n"); grid = -1; return; }
        if (hipOccupancyMaxActiveBlocksPerMultiprocessor(&per_cu, (const void*)mk_fwd, NTHREADS, LDS_BYTES) != hipSuccess || per_cu < 1) { fprintf(stderr, "kernel_launch: occupancy query says %d\n", per_cu); }
        (void)hipGetLastError();
        grid = cus;
        if (cus != 256) { fprintf(stderr, "kernel_launch: built for a 256-CU device (the mix phase splits the grid 128 + 128), found %d CUs\n", cus); if (cus > 256) grid = 256; }
    }
    if (grid < 0) return;
    if (hipMemsetAsync((char*)d_ws + WS_CTL, 0, CTL_RESERVED, stream) != hipSuccess) return;
    Args a{};
    for (int i = 0; i < N_IN; ++i) a.in[i] = (const float*)d_in[i];
    a.out = (float*)d_out; a.ws = (unsigned char*)d_ws;
#if MK_PER_PHASE
    for (int p = 0; p < N_PHASES; ++p) {
        if (p > 0) { const int l = (p - 1) / PH_PER_LAYER, q = (p - 1) % PH_PER_LAYER; if ((l & 1) && q >= 2 && q <= 5) continue; if (l == DEPTH - 1 && q == 11) continue; }
        a.ph_lo = p; a.ph_hi = p + 1;
        hipLaunchKernelGGL(mk_fwd, dim3(grid), dim3(NTHREADS), LDS_BYTES, stream, a);
    }
#else
    a.ph_lo = 0; a.ph_hi = N_PHASES;
    hipLaunchKernelGGL(mk_fwd, dim3(grid), dim3(NTHREADS), LDS_BYTES, stream, a);
#endif
    const hipError_t le = hipPeekAtLastError();
    if (le != hipSuccess) fprintf(stderr, "kernel_launch: launch failed: %s\n", hipGetErrorName(le));
}
```

```cpp
#include <hip/hip_runtime.h>
#include <cstdio>
#include <cstdint>

namespace pg8 {
#define PG8_LAS __attribute__((address_space(3)))
typedef unsigned short bf16_t;
typedef short bf16x8 __attribute__((ext_vector_type(8)));
typedef float f32x4 __attribute__((ext_vector_type(4)));
typedef unsigned u32x4 __attribute__((ext_vector_type(4)));
constexpr int BM = 256, BK = 64, HALF = 128, HTB = HALF * BK * 2  , STAGE_BYTES = 8 * HTB, NXCD = 8, WGM = 8;

__host__ __device__ __forceinline__ int lds_byte(int r, int c) { const int st = (r >> 4) * 2 + (c >> 5), rr = r & 15, cc = c & 31, ob = rr * 64 + cc * 2; return st * 1024 + (ob ^ (((ob >> 9) & 1) << 5)); }
__host__ __device__ __forceinline__ void stage_rc(int b, int& R, int& C) { const int st = b / 1024, sb = b % 1024, swz = sb ^ (((sb >> 9) & 1) << 5); R = (st >> 1) * 16 + swz / 64; C = (st & 1) * 32 + (swz % 64) / 2; }
__host__ __device__ __forceinline__ int perm32(int rho) { const int n = rho >> 4, i = rho & 15; return 8 * (i >> 2) + 4 * n + (i & 3); }

struct Unit { int pm, pn; };
struct Gemm { const bf16_t* A; const bf16_t* Bt; int M, N, K; };

struct StaticOrder {
    int nM, nN, nwg, G, c;
    __host__ __device__ void init(int M, int N, int G_, int c_) { nM = M / BM; nN = N / BM; nwg = nM * nN; G = G_; c = c_; }
    __host__ __device__ bool next(int i, Unit& u) const {
        const long L = (long)i * G + c; if (L >= nwg) return false;
        int wgid = (int)L; { const int q = nwg / NXCD, r = nwg % NXCD, xcd = wgid % NXCD, off = wgid / NXCD; wgid = (xcd < r ? xcd * (q + 1) : r * (q + 1) + (xcd - r) * q) + off; }
        const int nig = WGM * nN, gid = wgid / nig, fm = gid * WGM, gsz = (nM - fm) < WGM ? (nM - fm) : WGM;
        u.pm = fm + ((wgid % nig) % gsz); u.pn = (wgid % nig) / gsz; return true;
    }
    __device__ __forceinline__ void a_ready(const Unit&) const {}
    __device__ __forceinline__ void done(const Unit&) const {}
};

__device__ __forceinline__ unsigned cvt_pk_bf16(float lo, float hi) { unsigned r; asm volatile("v_cvt_pk_bf16_f32 %0, %1, %2" : "=v"(r) : "v"(lo), "v"(hi)); return r; }
template <class Epi, class Sched, bool ALIGN_EPI = false, bool SP2 = false>
__device__ __forceinline__ void gemm_phase(PG8_LAS unsigned char* lds, const Gemm g, const Sched& S, const Epi& E) {
    int tid_ = threadIdx.x; asm volatile("" : "+v"(tid_));
    const int tid = tid_, wid = __builtin_amdgcn_readfirstlane(tid >> 6), lane = tid & 63, wr = wid >> 2, wc = wid & 3, fr = lane & 15, fq = lane >> 4;
    const int K = g.K, nt = K / BK;
    unsigned voffA[2], voffB[2];
#pragma unroll
    for (int i = 0; i < 2; ++i) { int R, C; stage_rc(tid * 16 + i * 8192, R, C); const int Rb = Epi::PERM ? ((R & ~31) + perm32(R & 31)) : R;
        voffA[i] = (unsigned)(R * K + C) * 2u; voffB[i] = (unsigned)(Rb * K + C) * 2u; }
    const size_t kstep = (size_t)(BK * 2);
    const size_t hstep = (size_t)HALF * K * 2;
    const size_t tstep = 2 * hstep;
    const unsigned ldsw = (unsigned)wid * 1024u;
    const int aoff = lds_byte(wr * 64 + fr, fq * 8), boff = lds_byte(wc * 32 + fr, fq * 8);
#define PG8_SA(b, h) (((b) * 2 + (h)) * HTB)
#define PG8_SB(b, h) ((4 + (b) * 2 + (h)) * HTB)
#define PG8_STAGE(bufoff, gbase, voff) do { _Pragma("unroll") for (int _i = 0; _i < 2; ++_i) \
        __builtin_amdgcn_global_load_lds((const unsigned*)((const char*)(gbase) + (voff)[_i]), (PG8_LAS unsigned*)(lds + (bufoff) + ldsw + _i * 8192), 16, 0, 0); } while (0)
#define PG8_LDA(dst, b, h) do { _Pragma("unroll") for (int m = 0; m < 4; ++m) _Pragma("unroll") for (int k = 0; k < 2; ++k) dst[m][k] = *(const PG8_LAS bf16x8*)(lds + PG8_SA(b, h) + aoff + m * 2048 + k * 1024); } while (0)
#define PG8_LDB(dst, b, h) do { _Pragma("unroll") for (int n = 0; n < 2; ++n) _Pragma("unroll") for (int k = 0; k < 2; ++k) dst[n][k] = *(const PG8_LAS bf16x8*)(lds + PG8_SB(b, h) + boff + n * 2048 + k * 1024); } while (0)
#define PG8_MMA(ai, bj, At, Bt) do { __builtin_amdgcn_s_setprio(1); _Pragma("unroll") for (int m = 0; m < 4; ++m) _Pragma("unroll") for (int n = 0; n < 2; ++n) _Pragma("unroll") for (int k = 0; k < 2; ++k) \
        acc[ai][bj][m][n] = __builtin_amdgcn_mfma_f32_16x16x32_bf16(Bt[n][k], At[m][k], acc[ai][bj][m][n], 0, 0, 0); __builtin_amdgcn_s_setprio(0); } while (0)
#define PG8_WAIT_V(n) asm volatile("s_waitcnt vmcnt(" #n ")" ::: "memory")
#define PG8_WAIT_L(n) asm volatile("s_waitcnt lgkmcnt(" #n ")" ::: "memory")
#define PG8_BAR __builtin_amdgcn_s_barrier()
#define PG8_SCHED __builtin_amdgcn_sched_barrier(0)
    Unit cur, nxt; int ui = 0;
    if (!S.next(0, cur)) return;
    f32x4 acc[2][2][4][2];
#pragma unroll
    for (int a = 0; a < 2; ++a)
#pragma unroll
        for (int b = 0; b < 2; ++b)
#pragma unroll
            for (int m = 0; m < 4; ++m)
#pragma unroll
                for (int n = 0; n < 2; ++n) acc[a][b][m][n] = (f32x4){0.f, 0.f, 0.f, 0.f};
    bf16x8 At[4][2], B0[2][2], B1[2][2];
    const char* cA = (const char*)g.A + (size_t)cur.pm * tstep; const char* cB = (const char*)g.Bt + (size_t)cur.pn * tstep;
    S.a_ready(cur);
    if constexpr (SP2) {
        PG8_STAGE(PG8_SB(0, 0), cB, voffB); PG8_STAGE(PG8_SB(0, 1), cB + hstep, voffB); PG8_STAGE(PG8_SA(0, 0), cA, voffA); PG8_STAGE(PG8_SA(0, 1), cA + hstep, voffA);
        if (wr == 1) PG8_BAR;
        PG8_WAIT_V(2); PG8_BAR;
        PG8_STAGE(PG8_SB(1, 0), cB + kstep, voffB); PG8_STAGE(PG8_SA(1, 0), cA + kstep, voffA); PG8_STAGE(PG8_SB(1, 1), cB + hstep + kstep, voffB);
        PG8_WAIT_V(6); PG8_BAR;
    } else {
        PG8_STAGE(PG8_SB(0, 0), cB, voffB); PG8_STAGE(PG8_SA(0, 0), cA, voffA); PG8_STAGE(PG8_SB(0, 1), cB + hstep, voffB); PG8_STAGE(PG8_SA(0, 1), cA + hstep, voffA);
        if (wr == 1) PG8_BAR;
        PG8_WAIT_V(4); PG8_BAR;
        PG8_STAGE(PG8_SB(1, 0), cB + kstep, voffB); PG8_STAGE(PG8_SA(1, 0), cA + kstep, voffA); PG8_STAGE(PG8_SB(1, 1), cB + hstep + kstep, voffB);
        PG8_WAIT_V(6); PG8_BAR;
    }
    for (;;) {
        const bool has_next = S.next(ui + 1, nxt);
        const char* nA = has_next ? (const char*)g.A + (size_t)nxt.pm * tstep : cA; const char* nB = has_next ? (const char*)g.Bt + (size_t)nxt.pn * tstep : cB;
        for (int t = 0; t < nt; t += 2) {
            const bool last = (t == nt - 2);
            const char* a1 = cA + (size_t)(t + 1) * kstep;
            const char* a2 = last ? nA : cA + (size_t)(t + 2) * kstep; const char* b2 = last ? nB : cB + (size_t)(t + 2) * kstep;
            const char* a3 = a2 + kstep; const char* b3 = b2 + kstep;
            if (last && has_next) S.a_ready(nxt);
            if constexpr (SP2) {
            PG8_LDB(B0, 0, 0); PG8_LDB(B1, 0, 1); PG8_SCHED; PG8_LDA(At, 0, 0); PG8_STAGE(PG8_SA(1, 1), a1 + hstep, voffA);
            PG8_WAIT_V(8); PG8_WAIT_L(0); PG8_BAR; PG8_MMA(0, 0, At, B0); PG8_MMA(0, 1, At, B1); PG8_BAR; PG8_SCHED;
            PG8_LDA(At, 0, 1); PG8_STAGE(PG8_SB(0, 0), b2, voffB); PG8_STAGE(PG8_SB(0, 1), b2 + hstep, voffB); PG8_STAGE(PG8_SA(0, 0), a2, voffA);
            PG8_WAIT_V(8); PG8_WAIT_L(0); PG8_BAR; PG8_MMA(1, 0, At, B0); PG8_MMA(1, 1, At, B1); PG8_BAR; PG8_SCHED;
            PG8_LDB(B0, 1, 0); PG8_LDB(B1, 1, 1); PG8_SCHED; PG8_LDA(At, 1, 0); PG8_STAGE(PG8_SA(0, 1), a2 + hstep, voffA);
            PG8_WAIT_V(8); PG8_WAIT_L(0); PG8_BAR; PG8_MMA(0, 0, At, B0); PG8_MMA(0, 1, At, B1); PG8_BAR; PG8_SCHED;
            PG8_LDA(At, 1, 1); PG8_STAGE(PG8_SB(1, 0), b3, voffB); PG8_STAGE(PG8_SB(1, 1), b3 + hstep, voffB); PG8_STAGE(PG8_SA(1, 0), a3, voffA);
            PG8_WAIT_V(8); PG8_WAIT_L(0); PG8_BAR; PG8_MMA(1, 0, At, B0); PG8_MMA(1, 1, At, B1); PG8_BAR; PG8_SCHED;
            } else {
            PG8_LDB(B0, 0, 0); PG8_SCHED; PG8_LDA(At, 0, 0); PG8_STAGE(PG8_SA(1, 1), a1 + hstep, voffA);
            PG8_WAIT_L(8); PG8_BAR; PG8_WAIT_L(0); PG8_MMA(0, 0, At, B0); PG8_BAR; PG8_SCHED;
            PG8_LDB(B1, 0, 1); PG8_STAGE(PG8_SB(0, 0), b2, voffB);
            PG8_BAR; PG8_WAIT_L(0); PG8_MMA(0, 1, At, B1); PG8_BAR;
            PG8_LDA(At, 0, 1); PG8_STAGE(PG8_SA(0, 0), a2, voffA);
            PG8_BAR; PG8_WAIT_L(0); PG8_MMA(1, 0, At, B0); PG8_BAR; PG8_SCHED;
            PG8_STAGE(PG8_SB(0, 1), b2 + hstep, voffB);
            PG8_WAIT_V(6); PG8_BAR; PG8_MMA(1, 1, At, B1); PG8_BAR;
            PG8_LDB(B0, 1, 0); PG8_SCHED; PG8_LDA(At, 1, 0); PG8_STAGE(PG8_SA(0, 1), a2 + hstep, voffA);
            PG8_WAIT_L(8); PG8_BAR; PG8_WAIT_L(0); PG8_MMA(0, 0, At, B0); PG8_BAR; PG8_SCHED;
            PG8_LDB(B1, 1, 1); PG8_STAGE(PG8_SB(1, 0), b3, voffB);
            PG8_BAR; PG8_WAIT_L(0); PG8_MMA(0, 1, At, B1); PG8_BAR;
            PG8_LDA(At, 1, 1); PG8_STAGE(PG8_SA(1, 0), a3, voffA);
            PG8_BAR; PG8_WAIT_L(0); PG8_MMA(1, 0, At, B0); PG8_BAR; PG8_SCHED;
            PG8_STAGE(PG8_SB(1, 1), b3 + hstep, voffB);
            PG8_WAIT_V(6); PG8_BAR; PG8_MMA(1, 1, At, B1); PG8_BAR;
            }
        }
        if constexpr (ALIGN_EPI) { if (wr == 0) PG8_BAR; }
#if defined(PROBE_ID) && (PROBE_ID >= 16 && PROBE_ID <= 20)
        unsigned long long pt0_ = 0; if (PROBE_ID == Epi::PID) { __builtin_amdgcn_s_barrier(); pt0_ = __builtin_amdgcn_s_memrealtime(); }
#endif
        if constexpr (!Epi::AFTER_DRAIN) { E(acc, cur, wr, wc, fr, fq); S.done(cur); }
#if defined(PROBE_ID) && (PROBE_ID >= 16 && PROBE_ID <= 20)
        if (PROBE_ID == Epi::PID) { asm volatile("s_waitcnt vmcnt(0)" ::: "memory"); __builtin_amdgcn_s_barrier(); if (threadIdx.x == 0) ((volatile PG8_LAS unsigned*)(lds + 131072 + 320))[20] += (unsigned)(__builtin_amdgcn_s_memrealtime() - pt0_); }
#endif
        if (!has_next) break;
#pragma unroll
        for (int a = 0; a < 2; ++a)
#pragma unroll
            for (int b = 0; b < 2; ++b)
#pragma unroll
                for (int m = 0; m < 4; ++m)
#pragma unroll
                    for (int n = 0; n < 2; ++n) acc[a][b][m][n] = (f32x4){0.f, 0.f, 0.f, 0.f};
        cur = nxt; cA = nA; cB = nB; ++ui;
        if constexpr (ALIGN_EPI) { if (wr == 1) PG8_BAR; }
    }
    PG8_WAIT_V(0);
    if constexpr (!ALIGN_EPI) { if (wr == 0) PG8_BAR; }
    PG8_BAR;
    if constexpr (Epi::AFTER_DRAIN) { E.fused(acc, cur, wr, wc, fr, fq, lds, wid, lane); S.done(cur); }
#undef PG8_SA
#undef PG8_SB
#undef PG8_STAGE
#undef PG8_LDA
#undef PG8_LDB
#undef PG8_MMA
#undef PG8_WAIT_V
#undef PG8_WAIT_L
#undef PG8_BAR
#undef PG8_SCHED
}
}

constexpr int DM = 1024, NB = 8, SEQ = 2048, DEPTH = 4, DB = 128, DT = 8, PAST = 2048, PAGE = 128, NPAGE = 16, NPOOL = 2560;
constexpr int HD = 64, NCMP = 127, WIN = 512;
constexpr int MP = NB * SEQ, MS = DB * DT, MT = MP + MS;
constexpr int NE_ORIG = 3096, NE = 3328, RWP = 1792, NO = 3072, DFF = 2816, NUP = 2 * DFF;
constexpr int NLORA = 1536, KLORA = 256;
constexpr float RMS_EPS = 1e-6f, GN_EPS = 64e-5f, LOG2E = 1.4426950408889634f;
constexpr int NWAVES = 8, NTHREADS = 512;

enum { I_XP = 0, I_XS, I_CCMP, I_CSLC, I_CWIN, I_SWKV, I_SSHIFT, I_SCONV, I_SFFN, I_PT, I_NMIX, I_NFFN, I_RELB, I_WINE, I_WOUTE, I_QN, I_KN,
       I_PPE, I_PW1, I_PW2, I_MU, I_W0, I_W2, I_A0, I_A2, I_G2, I_KKW, I_KA, I_RK, I_LNW, I_LNB, I_WINO, I_CONVW, I_WOUTO, I_FUP, I_FCONV, I_FDOWN, N_IN };

constexpr size_t O_YP = 0, O_YS = O_YP + (size_t)MP * DM, O_CMPP = O_YS + (size_t)MS * DM, O_CMPS = O_CMPP + (size_t)NB * 2 * SEQ * 256,
    O_SLCP = O_CMPS + (size_t)DB * 2 * DT * 256, O_SLCS = O_SLCP + (size_t)NB * 2 * SEQ * 256, O_WINP = O_SLCS + (size_t)DB * 2 * DT * 256,
    O_WINS = O_WINP + (size_t)NB * 2 * WIN * 256, O_WKVP = O_WINS + (size_t)DB * 2 * WIN * 256, O_WKVS = O_WKVP + (size_t)NB * 2 * 8 * 4096,
    O_SHP = O_WKVS + (size_t)DB * 2 * 8 * 4096, O_SHS = O_SHP + (size_t)NB * 2 * RWP, O_CVP = O_SHS + (size_t)DB * 2 * RWP, O_CVS = O_CVP + (size_t)NB * 2 * 2 * DM,
    O_FFP = O_CVS + (size_t)DB * 2 * 2 * DM, O_FFS = O_FFP + (size_t)NB * 4 * 2 * DFF, O_END = O_FFS + (size_t)DB * 4 * 2 * DFF;

constexpr size_t al256(size_t x) { return (x + 255) & ~(size_t)255; }
constexpr size_t WS_CTL = 0, CTL_ZERO_BYTES = 1u << 20, CTL_RESERVED = 2u << 20;
constexpr size_t WS_WIE = CTL_RESERVED;
constexpr size_t WS_WOE = WS_WIE + (size_t)2 * NE * DM * 2;
constexpr size_t WS_WIO = WS_WOE + (size_t)2 * DM * DM * 2;
constexpr size_t WS_WOO = WS_WIO + (size_t)2 * NO * DM * 2;
constexpr size_t WS_WUP = WS_WOO + (size_t)2 * DM * DM * 2;
constexpr size_t WS_WDN = WS_WUP + (size_t)4 * NUP * DM * 2;
constexpr size_t WS_PHI1 = WS_WDN + (size_t)4 * DM * DFF * 2;
constexpr size_t WS_LORA = WS_PHI1 + (size_t)2 * 512 * 1024 * 2;
constexpr size_t WS_PEC = WS_LORA + (size_t)2 * NLORA * KLORA * 2;
constexpr size_t WS_XN = al256(WS_PEC + 4 * 128 * 4);
constexpr size_t WS_ZB = WS_XN + (size_t)MT * DM * 2;
constexpr size_t WS_QB = WS_ZB + (size_t)MT * NUP * 2;
constexpr size_t WS_CSEG = WS_QB + (size_t)MT * 512 * 2;
constexpr int CS_SK = 0, CS_SV = 32768, CS_PK = 65536, CS_PV = 67584, CS_ROWS = 69632;
constexpr size_t WS_PART = WS_CSEG + (size_t)CS_ROWS * 1024 * 2;
constexpr size_t WS_KC = WS_PART + (size_t)CS_ROWS * 256 * 4;
constexpr size_t WS_VCT = WS_KC + (size_t)272 * 128 * 64 * 2;
constexpr size_t WS_KS = WS_VCT + (size_t)272 * 128 * 64 * 2;
constexpr size_t WS_KW = WS_KS + (size_t)NB * 2 * SEQ * 64 * 2;
constexpr size_t WS_VST = WS_KW + (size_t)NB * 2 * SEQ * 64 * 2;
constexpr size_t WS_VWT = WS_VST + (size_t)NB * 2 * SEQ * 64 * 2;
constexpr size_t WS_GATE = WS_VWT + (size_t)NB * 2 * SEQ * 64 * 2;
constexpr size_t WS_SC = WS_GATE + (size_t)MT * 32 * 4;
constexpr int SCR_BYTES = 896, SCR_KK = 256, SCR_A = 384, SCR_K = 512, SCR_R = 640, SCR_V = 768;
#define SCREC(row, h) ((unsigned char*)(F.ws + WS_SC + ((size_t)(row) * 8 + (h)) * SCR_BYTES))
constexpr size_t WS_G = WS_SC + (size_t)MT * 8 * 6 * 64 * 4;
constexpr size_t WS_LA = WS_G + (size_t)MT * 512 * 4;
constexpr size_t WS_MIX = WS_LA + (size_t)MT * 256 * 2;
constexpr size_t WS_H = WS_MIX + (size_t)MT * DM * 2;
constexpr size_t WS_YRAW = WS_H + (size_t)MT * DFF * 2;
constexpr size_t WS_HALO = WS_YRAW + (size_t)MP * 512 * 4;
constexpr size_t WS_PECP = WS_HALO + (size_t)256 * 6 * DFF * 4;
constexpr size_t WS_END = WS_PECP + (size_t)32 * 512 * 4;

constexpr int CW_TMO = 0, CW_CODE = 1;
constexpr int CW_QUEUE = 64;
constexpr int CW_BAR = 4096;
constexpr size_t CTL_SSQ_BYTE = 65536; constexpr float SSQ_SCALE = 1048576.f;
static_assert(CTL_SSQ_BYTE + (size_t)8 * MT * 8 <= CTL_ZERO_BYTES * 2, "SSQ inside the memset region");
#define SSQP(k) ((unsigned long long*)(F.ws + WS_CTL + CTL_SSQ_BYTE) + (size_t)(k) * MT)


constexpr int RING_OFF = 0, RING_BYTES = 131072;
constexpr int LDSCTL_OFF = RING_BYTES, MISC_OFF = LDSCTL_OFF + 320;
constexpr int LDS_BYTES = 147456;

#define GAS __attribute__((address_space(1)))
#define LAS __attribute__((address_space(3)))
typedef unsigned short bf16;
typedef unsigned v4u __attribute__((ext_vector_type(4)));
typedef unsigned v2u __attribute__((ext_vector_type(2)));
typedef float f32x4 __attribute__((ext_vector_type(4)));
typedef float f32x2 __attribute__((ext_vector_type(2)));
typedef float f32x16 __attribute__((ext_vector_type(16)));
typedef short bf16x8 __attribute__((ext_vector_type(8)));
typedef GAS unsigned gu32;
#define RLX_AGENT __ATOMIC_RELAXED, __HIP_MEMORY_SCOPE_AGENT
#define LDS_WAIT() asm volatile("s_waitcnt lgkmcnt(0)" ::: "memory")
#define VM_WAIT() asm volatile("s_waitcnt vmcnt(0)" ::: "memory")
#define DI __device__ __forceinline__
#define MFMA32(a, b, c) __builtin_amdgcn_mfma_f32_32x32x16_bf16((a), (b), (c), 0, 0, 0)

DI float bf2f(unsigned b) { return __builtin_bit_cast(float, b << 16); }
DI float bflo(unsigned w) { return __builtin_bit_cast(float, w << 16); }
DI float bfhi(unsigned w) { return __builtin_bit_cast(float, w & 0xffff0000u); }
DI unsigned pk2(float lo, float hi) {
    typedef __bf16 bf2v __attribute__((ext_vector_type(2)));
    f32x2 v = {lo, hi}; bf2v r = __builtin_convertvector(v, bf2v); return __builtin_bit_cast(unsigned, r);
}
DI float rbf(float x) { return bflo(pk2(x, 0.f) & 0xffffu); }
DI float fexp2(float x) { return __builtin_amdgcn_exp2f(x); }
DI float fexp(float x) { return __builtin_amdgcn_exp2f(x * LOG2E); }
DI float frcp(float x) { return __builtin_amdgcn_rcpf(x); }
DI float sigmoidf_(float x) { return __builtin_amdgcn_rcpf(1.0f + __expf(-x)); }
DI float tanhf_(float x) { const float e = __expf(2.0f * x); return 1.0f - 2.0f * __builtin_amdgcn_rcpf(e + 1.0f); }
template <int CTRL> DI float dppf(float x) { return __builtin_bit_cast(float, __builtin_amdgcn_mov_dpp(__builtin_bit_cast(int, x), CTRL, 0xf, 0xf, true)); }
template <int CTRL> DI unsigned dppu(unsigned x) { return (unsigned)__builtin_amdgcn_mov_dpp((int)x, CTRL, 0xf, 0xf, true); }
constexpr int XOR1 = 0xB1, XOR2 = 0x4E, HMIR = 0x141, ROR8 = 0x128;
DI float sum4(float v) { v += dppf<XOR1>(v); v += dppf<XOR2>(v); return v; }
DI float sum8(float v) { v = sum4(v); v += dppf<HMIR>(v); return v; }
DI float sum16(float v) { v = sum8(v); v += dppf<ROR8>(v); return v; }
DI float wave_sum(float v) {
#pragma unroll
    for (int o = 1; o < 64; o <<= 1) v += __shfl_xor(v, o);
    return v;
}
DI float rinv_of(const unsigned long long* ssq, int row) { return __builtin_amdgcn_rsqf((float)ssq[row] * (1.f / (SSQ_SCALE * DM)) + RMS_EPS); }
DI int crow(int i, int h) { return (i & 3) + 8 * (i >> 2) + 4 * h; }

#define XB_TMO      128
#define XB_XCNT(j)  (256  + 64 * (j))
#define XB_XSUB(j)  (1280 + 64 * (j))
#define XB_XGEN(j)  (2304 + 64 * (j))
#define XB_TOP      3328
#define XB_TOPGEN   3392
#define XCD_BAR_WORDS 3456
#define XB_SPIN_CAP (1u << 18)

__device__ __forceinline__ unsigned xb_ld(unsigned* p)              { return __hip_atomic_load(p, __ATOMIC_RELAXED, __HIP_MEMORY_SCOPE_AGENT); }
__device__ __forceinline__ unsigned xb_add(unsigned* p, unsigned v) { return __hip_atomic_fetch_add(p, v, __ATOMIC_RELAXED, __HIP_MEMORY_SCOPE_AGENT); }
__device__ __forceinline__ unsigned xb_xcc_id() { return (unsigned)__builtin_amdgcn_s_getreg((3 << 11) | 20) & 0xFu; }
#define XB_SPIN(cond, bar) do { unsigned _sp = 0; while (cond) { __builtin_amdgcn_s_sleep(1); \
    if ((++_sp & 255u) == 0u) { if (xb_ld(&(bar)[XB_TMO])) break; if (_sp > XB_SPIN_CAP) { atomicAdd(&(bar)[XB_TMO], 1u); break; } } } } while (0)

struct XcdBarrier { unsigned* bar; unsigned x; volatile LAS unsigned* st; };

__device__ __forceinline__ XcdBarrier xcd_barrier_post(unsigned* bar, volatile LAS unsigned* st) {
    XcdBarrier b; b.bar = bar; b.x = xb_xcc_id(); b.st = st;
    if (threadIdx.x == 0) (void)xb_add(&bar[XB_XCNT(b.x)], 1u);
    return b;
}
__device__ __forceinline__ void xcd_barrier_complete(unsigned* bar, unsigned x, unsigned& nloc, unsigned& nx) {
    const unsigned G = gridDim.x * gridDim.y * gridDim.z;
    unsigned sum, cnt, mine, sp = 0u;
    for (;;) {
        sum = 0u; cnt = 0u; mine = 0u;
#pragma unroll
        for (unsigned j = 0; j < 16; ++j) { const unsigned c = xb_ld(&bar[XB_XCNT(j)]); sum += c; cnt += (c > 0u) ? 1u : 0u; mine = (j == x) ? c : mine; }
        if (sum == G) break;
        __builtin_amdgcn_s_sleep(1);
        if ((++sp & 255u) == 0u) { if (xb_ld(&bar[XB_TMO])) break; if (sp > XB_SPIN_CAP) { atomicAdd(&bar[XB_TMO], 1u); break; } }
    }
    nloc = mine > 0u ? mine : 1u; nx = cnt > 0u ? cnt : 1u;
}
__device__ __forceinline__ void xcd_barrier(const XcdBarrier& b) {
    asm volatile("s_waitcnt vmcnt(0)" ::: "memory");
    __syncthreads();
    if (threadIdx.x == 0) {
        unsigned* bar = b.bar;
        __builtin_amdgcn_s_waitcnt(0);
        unsigned nloc = b.st[0], nx = b.st[1];
        if (nloc == 0u) { xcd_barrier_complete(bar, b.x, nloc, nx); b.st[0] = nloc; b.st[1] = nx; }
        const unsigned old = xb_add(&bar[XB_XSUB(b.x)], 1u);
        const unsigned gen = old / nloc;
        if (old + 1u == (gen + 1u) * nloc) {
            __builtin_amdgcn_fence(__ATOMIC_RELEASE, "agent");
            asm volatile("s_waitcnt vmcnt(0)" ::: "memory");
            const unsigned og = xb_add(&bar[XB_TOP], 1u);
            const unsigned tg = og / nx;
            if (og + 1u == (tg + 1u) * nx) xb_add(&bar[XB_TOPGEN], 1u);
            else XB_SPIN(xb_ld(&bar[XB_TOPGEN]) == tg, bar);
            __builtin_amdgcn_fence(__ATOMIC_ACQUIRE, "agent");
            xb_add(&bar[XB_XGEN(b.x)], 1u);
            asm volatile("s_waitcnt vmcnt(0)" ::: "memory");
        } else {
            XB_SPIN(xb_ld(&bar[XB_XGEN(b.x)]) == gen, bar);
            __builtin_amdgcn_fence(__ATOMIC_ACQUIRE, "agent");
            asm volatile("s_waitcnt vmcnt(0)" ::: "memory");
        }
    }
    __syncthreads();
}

struct Frame {
    LAS unsigned char* lds;
    volatile LAS unsigned* MISC;
    gu32* ctl;
    int tid, lane, wave, G, bid;
    GAS float* out;
    GAS unsigned char* ws;
    unsigned long long ka;
};
#define LAUNDER(F) do { asm volatile("" : "+s"((F).ws)); asm volatile("" : "+s"((F).out)); asm volatile("" : "+s"((F).ka)); asm volatile("" : "+s"((F).bid)); asm volatile("" : "+s"((F).G)); asm volatile("" : "+v"((F).tid)); (F).lane = (F).tid & 63; (F).wave = __builtin_amdgcn_readfirstlane((F).tid >> 6); } while (0)
#define WSP(T, off) ((T*)(F.ws + (off)))
#define OUTF ((float*)F.out)
struct Args { const float* in[N_IN]; float* out; unsigned char* ws; int ph_lo, ph_hi; };
struct KArgs { const GAS float* in[N_IN]; GAS float* out; GAS unsigned char* ws; int ph_lo, ph_hi; };
#define KIN(i) ((const float*)(((const __attribute__((address_space(4))) KArgs*)(F.ka))->in[i]))

#ifndef PROBE_ID
#define PROBE_ID 0
#endif
#ifndef PROBE_MUL
#define PROBE_MUL 8
#endif
#define PROBE_T0(id) unsigned long long _pt0_##id = 0; if (PROBE_ID == (id)) { __syncthreads(); _pt0_##id = __builtin_amdgcn_s_memrealtime(); }
#define PROBE_T1(id) if (PROBE_ID == (id)) { __syncthreads(); if (F.tid == 0) F.MISC[20] += (unsigned)(__builtin_amdgcn_s_memrealtime() - _pt0_##id); }
template <class SRC> DI void tr_load(const SRC& src, int N, int item, int lane, float (&tv)[32]) {
    const int nblk = N / 32, kb = item / nblk, nb = item % nblk, k0 = 64 * kb, n0 = 32 * nb;
#pragma unroll
    for (int i = 0; i < 32; ++i) tv[i] = src(k0 + 2 * i + (lane >> 5), n0 + (lane & 31));
}
DI void tr_store(const float (&tv)[32], int K, int N, bf16* WT, LAS float* scr, int item, int lane) {
    const int nblk = N / 32, kb = item / nblk, nb = item % nblk, k0 = 64 * kb, n0 = 32 * nb;
#pragma unroll
    for (int i = 0; i < 32; ++i) scr[(2 * i + (lane >> 5)) * 33 + (lane & 31)] = tv[i];
    LDS_WAIT(); asm volatile("" ::: "memory");
    const int c = lane & 7;
#pragma unroll
    for (int j = 0; j < 4; ++j) { const int n = (lane >> 3) + 8 * j; const LAS float* s = scr + (8 * c) * 33 + n;
        v4u o; o.x = pk2(s[0 * 33], s[1 * 33]); o.y = pk2(s[2 * 33], s[3 * 33]); o.z = pk2(s[4 * 33], s[5 * 33]); o.w = pk2(s[6 * 33], s[7 * 33]);
        *(v4u*)(WT + (size_t)(n0 + n) * K + k0 + 8 * c) = o; }
    LDS_WAIT(); asm volatile("" ::: "memory");
}
template <class SRC> DI void tr_item(const SRC& src, int K, int N, bf16* WT, LAS float* scr, int item, int lane) { float tv[32]; tr_load(src, N, item, lane, tv); tr_store(tv, K, N, WT, scr, item, lane); }
template <class SRC> DI void tr_matrix(const SRC& src, int K, int N, bf16* WT, LAS float* scr, int first, int stride, int count, int lane) {
    if (first >= count) return;
    float cur[32], nxt[32]; tr_load(src, N, first, lane, cur);
    for (int it = first; it < count; it += stride) {
        const bool more = it + stride < count;
        if (more) tr_load(src, N, it + stride, lane, nxt);
        tr_store(cur, K, N, WT, scr, it, lane);
        if (more) {
#pragma unroll
            for (int i = 0; i < 32; ++i) cur[i] = nxt[i]; }
    }
}
struct SrcPlain { const float* W; int N; DI float operator()(int k, int n) const { return W[(size_t)k * N + n]; } };
struct SrcGain { const float* W; int N; const float* g; DI float operator()(int k, int n) const { return W[(size_t)k * N + n] * g[k]; } };
struct SrcWie { const float* W; const float* g; DI float operator()(int k, int n) const {
    int c; if (n < 1280) c = n; else if (n < 3072) c = n + 24; else if (n < 3096) c = n - 3072 + 1280; else c = -1;
    return c < 0 ? 0.f : W[(size_t)k * NE_ORIG + c] * g[k]; } };
struct SrcUp { const float* W; const float* g; DI float operator()(int k, int n) const {
    const int c = ((n >> 7) & 1) * DFF + (n >> 8) * 128 + (n & 127); return W[(size_t)k * NUP + c] * g[k]; } };
struct SrcPhi { const float* W; DI float operator()(int k, int n) const {
    const int kv = n >> 8, r = (n >> 7) & 1, e = n & 127; return W[(size_t)kv * 262144 + (size_t)r * 131072 + (size_t)k * 128 + e]; } };
struct SrcLora { const float *w2, *a2, *g2; DI float operator()(int k, int n) const {
    const int seg = n >> 9, c = n & 511;
    if (seg == 0) return k < 64 ? w2[k * 512 + c] : 0.f;
    if (seg == 1) return (k >= 64 && k < 128) ? a2[(k - 64) * 512 + c] : 0.f;
    return k >= 128 ? g2[(k - 128) * 512 + c] : 0.f; } };

DI void row_to_bf16_ssq(const float* xrow, bf16* orow, unsigned long long* ssq, int lane) {
    const f32x4* xr = (const f32x4*)xrow + lane;
    f32x4 v[4]; float s = 0.f;
#pragma unroll
    for (int j = 0; j < 4; ++j) { v[j] = xr[64 * j]; s += (v[j].x * v[j].x + v[j].y * v[j].y) + (v[j].z * v[j].z + v[j].w * v[j].w); }
    s = wave_sum(s);
    v2u* o8 = (v2u*)orow + lane;
#pragma unroll
    for (int j = 0; j < 4; ++j) { v2u o; o.x = pk2(v[j].x, v[j].y); o.y = pk2(v[j].z, v[j].w); o8[64 * j] = o; }
    if (lane == 0) *ssq = (unsigned long long)(s * SSQ_SCALE + 0.5f);
}
DI const float* xin_row(Frame& F, int row) { return row < MP ? KIN(I_XP) + (size_t)row * DM : KIN(I_XS) + (size_t)(row - MP) * DM; }

DI void p0_prologue(Frame& F) {
    LAS float* scr = (LAS float*)(F.lds + RING_OFF + F.wave * 16384);
    const int gw = F.bid * NWAVES + F.wave, NGW = F.G * NWAVES, lane = F.lane;
    constexpr int I_WIE = 16 * (NE / 32), I_SQ = 16 * 32, I_WIO = 16 * (NO / 32), I_UP = 16 * (NUP / 32), I_DN = (DFF / 64) * 32, I_PHI = 16 * 16, I_LORA = 4 * (NLORA / 32);
    int rot = 0;
#define TR_MAT(srcexpr, K_, N_, dst, cnt) do { auto s_ = srcexpr; const int f_ = (gw + NGW - (rot % NGW)) % NGW; tr_matrix(s_, K_, N_, dst, scr, f_, NGW, cnt, lane); rot += (cnt); } while (0)
    for (int li = 0; li < 2; ++li) TR_MAT((SrcWie{KIN(I_WINE) + (size_t)li * DM * NE_ORIG, KIN(I_NMIX) + (2 * li) * DM}), DM, NE, WSP(bf16, WS_WIE) + (size_t)li * NE * DM, I_WIE);
    for (int li = 0; li < 2; ++li) TR_MAT((SrcPlain{KIN(I_WOUTE) + (size_t)li * DM * DM, DM}), DM, DM, WSP(bf16, WS_WOE) + (size_t)li * DM * DM, I_SQ);
    for (int li = 0; li < 2; ++li) TR_MAT((SrcGain{KIN(I_WINO) + (size_t)li * DM * NO, NO, KIN(I_NMIX) + (2 * li + 1) * DM}), DM, NO, WSP(bf16, WS_WIO) + (size_t)li * NO * DM, I_WIO);
    for (int li = 0; li < 2; ++li) TR_MAT((SrcPlain{KIN(I_WOUTO) + (size_t)li * DM * DM, DM}), DM, DM, WSP(bf16, WS_WOO) + (size_t)li * DM * DM, I_SQ);
    for (int l = 0; l < 4; ++l) TR_MAT((SrcUp{KIN(I_FUP) + (size_t)l * DM * NUP, KIN(I_NFFN) + l * DM}), DM, NUP, WSP(bf16, WS_WUP) + (size_t)l * NUP * DM, I_UP);
    for (int l = 0; l < 4; ++l) TR_MAT((SrcPlain{KIN(I_FDOWN) + (size_t)l * DFF * DM, DM}), DFF, DM, WSP(bf16, WS_WDN) + (size_t)l * DM * DFF, I_DN);
    for (int li = 0; li < 2; ++li) TR_MAT((SrcPhi{KIN(I_PW1) + (size_t)li * 2 * 262144}), 1024, 512, WSP(bf16, WS_PHI1) + (size_t)li * 512 * 1024, I_PHI);
    for (int li = 0; li < 2; ++li) TR_MAT((SrcLora{KIN(I_W2) + (size_t)li * 64 * 512, KIN(I_A2) + (size_t)li * 64 * 512, KIN(I_G2) + (size_t)li * 128 * 512}), KLORA, NLORA, WSP(bf16, WS_LORA) + (size_t)li * NLORA * KLORA, I_LORA);
#undef TR_MAT
    if (F.wave == NWAVES - 1 && F.bid < 256) { const int q = F.bid, jc = q >> 3, lk = (q >> 1) & 3, e = (q & 1) * 64 + lane; const float* pe = KIN(I_PPE) + (size_t)lk * 2048 + jc * 64; const float* w1 = KIN(I_PW1) + (size_t)lk * 262144 + (size_t)jc * 64 * 128;
        float a = 0.f;
#pragma unroll 16
        for (int jd = 0; jd < 64; ++jd) a += pe[jd] * w1[(size_t)jd * 128 + e];
        WSP(float, WS_PECP)[(jc * 4 + lk) * 128 + e] = a; }
    for (int m = gw; m < MT; m += NGW) row_to_bf16_ssq(xin_row(F, m), WSP(bf16, WS_XN) + (size_t)m * DM, SSQP(0) + m, lane);
}

DI void store8f(float* p, const float (&v)[8]) { *(f32x4*)p = (f32x4){v[0], v[1], v[2], v[3]}; *(f32x4*)(p + 4) = (f32x4){v[4], v[5], v[6], v[7]}; }
DI void ld8bf(const bf16* p, float (&v)[8]) { const v4u w = *(const v4u*)p; v[0] = bflo(w.x); v[1] = bfhi(w.x); v[2] = bflo(w.y); v[3] = bfhi(w.y); v[4] = bflo(w.z); v[5] = bfhi(w.z); v[6] = bflo(w.w); v[7] = bfhi(w.w); }
DI void ld8f(const float* p, float (&v)[8]) { const f32x4 a = *(const f32x4*)p, b = *(const f32x4*)(p + 4); v[0] = a.x; v[1] = a.y; v[2] = a.z; v[3] = a.w; v[4] = b.x; v[5] = b.y; v[6] = b.z; v[7] = b.w; }

struct RowRawA { v4u q; v2u kv[3]; unsigned gate; unsigned long long sq; };
struct RowRawB { v4u z[4]; unsigned long long sq; };
DI RowRawA load_row_a(const bf16* zr, const unsigned long long* sq, int lane) { RowRawA r; r.sq = *sq; r.q = *(const v4u*)(zr + lane * 8);
#pragma unroll
    for (int c = 0; c < 3; ++c) r.kv[c] = *(const v2u*)(zr + 512 + c * 256 + lane * 4);
    r.gate = zr[3072 + lane]; return r; }
DI RowRawB load_row_b(const bf16* zr, const unsigned long long* sq, int lane) { RowRawB r; r.sq = *sq;
#pragma unroll
    for (int p = 0; p < 4; ++p) r.z[p] = *(const v4u*)(zr + 1280 + p * 512 + lane * 8);
    return r; }
DI void unpk8(const v4u w, float (&v)[8]) { v[0] = bflo(w.x); v[1] = bfhi(w.x); v[2] = bflo(w.y); v[3] = bfhi(w.y); v[4] = bflo(w.z); v[5] = bfhi(w.z); v[6] = bflo(w.w); v[7] = bfhi(w.w); }
DI void post_even_run(Frame& F, int li, int l, bool samp, int b, int tbase, int row0, int ntok) {
    const int lane = F.lane;
    LAS bf16* vts = (LAS bf16*)(F.lds + RING_OFF);
    LAS bf16* vtw = vts + 2 * 64 * 66;
    const bf16* ZB = WSP(bf16, WS_ZB);
    float kn1[4], kn2[4];
    { const f32x4 a = *(const f32x4*)(KIN(I_KN) + (li * 3 + 1) * 64 + (lane & 15) * 4), c = *(const f32x4*)(KIN(I_KN) + (li * 3 + 2) * 64 + (lane & 15) * 4);
      kn1[0] = a.x; kn1[1] = a.y; kn1[2] = a.z; kn1[3] = a.w; kn2[0] = c.x; kn2[1] = c.y; kn2[2] = c.z; kn2[3] = c.w; }
    const unsigned long long* ssq = SSQP(2 * l);
    float qg[8]; ld8f(KIN(I_QN) + li * 64 + (lane & 7) * 8, qg);
    RowRawA nx = load_row_a(ZB + (size_t)row0 * NE, ssq + row0, lane);
    for (int i8 = 0; i8 < ntok; ++i8) {
        const int t = tbase + i8, row = row0 + i8;
        const RowRawA cu = nx;
        if (i8 < ntok - 1) nx = load_row_a(ZB + (size_t)(row + 1) * NE, ssq + row + 1, lane);
        const float rin = __builtin_amdgcn_rsqf((float)cu.sq * (1.f / (SSQ_SCALE * DM)) + RMS_EPS);
        { float x[8]; unpk8(cu.q, x); float ss = 0.f;
#pragma unroll
          for (int i = 0; i < 8; ++i) x[i] *= rin;
#pragma unroll
          for (int i = 0; i < 8; ++i) ss += x[i] * x[i];
          ss = sum8(ss); const float rinv = 1.0f / sqrtf(ss * (1.f / 64.f) + RMS_EPS);
          v4u o; o.x = pk2(x[0] * rinv * qg[0], x[1] * rinv * qg[1]); o.y = pk2(x[2] * rinv * qg[2], x[3] * rinv * qg[3]); o.z = pk2(x[4] * rinv * qg[4], x[5] * rinv * qg[5]); o.w = pk2(x[6] * rinv * qg[6], x[7] * rinv * qg[7]);
          *(v4u*)(WSP(bf16, WS_QB) + (size_t)row * 512 + lane * 8) = o; }
#pragma unroll
        for (int c = 0; c < 3; ++c) {
            const v2u wv = cu.kv[c];
            float x[4] = {bflo(wv.x) * rin, bfhi(wv.x) * rin, bflo(wv.y) * rin, bfhi(wv.y) * rin};
            const int g = (lane >> 4) & 1, dd = (lane & 15) * 4; const bool isv = lane >= 32;
            if (c > 0) { float ss = (x[0] * x[0] + x[1] * x[1]) + (x[2] * x[2] + x[3] * x[3]); ss = sum16(ss);
                if (!isv) { const float rinv = 1.0f / sqrtf(ss * (1.f / 64.f) + RMS_EPS);
#pragma unroll
                    for (int i = 0; i < 4; ++i) x[i] = x[i] * rinv * (c == 1 ? kn1[i] : kn2[i]); } }
            float* op = nullptr;
            if (c == 0) op = OUTF + (samp ? O_CMPS + ((size_t)(b * 2 + li) * DT + t) * 256 : O_CMPP + ((size_t)(b * 2 + li) * SEQ + t) * 256);
            else if (c == 1) op = OUTF + (samp ? O_SLCS + ((size_t)(b * 2 + li) * DT + t) * 256 : O_SLCP + ((size_t)(b * 2 + li) * SEQ + t) * 256);
            else { if (samp) op = OUTF + O_WINS + ((size_t)(b * 2 + li) * WIN + (WIN - DT) + t) * 256; else if (t >= SEQ - WIN) op = OUTF + O_WINP + ((size_t)(b * 2 + li) * WIN + (t - (SEQ - WIN))) * 256; }
            if (op) *(f32x4*)(op + lane * 4) = (f32x4){x[0], x[1], x[2], x[3]};
            if (!samp) {
                v2u pk; pk.x = pk2(x[0], x[1]); pk.y = pk2(x[2], x[3]);
                if (c == 0) { const int rw = (isv ? CS_PV : CS_PK) + (b * 2 + g) * 128 + (t >> 4);
                    *(v2u*)(WSP(bf16, WS_CSEG) + (size_t)rw * 1024 + (t & 15) * 64 + dd) = pk; }
                else if (!isv) { *(v2u*)(WSP(bf16, c == 1 ? WS_KS : WS_KW) + ((size_t)(b * 2 + g) * SEQ + t) * 64 + dd) = pk; }
                else { LAS bf16* vt = (c == 1 ? vts : vtw) + (g * 64 + dd) * 66 + (t & 63);
                    vt[0] = (bf16)(pk.x & 0xffffu); vt[66] = (bf16)(pk.x >> 16); vt[132] = (bf16)(pk.y & 0xffffu); vt[198] = (bf16)(pk.y >> 16); }
            }
        }
        if (lane < 24) WSP(float, WS_GATE)[(size_t)row * 32 + lane] = sigmoidf_(bf2f(cu.gate) * rin);
    }
    float zp[4][8];
#pragma unroll
    for (int p = 0; p < 4; ++p) {
        const bool act = (p < 3 || lane < 32);
        if (!act) { for (int i = 0; i < 8; ++i) zp[p][i] = 0.f; }
        else if (tbase == 0) { if (samp) ld8f(KIN(I_SSHIFT) + (size_t)(b * 2 + li) * RWP + p * 512 + lane * 8, zp[p]); else { for (int i = 0; i < 8; ++i) zp[p][i] = 0.f; } }
        else { ld8bf(ZB + (size_t)(row0 - 1) * NE + 1280 + p * 512 + lane * 8, zp[p]); const float rp = rinv_of(ssq, row0 - 1);
#pragma unroll
            for (int i = 0; i < 8; ++i) zp[p][i] *= rp; }
    }
    float mu[4][8], kkw[8]; ld8f(KIN(I_KKW) + li * 512 + lane * 8, kkw);
#pragma unroll
    for (int p = 0; p < 4; ++p) { if (p < 3 || lane < 32) ld8f(KIN(I_MU) + li * RWP + p * 512 + lane * 8, mu[p]); else { for (int i = 0; i < 8; ++i) mu[p][i] = 0.f; } }
    RowRawB nb = load_row_b(ZB + (size_t)row0 * NE, ssq + row0, lane);
    for (int i8 = 0; i8 < ntok; ++i8) {
        const int t = tbase + i8, row = row0 + i8;
        const RowRawB cu = nb;
        if (i8 < ntok - 1) nb = load_row_b(ZB + (size_t)(row + 1) * NE, ssq + row + 1, lane);
        const float rin = __builtin_amdgcn_rsqf((float)cu.sq * (1.f / (SSQ_SCALE * DM)) + RMS_EPS);
        const bool lastt = samp ? (t == DT - 1) : (t == SEQ - 1);
#pragma unroll
        for (int p = 0; p < 4; ++p) {
            if (p < 3 || lane < 32) {
                float z[8], zz[8]; unpk8(cu.z[p], z);
#pragma unroll
                for (int i = 0; i < 8; ++i) z[i] *= rin;

#pragma unroll
                for (int i = 0; i < 8; ++i) { zz[i] = z[i] + (zp[p][i] - z[i]) * mu[p][i]; zp[p][i] = z[i]; }
                if (lastt) store8f(OUTF + (samp ? O_SHS : O_SHP) + (size_t)(b * 2 + li) * RWP + p * 512 + lane * 8, z);
                const int h = lane >> 3, d = (lane & 7) * 8;
                unsigned char* scb = (unsigned char*)SCREC(row, h) + d * 2;
                v4u zb; zb.x = pk2(zz[0], zz[1]); zb.y = pk2(zz[2], zz[3]); zb.z = pk2(zz[4], zz[5]); zb.w = pk2(zz[6], zz[7]);
                if (p == 0) *(v4u*)(scb + SCR_R) = zb;
                else if (p == 2) *(v4u*)(scb + SCR_V) = zb;
                else if (p == 1) { *(v4u*)(scb + SCR_K) = zb; float kk[8]; float ss = 0.f;
#pragma unroll
                    for (int i = 0; i < 8; ++i) { kk[i] = zz[i] * kkw[i]; ss += kk[i] * kk[i]; }
                    ss = sum8(ss); const float rinv = 1.0f / sqrtf(fmaxf(ss, 1e-24f));
#pragma unroll
                    for (int i = 0; i < 8; ++i) kk[i] *= rinv;
                    v4u kb; kb.x = pk2(kk[0], kk[1]); kb.y = pk2(kk[2], kk[3]); kb.z = pk2(kk[4], kk[5]); kb.w = pk2(kk[6], kk[7]); *(v4u*)(scb + SCR_KK) = kb; }
                else { float o[8];
#pragma unroll
                    for (int i = 0; i < 8; ++i) o[i] = lane < 8 ? tanhf_(zz[i]) : (lane < 16 ? zz[i] : sigmoidf_(zz[i]));
                    v4u pk; pk.x = pk2(o[0], o[1]); pk.y = pk2(o[2], o[3]); pk.z = pk2(o[4], o[5]); pk.w = pk2(o[6], o[7]);
                    *(v4u*)(WSP(bf16, WS_LA) + (size_t)row * 256 + lane * 8) = pk; }
            }
        }
    }
}
DI void post_even_tile(Frame& F, int tt, int li, int l) {
    const int w = F.wave, b = tt >> 5, blk = tt & 31;
    post_even_run(F, li, l, false, b, blk * 64 + 8 * w, b * SEQ + blk * 64 + 8 * w, 8);
    if (w < 4) { const int st = tt * 4 + w; post_even_run(F, li, l, true, st >> 3, st & 7, MP + st, 1); }
    LAS bf16* vts = (LAS bf16*)(F.lds + RING_OFF); LAS bf16* vtw = vts + 2 * 64 * 66;
    {
        __syncthreads();
#pragma unroll
        for (int a = 0; a < 2; ++a) { const LAS bf16* vt = a ? vtw : vts; const int ri = F.tid >> 2, q4 = F.tid & 3;
            const LAS unsigned* s = (const LAS unsigned*)(vt + ri * 66 + q4 * 16);
            v4u o0, o1; o0.x = s[0]; o0.y = s[1]; o0.z = s[2]; o0.w = s[3]; o1.x = s[4]; o1.y = s[5]; o1.z = s[6]; o1.w = s[7];
            bf16* dst = WSP(bf16, a ? WS_VWT : WS_VST) + (((size_t)(b * 2 + (ri >> 6)) * 32 + blk) * 64 + (ri & 63)) * 64 + q4 * 16;
            *(v4u*)dst = o0; *(v4u*)(dst + 8) = o1; }
        __syncthreads();
    }
}
DI void cseg_page_load(Frame& F, int u, int li, f32x4 (&v)[8][2]) {
    const int b = u >> 4, p = u & 15; const int pg = ((const int*)KIN(I_PT))[b * NPAGE + p];
    const float* src = KIN(I_CCMP) + ((size_t)pg * 2 + li) * (PAGE * 256);
#pragma unroll
    for (int k = 0; k < 8; ++k) { const int q = k * NTHREADS + F.tid; const f32x4* sp = (const f32x4*)(src + (size_t)(q >> 5) * 256 + (q & 31) * 8);
        v[k][0] = __builtin_nontemporal_load(sp); v[k][1] = __builtin_nontemporal_load(sp + 1); }
}
DI void cseg_page_store(Frame& F, int u, const f32x4 (&v)[8][2]) {
    const int b = u >> 4, p = u & 15; bf16* CS = WSP(bf16, WS_CSEG);
#pragma unroll
    for (int k = 0; k < 8; ++k) { const int q = k * NTHREADS + F.tid; const int r = q >> 5, c = q & 31;
        const int kv = c >> 4, g = (c >> 3) & 1, d0 = (c & 7) * 8;
        v4u o; o.x = pk2(v[k][0].x, v[k][0].y); o.y = pk2(v[k][0].z, v[k][0].w); o.z = pk2(v[k][1].x, v[k][1].y); o.w = pk2(v[k][1].z, v[k][1].w);
        *(v4u*)(CS + ((size_t)((kv ? CS_SV : CS_SK) + (b * 2 + g) * 128 + p * 8 + (r >> 4))) * 1024 + (r & 15) * 64 + d0) = o; }
}
DI void cseg_page_unit(Frame& F, int u, int li) { f32x4 v[8][2]; cseg_page_load(F, u, li, v); cseg_page_store(F, u, v); }
DI void win_copy_unit(Frame& F, int u, int li) {
    const int b = u / 9, q = u % 9;
    const f32x4* src = (const f32x4*)(KIN(I_CWIN) + ((size_t)(b * 2 + li) * WIN + DT + q * 56) * 256) + F.tid;
    f32x4* dst = (f32x4*)(OUTF + O_WINS + ((size_t)(b * 2 + li) * WIN + q * 56) * 256) + F.tid;
    f32x4 v[7];
#pragma unroll
    for (int k = 0; k < 7; ++k) v[k] = __builtin_nontemporal_load(src + k * NTHREADS);
#pragma unroll
    for (int k = 0; k < 7; ++k) __builtin_nontemporal_store(v[k], dst + k * NTHREADS);
}
DI void bg_units(Frame& F, int li, int max_tickets) {
    constexpr int NTK = (DB * NPAGE + DB * 9) / 4;
    volatile LAS unsigned* tk = F.MISC + 17;
    for (int n = 0; n < max_tickets; ++n) {
        __syncthreads();
        if (F.tid == 0) tk[0] = __hip_atomic_fetch_add((unsigned*)(F.ctl + CW_QUEUE + 16 + 32 * li), 1u, RLX_AGENT);
        __syncthreads();
        const int t4 = __builtin_amdgcn_readfirstlane((int)tk[0]);
        if (t4 >= NTK) break;
#pragma unroll 1
        for (int k = 0; k < 4; ++k) { LAUNDER(F); const int u = t4 * 4 + k; if (u < DB * NPAGE) cseg_page_unit(F, u, li); else win_copy_unit(F, u - DB * NPAGE, li); }
    }
}
DI void post_even_phase(Frame& F, int li, int l) {
    for (int u = F.bid; u < 256; u += F.G) post_even_tile(F, u, li, l);
    bg_units(F, li, 1 << 30);
}

DI float gelu_tanh(float x) { const float u = 0.7978845608028654f * (x + 0.044715f * x * x * x); return 0.5f * x * (1.0f + tanhf_(u)); }
DI void compress2_stage_w2(Frame& F, int li) {
    LAS bf16* w2t = (LAS bf16*)(F.lds + RING_OFF);
    const float* w2 = KIN(I_PW2) + (size_t)li * 2 * 128 * 64;
    for (int i = F.tid; i < 2 * 128 * 64; i += NTHREADS) { const int kv = i >> 13, e = (i >> 6) & 127, d = i & 63; w2t[(kv * 64 + d) * 136 + e] = (bf16)(pk2(w2[i], 0.f) & 0xffffu); }
    if (F.tid < 256) { float a = 0.f; const float* pp = WSP(float, WS_PECP) + li * 256 + F.tid;
#pragma unroll 8
        for (int jc = 0; jc < 32; ++jc) a += pp[jc * 512];
        ((LAS float*)(F.lds + RING_OFF + 36864))[F.tid] = a; }
    __syncthreads();
}
DI void compress2_unit(Frame& F, int cu, int li) {
    const int w = F.wave, lane = F.lane, kl = lane & 31, h = lane >> 5, kv = w >> 2, n = (w & 3) * 32 + kl;
    const LAS bf16* w2t = (const LAS bf16*)(F.lds + RING_OFF) + kv * 64 * 136;
    const bool prm = cu >= 256; const int bg = prm ? cu - 256 : cu;
    const size_t rb = (size_t)(prm ? (kv ? CS_PV : CS_PK) : (kv ? CS_SV : CS_SK)) + (size_t)bg * 128;
    const float* p0 = WSP(float, WS_PART) + (rb + n) * 256 + 8 * h; const float* p1 = p0 + 256 + 128; const LAS float* pec = (const LAS float*)(F.lds + RING_OFF + 36864) + kv * 128 + 8 * h;
    f32x16 C[2];
#pragma unroll
    for (int i = 0; i < 16; ++i) { C[0][i] = 0.f; C[1][i] = 0.f; }
#pragma unroll
    for (int ks = 0; ks < 8; ++ks) {
        float x0[8], x1[8], pc[8]; ld8f(p0 + 16 * ks, x0); ld8f(p1 + 16 * ks, x1);
#pragma unroll
        for (int j = 0; j < 8; ++j) pc[j] = pec[16 * ks + j];
        v4u bv; bv.x = pk2(gelu_tanh(pc[0] + x0[0] + x1[0]), gelu_tanh(pc[1] + x0[1] + x1[1])); bv.y = pk2(gelu_tanh(pc[2] + x0[2] + x1[2]), gelu_tanh(pc[3] + x0[3] + x1[3]));
        bv.z = pk2(gelu_tanh(pc[4] + x0[4] + x1[4]), gelu_tanh(pc[5] + x0[5] + x1[5])); bv.w = pk2(gelu_tanh(pc[6] + x0[6] + x1[6]), gelu_tanh(pc[7] + x0[7] + x1[7]));
        const bf16x8 bf = __builtin_bit_cast(bf16x8, bv);
#pragma unroll
        for (int dt = 0; dt < 2; ++dt) { const bf16x8 a = *(const LAS bf16x8*)(w2t + (dt * 32 + kl) * 136 + 16 * ks + 8 * h); C[dt] = MFMA32(a, bf, C[dt]); }
    }
    const bool valid = n < NCMP;
    if (kv == 0) {
        float ss = 0.f;
#pragma unroll
        for (int dt = 0; dt < 2; ++dt)
#pragma unroll
            for (int i = 0; i < 16; ++i) ss += C[dt][i] * C[dt][i];
        ss += __shfl_xor(ss, 32);
        const float rinv = valid ? 1.0f / sqrtf(ss * (1.f / 64.f) + RMS_EPS) : 0.f;
        bf16* KC = WSP(bf16, WS_KC) + (size_t)cu * 8192 + n * 64; const float* kn = KIN(I_KN) + (li * 3 + 0) * 64;
#pragma unroll
        for (int dt = 0; dt < 2; ++dt)
#pragma unroll
            for (int a = 0; a < 4; ++a) { const int d0 = dt * 32 + 8 * a + 4 * h; const f32x4 g = *(const f32x4*)(kn + d0);
                v2u o; o.x = pk2(C[dt][4 * a] * rinv * g.x, C[dt][4 * a + 1] * rinv * g.y); o.y = pk2(C[dt][4 * a + 2] * rinv * g.z, C[dt][4 * a + 3] * rinv * g.w); if (!valid) { o.x = 0u; o.y = 0u; } *(v2u*)(KC + d0) = o; }
    } else {
        bf16* VCT = WSP(bf16, WS_VCT) + (size_t)cu * 8192 + n;
#pragma unroll
        for (int dt = 0; dt < 2; ++dt)
#pragma unroll
            for (int i = 0; i < 16; ++i) VCT[(dt * 32 + crow(i, h)) * 128] = (bf16)(pk2(valid ? C[dt][i] : 0.f, 0.f) & 0xffffu);
    }
}
DI void compress2_phase(Frame& F, int li) { compress2_stage_w2(F, li); for (int u = F.bid; u < 272; u += F.G) compress2_unit(F, u, li); __syncthreads(); }

DI void odd_mix_phase(Frame& F, int li, int l) {
    const unsigned long long* ssq = SSQP(2 * l);
    const bf16* ZB = WSP(bf16, WS_ZB); bf16* MIX = WSP(bf16, WS_MIX);
    const float* cw = KIN(I_CONVW) + (size_t)li * 3 * DM;
    constexpr int NCG = DM / 8, NRUN = MT / 8;
    for (int it = F.bid * NTHREADS + F.tid; it < NRUN * NCG; it += F.G * NTHREADS) {
        const int run = it / NCG, ch = (it % NCG) * 8;
        const bool samp = run >= MP / 8; const int b = samp ? run - MP / 8 : run >> 8, t0 = samp ? 0 : (run & 255) * 8, row0 = run * 8;
        v4u rb[8], rc[10], rx[10]; unsigned long long sq[10];
        const bool halo = t0 != 0;
#pragma unroll
        for (int j = 0; j < 10; ++j) { const int rr = halo ? row0 - 2 + j : (j < 2 ? row0 : row0 - 2 + j); const bf16* zr = ZB + (size_t)rr * NO;
            rc[j] = *(const v4u*)(zr + DM + ch); rx[j] = *(const v4u*)(zr + 2 * DM + ch); sq[j] = ssq[rr]; if (j >= 2) rb[j - 2] = *(const v4u*)(zr + ch); }
        float w0[8], w1[8], w2[8], p2[8], p1[8];
        ld8f(cw + ch, w0); ld8f(cw + DM + ch, w1); ld8f(cw + 2 * DM + ch, w2);
        if (!halo) { if (samp) { ld8f(KIN(I_SCONV) + ((size_t)(b * 2 + li) * 2 + 0) * DM + ch, p2); ld8f(KIN(I_SCONV) + ((size_t)(b * 2 + li) * 2 + 1) * DM + ch, p1); }
                     else { for (int i = 0; i < 8; ++i) { p2[i] = 0.f; p1[i] = 0.f; } } }
        else { float a[8], c[8]; float rr = __builtin_amdgcn_rsqf((float)sq[0] * (1.f / (SSQ_SCALE * DM)) + RMS_EPS); rr *= rr; unpk8(rc[0], a); unpk8(rx[0], c); for (int i = 0; i < 8; ++i) p2[i] = a[i] * c[i] * rr;
               rr = __builtin_amdgcn_rsqf((float)sq[1] * (1.f / (SSQ_SCALE * DM)) + RMS_EPS); rr *= rr; unpk8(rc[1], a); unpk8(rx[1], c); for (int i = 0; i < 8; ++i) p1[i] = a[i] * c[i] * rr; }
#pragma unroll
        for (int j = 0; j < 8; ++j) {
            float bgv[8], cg[8], xi[8], p[8], o[8]; unpk8(rb[j], bgv); unpk8(rc[j + 2], cg); unpk8(rx[j + 2], xi);
            const float rin = __builtin_amdgcn_rsqf((float)sq[j + 2] * (1.f / (SSQ_SCALE * DM)) + RMS_EPS), rin2 = rin * rin;
#pragma unroll
            for (int i = 0; i < 8; ++i) { p[i] = cg[i] * xi[i] * rin2; o[i] = bgv[i] * rin * (w0[i] * p2[i] + w1[i] * p1[i] + w2[i] * p[i]); p2[i] = p1[i]; p1[i] = p[i]; }
            v4u pk; pk.x = pk2(o[0], o[1]); pk.y = pk2(o[2], o[3]); pk.z = pk2(o[4], o[5]); pk.w = pk2(o[6], o[7]);
            *(v4u*)(MIX + (size_t)(row0 + j) * DM + ch) = pk;
            const int t = t0 + j; const int tl = samp ? DT : SEQ;
            if (t >= tl - 2) store8f(OUTF + (samp ? O_CVS : O_CVP) + ((size_t)(b * 2 + li) * 2 + (t - (tl - 2))) * DM + ch, p);
        }
    }
}
DI void ffn_act_phase(Frame& F, int l) {
    const unsigned long long* ssq = SSQP(2 * l + 1);
    const bf16* AU = WSP(bf16, WS_ZB); bf16* H = WSP(bf16, WS_H);
    const float* cw = KIN(I_FCONV) + (size_t)l * 3 * DFF;
    constexpr int NCG = DFF / 8, NRUN = MT / 8;
    for (int it = F.bid * NTHREADS + F.tid; it < NRUN * NCG; it += F.G * NTHREADS) {
        const int run = it / NCG, ch = (it % NCG) * 8;
        const bool samp = run >= MP / 8; const int b = samp ? run - MP / 8 : run >> 8, t0 = samp ? 0 : (run & 255) * 8, row0 = run * 8;
        float w0[8], w1[8], w2[8], a2[8], a1[8];
        ld8f(cw + ch, w0); ld8f(cw + DFF + ch, w1); ld8f(cw + 2 * DFF + ch, w2);
        if (t0 == 0) { if (samp) { ld8f(KIN(I_SFFN) + ((size_t)(b * 4 + l) * 2 + 0) * DFF + ch, a2); ld8f(KIN(I_SFFN) + ((size_t)(b * 4 + l) * 2 + 1) * DFF + ch, a1); }
                       else { for (int i = 0; i < 8; ++i) { a2[i] = 0.f; a1[i] = 0.f; } } }
        else { ld8bf(AU + (size_t)(row0 - 2) * NUP + ch, a2); ld8bf(AU + (size_t)(row0 - 1) * NUP + ch, a1); const float r2 = rinv_of(ssq, row0 - 2), r1 = rinv_of(ssq, row0 - 1); for (int i = 0; i < 8; ++i) { a2[i] *= r2; a1[i] *= r1; } }
#pragma unroll
        for (int j = 0; j < 8; ++j) {
            const bf16* zr = AU + (size_t)(row0 + j) * NUP; float a[8], uu[8], o[8];
            ld8bf(zr + ch, a); ld8bf(zr + DFF + ch, uu);
            const float rin = rinv_of(ssq, row0 + j);
#pragma unroll
            for (int i = 0; i < 8; ++i) { a[i] *= rin; const float y = w0[i] * a2[i] + w1[i] * a1[i] + w2[i] * a[i]; o[i] = y * sigmoidf_(y) * uu[i] * rin; a2[i] = a1[i]; a1[i] = a[i]; }
            v4u pk; pk.x = pk2(o[0], o[1]); pk.y = pk2(o[2], o[3]); pk.z = pk2(o[4], o[5]); pk.w = pk2(o[6], o[7]);
            *(v4u*)(H + (size_t)(row0 + j) * DFF + ch) = pk;
            const int t = t0 + j; const int tl = samp ? DT : SEQ;
            if (t >= tl - 2) store8f(OUTF + (samp ? O_FFS : O_FFP) + ((size_t)(b * 4 + l) * 2 + (t - (tl - 2))) * DFF + ch, a);
        }
    }
}

DI int rel_bucket(int d) {
    if (d < 16) return d;
    int bkt = 16;
    bkt += (d >= 19) + (d >= 21) + (d >= 24) + (d >= 27) + (d >= 31) + (d >= 35) + (d >= 40) + (d >= 46) + (d >= 52) + (d >= 59) + (d >= 67) + (d >= 77) + (d >= 87) + (d >= 99) + (d >= 113);
    return bkt;
}
DI void fill_bias_table(Frame& F, LAS float* biasT, int g) {
    const int hq = F.tid >> 7, d = F.tid & 127;
    biasT[F.tid] = KIN(I_RELB)[rel_bucket(d) * 8 + g * 4 + hq] * LOG2E;
}
DI bf16x8 pack_p(const f32x16& p, int s) {
    v4u r; r.x = pk2(p[8 * s + 0], p[8 * s + 1]); r.y = pk2(p[8 * s + 2], p[8 * s + 3]); r.z = pk2(p[8 * s + 4], p[8 * s + 5]); r.w = pk2(p[8 * s + 6], p[8 * s + 7]);
    return __builtin_bit_cast(bf16x8, r);
}
DI float xhalf_max(float x) { return fmaxf(x, __shfl_xor(x, 32)); }
DI float xhalf_sum(float x) { return x + __shfl_xor(x, 32); }
constexpr float SC2 = 0.125f * LOG2E;
constexpr float NEG_BIG = -1e30f;

constexpr float SREF = 8.0f;
DI void softmax_pv(f32x16& s, float& l, f32x16 (&O)[2], const bf16x8 (&vf)[2][2]) {
    float ps0 = 0.f, ps1 = 0.f;
#pragma unroll
    for (int i = 0; i < 16; i += 2) { s[i] = fexp2(s[i]); s[i + 1] = fexp2(s[i + 1]); ps0 += s[i]; ps1 += s[i + 1]; }
    l += ps0 + ps1;
    const bf16x8 p0 = pack_p(s, 0), p1 = pack_p(s, 1);
#pragma unroll
    for (int dt = 0; dt < 2; ++dt) { O[dt] = MFMA32(vf[dt][0], p0, O[dt]); O[dt] = MFMA32(vf[dt][1], p1, O[dt]); }
}

DI void cmp_branch(const bf16x8 (&qf)[4], const bf16* kc, const bf16* vct, int t, int ccur, const LAS float* biasT, int lane, LAS float* scr, f32x16 (&Oc)[2], unsigned& selmask) {
    const int kl = lane & 31, h = lane >> 5, hq = kl & 3, tl = kl >> 2;
    f32x16 S[4];
#pragma unroll
    for (int kt = 0; kt < 4; ++kt) {
#pragma unroll
        for (int i = 0; i < 16; ++i) S[kt][i] = 0.f;
#pragma unroll
        for (int ks = 0; ks < 4; ++ks) { const bf16x8 a = *(const bf16x8*)(kc + (32 * kt + kl) * 64 + 16 * ks + 8 * h); S[kt] = MFMA32(a, qf[ks], S[kt]); }
    }
    const int nmax = (t - 31) >> 4;
    float mx = NEG_BIG;
#pragma unroll
    for (int kt = 0; kt < 4; ++kt) {
        float bv[16];
#pragma unroll
        for (int i = 0; i < 16; ++i) { const int n = 32 * kt + crow(i, h); const int dist = t - (16 * n + 31); const int idx = dist < 0 ? 0 : (dist > 127 ? 127 : dist); bv[i] = biasT[hq * 128 + idx]; }
#pragma unroll
        for (int i = 0; i < 16; ++i) { const int n = 32 * kt + crow(i, h); float v = S[kt][i] * SC2 + bv[i]; v = (n <= nmax) ? v : -INFINITY; S[kt][i] = v; mx = fmaxf(mx, v); }
    }
    mx = xhalf_max(mx);
    float sum = 0.f;
#pragma unroll
    for (int kt = 0; kt < 4; ++kt)
#pragma unroll
        for (int i = 0; i < 16; ++i) { const float e = fexp2(S[kt][i] - mx); S[kt][i] = e; sum += e; }
    sum = xhalf_sum(sum);
    const float inv = sum > 0.f ? 1.0f / sum : 0.f;
#pragma unroll
    for (int kt = 0; kt < 4; ++kt) S[kt] = S[kt] * inv;
    f32x16 I;
#pragma unroll
    for (int i = 0; i < 16; ++i) { Oc[0][i] = 0.f; Oc[1][i] = 0.f; I[i] = 0.f; }
#pragma unroll
    for (int kt = 0; kt < 4; ++kt)
#pragma unroll
        for (int st = 0; st < 2; ++st) {
            const bf16x8 ph = pack_p(S[kt], st);
            f32x16 lo = S[kt];
#pragma unroll
            for (int j = 0; j < 8; ++j) { const unsigned short hb = (unsigned short)ph[j]; lo[8 * st + j] = S[kt][8 * st + j] - bf2f(hb); }
            const bf16x8 pl = pack_p(lo, st);
#pragma unroll
            for (int dt = 0; dt < 2; ++dt) { const bf16* vr = vct + (dt * 32 + kl) * 128 + 32 * kt + 16 * st + 4 * h;
                const v2u a0 = *(const v2u*)vr, a1 = *(const v2u*)(vr + 8); v4u av; av.x = a0.x; av.y = a0.y; av.z = a1.x; av.w = a1.y;
                Oc[dt] = MFMA32(__builtin_bit_cast(bf16x8, av), ph, Oc[dt]); }
            bf16x8 ov;
#pragma unroll
            for (int j = 0; j < 8; ++j) { const int n = 32 * kt + 16 * st + 8 * (j >> 2) + 4 * h + (j & 3); ov[j] = (n >= 4 * kl - 1 && n <= 4 * kl + 3) ? (short)0x3F80 : (short)0; }
            I = MFMA32(ov, ph, I); I = MFMA32(ov, pl, I);
        }
#pragma unroll
    for (int i = 0; i < 16; ++i) I[i] = sum4(I[i]);
    if (hq == 0) {
#pragma unroll
        for (int i = 0; i < 16; ++i) { const int sb = crow(i, h); scr[tl * 33 + sb] = (sb >= 1 && sb <= ccur - 2) ? I[i] : -INFINITY; }
    }
    LDS_WAIT(); asm volatile("" ::: "memory");
    float v[32];
#pragma unroll
    for (int s = 0; s < 32; ++s) v[s] = scr[tl * 33 + s];
    const int sub = hq + 4 * h;
    unsigned bits = 0u;
#pragma unroll
    for (int k = 0; k < 4; ++k) { const int sk = 4 * sub + k; const float x = scr[tl * 33 + sk]; int cnt = 0;
#pragma unroll
        for (int s = 0; s < 32; ++s) cnt += (v[s] > x || (v[s] == x && s < sk)) ? 1 : 0;
        if (sk >= 1 && sk <= ccur - 2 && cnt < 13) bits |= 1u << sk; }
    LDS_WAIT(); asm volatile("" ::: "memory");
    bits |= dppu<XOR1>(bits); bits |= dppu<XOR2>(bits); bits |= (unsigned)__shfl_xor((int)bits, 32);
    unsigned forced = 1u;
    if (ccur < 32) forced |= 1u << ccur;
    if (ccur >= 1) forced |= 1u << (ccur - 1);
    selmask = bits | forced;
}

constexpr int KV_PITCH = 72;
constexpr int AT_KBUF = 0, AT_VBUF = 2 * 64 * KV_PITCH * 2, AT_BIAS = 2 * AT_VBUF, AT_SCR = AT_BIAS + 2048, AT_OUT = AT_SCR + 8 * 8 * 33 * 4, AT_END = AT_OUT + 8 * 64 * 32 * 4;
template <int MODE>
DI void prompt_branch(Frame& F, const bf16* Kg, const bf16* Vg, int s_lo, int s_hi, int c, int t, unsigned sel, const bf16x8 (&qf)[4], const LAS float* biasT, float gate, LAS float* outw) {
    const int lane = F.lane, kl = lane & 31, h = lane >> 5, hq = kl & 3;
    LAS bf16* Kb = (LAS bf16*)(F.lds + RING_OFF + AT_KBUF); LAS bf16* Vb = (LAS bf16*)(F.lds + RING_OFF + AT_VBUF);
    const int srow = F.tid >> 3, spc = F.tid & 7;
    f32x16 O[2]; float l = 0.f;
#pragma unroll
    for (int i = 0; i < 16; ++i) { O[0][i] = 0.f; O[1][i] = 0.f; }
    const float bfar = biasT[hq * 128 + 127] - SREF;
    v4u kr = *(const v4u*)(Kg + ((size_t)s_lo * 64 + srow) * 64 + spc * 8), vr = *(const v4u*)(Vg + ((size_t)s_lo * 64 + srow) * 64 + spc * 8);
    *(LAS v4u*)(Kb + srow * KV_PITCH + spc * 8) = kr; *(LAS v4u*)(Vb + srow * KV_PITCH + spc * 8) = vr;
    __syncthreads();
    int buf = 0;
    for (int s = s_lo; s <= s_hi; ++s) {
        if (s < s_hi) { kr = *(const v4u*)(Kg + ((size_t)(s + 1) * 64 + srow) * 64 + spc * 8); vr = *(const v4u*)(Vg + ((size_t)(s + 1) * 64 + srow) * 64 + spc * 8); }
        const bool act = (MODE == 1) ? true : (((sel >> s) & 1u) != 0u);
        if (__any(act)) {
            const LAS bf16* kb = Kb + buf * 64 * KV_PITCH; const LAS bf16* vb = Vb + buf * 64 * KV_PITCH;
            const bool near = s >= c - 2;
#pragma unroll
            for (int kt = 0; kt < 2; ++kt) {
                f32x16 S;
#pragma unroll
                for (int i = 0; i < 16; ++i) S[i] = 0.f;
#pragma unroll
                for (int ks = 0; ks < 4; ++ks) { const bf16x8 a = *(const LAS bf16x8*)(kb + (32 * kt + kl) * KV_PITCH + 16 * ks + 8 * h); S = MFMA32(a, qf[ks], S); }
                bf16x8 vf[2][2];
#pragma unroll
                for (int dt = 0; dt < 2; ++dt)
#pragma unroll
                    for (int st = 0; st < 2; ++st) { const LAS bf16* vp = vb + (dt * 32 + kl) * KV_PITCH + 32 * kt + 16 * st + 4 * h;
                        const v2u a0 = *(const LAS v2u*)vp, a1 = *(const LAS v2u*)(vp + 8); v4u av; av.x = a0.x; av.y = a0.y; av.z = a1.x; av.w = a1.y; vf[dt][st] = __builtin_bit_cast(bf16x8, av); }
                const int key0 = 64 * s + 32 * kt;
                if (near) {
                    float bv[16];
#pragma unroll
                    for (int i = 0; i < 16; ++i) { const int dist = t - (key0 + crow(i, h)); const int idx = dist < 0 ? 0 : (dist > 127 ? 127 : dist); bv[i] = biasT[hq * 128 + idx]; }
#pragma unroll
                    for (int i = 0; i < 16; ++i) { const int dist = t - (key0 + crow(i, h)); const bool ok = act && dist >= 0 && (MODE == 0 || dist < WIN); const float v = S[i] * SC2 + (bv[i] - SREF); S[i] = ok ? v : -INFINITY; }
                } else if (MODE == 1 && s == c - 8) {
#pragma unroll
                    for (int i = 0; i < 16; ++i) { const int dist = t - (key0 + crow(i, h)); const float v = S[i] * SC2 + bfar; S[i] = dist < WIN ? v : -INFINITY; }
                } else {
                    const float addc = act ? bfar : -INFINITY;
#pragma unroll
                    for (int i = 0; i < 16; ++i) S[i] = S[i] * SC2 + addc;
                }
                softmax_pv(S, l, O, vf);
            }
        }
        if (s < s_hi) { *(LAS v4u*)(Kb + (buf ^ 1) * 64 * KV_PITCH + srow * KV_PITCH + spc * 8) = kr; *(LAS v4u*)(Vb + (buf ^ 1) * 64 * KV_PITCH + srow * KV_PITCH + spc * 8) = vr; }
        __syncthreads();
        buf ^= 1;
    }
    l = xhalf_sum(l);
    const float sc = l > 0.f ? gate / l : 0.f;
#pragma unroll
    for (int dt = 0; dt < 2; ++dt)
#pragma unroll
        for (int i = 0; i < 16; ++i) outw[(dt * 32 + crow(i, h)) * 32 + kl] += O[dt][i] * sc;
}
DI void attn_prompt_unit(Frame& F, int b, int g, int c, int li) {
    const int w = F.wave, lane = F.lane, kl = lane & 31, h = lane >> 5, hq = kl & 3, tl = kl >> 2, hd = g * 4 + hq;
    LAS float* biasT = (LAS float*)(F.lds + RING_OFF + AT_BIAS); LAS float* scr = (LAS float*)(F.lds + RING_OFF + AT_SCR) + w * 8 * 33;
    fill_bias_table(F, biasT, g);
    const int t = 64 * c + 8 * w + tl, row = b * SEQ + t;
    bf16x8 qf[4];
#pragma unroll
    for (int ks = 0; ks < 4; ++ks) qf[ks] = *(const bf16x8*)(WSP(bf16, WS_QB) + (size_t)row * 512 + hd * 64 + 16 * ks + 8 * h);
    const float* gp = WSP(float, WS_GATE) + (size_t)row * 32 + hd * 3; const float g0 = gp[0], g1 = gp[1], g2 = gp[2];
    __syncthreads();
    unsigned sel;
    LAS float* outw = (LAS float*)(F.lds + RING_OFF + AT_OUT) + w * 2048;
    { f32x16 Oc[2];
      const int cu = 256 + b * 2 + g;
      cmp_branch(qf, WSP(bf16, WS_KC) + (size_t)cu * 8192, WSP(bf16, WS_VCT) + (size_t)cu * 8192, t, c, biasT, lane, scr, Oc, sel);
#pragma unroll
      for (int dt = 0; dt < 2; ++dt)
#pragma unroll
          for (int i = 0; i < 16; ++i) outw[(dt * 32 + crow(i, h)) * 32 + kl] = Oc[dt][i] * g0; }
    const size_t kvo = (size_t)(b * 2 + g) * SEQ * 64;
    prompt_branch<0>(F, WSP(bf16, WS_KS) + kvo, WSP(bf16, WS_VST) + kvo, 0, c, c, t, sel, qf, biasT, g1, outw);
    prompt_branch<1>(F, WSP(bf16, WS_KW) + kvo, WSP(bf16, WS_VWT) + kvo, c > 8 ? c - 8 : 0, c, c, t, sel, qf, biasT, g2, outw);
    bf16* mix = WSP(bf16, WS_MIX) + (size_t)row * DM + hd * 64;
#pragma unroll
    for (int dt = 0; dt < 2; ++dt)
#pragma unroll
        for (int a = 0; a < 4; ++a) { const LAS float* o4 = outw + (dt * 32 + 8 * a + 4 * h) * 32 + kl;
            v2u o; o.x = pk2(o4[0], o4[32]); o.y = pk2(o4[64], o4[96]); *(v2u*)(mix + dt * 32 + 8 * a + 4 * h) = o; }
}

constexpr int SA_BIAS = 0, SA_SCR = 2048, SA_ML = SA_SCR + 8 * 8 * 33 * 4, SA_OUT = SA_ML + 8 * 2 * 32 * 4, SA_RED = SA_OUT + 32 * 64 * 4, SA_END = SA_RED + 8 * 64 * 32 * 4;
struct SampTile { float v[2][2][8]; };
template <int MODE> DI const float* samp_tile_base(Frame& F, const int* pt, int b, int g, int li, int j, int ntile) {
    const bool fresh = (j == ntile - 1);
    if (MODE == 0) return fresh ? OUTF + O_SLCS + ((size_t)(b * 2 + li) * DT) * 256 + g * 64 : KIN(I_CSLC) + (((size_t)pt[j >> 2] * 2 + li) * PAGE + (j & 3) * 32) * 256 + g * 64;
    return fresh ? OUTF + O_WINS + ((size_t)(b * 2 + li) * WIN + (WIN - DT)) * 256 + g * 64 : KIN(I_CWIN) + ((size_t)(b * 2 + li) * WIN + 32 * j) * 256 + g * 64;
}
DI void samp_tile_load(SampTile& T, const float* base, int rmask, int kl, int h) {
#pragma unroll
    for (int st = 0; st < 2; ++st)
#pragma unroll
        for (int jj = 0; jj < 8; ++jj) { const int kr = (16 * st + 8 * (jj >> 2) + 4 * h + (jj & 3)) & rmask; const float* vp = base + (size_t)kr * 256 + 128 + kl; T.v[st][0][jj] = vp[0]; T.v[st][1][jj] = vp[32]; }
}
template <int MODE>
DI void sample_branch(Frame& F, int b, int g, int li, int t, unsigned sel, const bf16x8 (&qf)[4], const LAS float* biasT) {
    const int w = F.wave, lane = F.lane, kl = lane & 31, h = lane >> 5, hq = kl & 3;
    const int ntile = (MODE == 0) ? 65 : 17;
    f32x16 O[2]; float l = 0.f;
#pragma unroll
    for (int i = 0; i < 16; ++i) { O[0][i] = 0.f; O[1][i] = 0.f; }
    const int* pt = (const int*)KIN(I_PT) + b * NPAGE;
    SampTile T;
    samp_tile_load(T, samp_tile_base<MODE>(F, pt, b, g, li, w, ntile), (w == ntile - 1) ? 7 : 31, kl, h);
    for (int j = w; j < ntile; j += NWAVES) {
        const bool fresh = (j == ntile - 1);
        const int pos0 = fresh ? PAST : (MODE == 0 ? 32 * j : PAST - WIN + 32 * j);
        bf16x8 kf[4], vf[2][2];
        { const float* kp = samp_tile_base<MODE>(F, pt, b, g, li, j, ntile) + (size_t)(kl & (fresh ? 7 : 31)) * 256 + 8 * h;
#pragma unroll
          for (int ks = 0; ks < 4; ++ks) { const f32x4 x0 = *(const f32x4*)(kp + 16 * ks), x1 = *(const f32x4*)(kp + 16 * ks + 4); v4u av; av.x = pk2(x0.x, x0.y); av.y = pk2(x0.z, x0.w); av.z = pk2(x1.x, x1.y); av.w = pk2(x1.z, x1.w); kf[ks] = __builtin_bit_cast(bf16x8, av); } }
#pragma unroll
        for (int st = 0; st < 2; ++st)
#pragma unroll
            for (int dt = 0; dt < 2; ++dt) { v4u av; av.x = pk2(T.v[st][dt][0], T.v[st][dt][1]); av.y = pk2(T.v[st][dt][2], T.v[st][dt][3]); av.z = pk2(T.v[st][dt][4], T.v[st][dt][5]); av.w = pk2(T.v[st][dt][6], T.v[st][dt][7]); vf[dt][st] = __builtin_bit_cast(bf16x8, av); }
        if (j + NWAVES < ntile) samp_tile_load(T, samp_tile_base<MODE>(F, pt, b, g, li, j + NWAVES, ntile), (j + NWAVES == ntile - 1) ? 7 : 31, kl, h);
        f32x16 S;
#pragma unroll
        for (int i = 0; i < 16; ++i) S[i] = 0.f;
#pragma unroll
        for (int ks = 0; ks < 4; ++ks) S = MFMA32(kf[ks], qf[ks], S);
        { float bv[16];
#pragma unroll
          for (int i = 0; i < 16; ++i) { const int dist = t - (pos0 + crow(i, h)); const int idx = dist < 0 ? 0 : (dist > 127 ? 127 : dist); bv[i] = biasT[hq * 128 + idx]; }
          const bool blk_ok = (MODE == 1) || fresh || (((sel >> ((j >> 1) & 31)) & 1u) != 0u);
#pragma unroll
          for (int i = 0; i < 16; ++i) { const int ko = crow(i, h); const int dist = t - (pos0 + ko);
            const bool ok = blk_ok && dist >= 0 && (!fresh || ko < DT) && (MODE == 0 || dist < WIN);
            const float v = S[i] * SC2 + (bv[i] - SREF); S[i] = ok ? v : -INFINITY; } }
        softmax_pv(S, l, O, vf);
    }
    l += __shfl_xor(l, 32);
    LAS float* ml = (LAS float*)(F.lds + RING_OFF + SA_ML); LAS float* red = (LAS float*)(F.lds + RING_OFF + SA_RED) + w * 2048;
    if (h == 0) { ml[(w * 2 + 0) * 32 + kl] = 0.f; ml[(w * 2 + 1) * 32 + kl] = l; }
#pragma unroll
    for (int dt = 0; dt < 2; ++dt)
#pragma unroll
        for (int i = 0; i < 16; ++i) red[(dt * 32 + crow(i, h)) * 32 + kl] = O[dt][i];
}
DI void sample_combine(Frame& F, int b, int g, int gi) {
    const LAS float* ml = (const LAS float*)(F.lds + RING_OFF + SA_ML); const LAS float* red = (const LAS float*)(F.lds + RING_OFF + SA_RED);
    LAS float* outF = (LAS float*)(F.lds + RING_OFF + SA_OUT);
    const int q = F.tid & 31, d0 = (F.tid >> 5) * 4;
    float M = NEG_BIG;
#pragma unroll
    for (int w = 0; w < 8; ++w) M = fmaxf(M, ml[(w * 2) * 32 + q]);
    float L = 0.f, o[4] = {0.f, 0.f, 0.f, 0.f};
#pragma unroll
    for (int w = 0; w < 8; ++w) { const float f = fexp2(ml[(w * 2) * 32 + q] - M); L += ml[(w * 2 + 1) * 32 + q] * f;
#pragma unroll
        for (int k = 0; k < 4; ++k) o[k] += red[w * 2048 + (d0 + k) * 32 + q] * f; }
    const int row = MP + b * DT + (q >> 2), hd = g * 4 + (q & 3);
    const float gate = WSP(float, WS_GATE)[(size_t)row * 32 + hd * 3 + gi];
    const float sc = L > 0.f ? gate / L : 0.f;
#pragma unroll
    for (int k = 0; k < 4; ++k) outF[q * 64 + d0 + k] += o[k] * sc;
}
DI void attn_sample_unit(Frame& F, int b, int g, int li) {
    const int w = F.wave, lane = F.lane, kl = lane & 31, h = lane >> 5, hq = kl & 3, tl = kl >> 2, hd = g * 4 + hq;
    LAS float* biasT = (LAS float*)(F.lds + RING_OFF + SA_BIAS); LAS float* scr = (LAS float*)(F.lds + RING_OFF + SA_SCR) + w * 8 * 33;
    LAS float* outF = (LAS float*)(F.lds + RING_OFF + SA_OUT);
    fill_bias_table(F, biasT, g);
    const int t = PAST + tl, row = MP + b * DT + tl;
    bf16x8 qf[4];
#pragma unroll
    for (int ks = 0; ks < 4; ++ks) qf[ks] = *(const bf16x8*)(WSP(bf16, WS_QB) + (size_t)row * 512 + hd * 64 + 16 * ks + 8 * h);
    __syncthreads();
    f32x16 Oc[2]; unsigned sel;
    const int cu = b * 2 + g;
    cmp_branch(qf, WSP(bf16, WS_KC) + (size_t)cu * 8192, WSP(bf16, WS_VCT) + (size_t)cu * 8192, t, 32, biasT, lane, scr, Oc, sel);
    if (w == 0) { const float g0 = WSP(float, WS_GATE)[(size_t)row * 32 + hd * 3];
#pragma unroll
        for (int dt = 0; dt < 2; ++dt)
#pragma unroll
            for (int i = 0; i < 16; ++i) outF[kl * 64 + dt * 32 + crow(i, h)] = Oc[dt][i] * g0; }
    sample_branch<0>(F, b, g, li, t, sel, qf, biasT);
    __syncthreads();
    sample_combine(F, b, g, 1);
    __syncthreads();
    sample_branch<1>(F, b, g, li, t, sel, qf, biasT);
    __syncthreads();
    sample_combine(F, b, g, 2);
    __syncthreads();
    { const int q = F.tid >> 4, d4 = (F.tid & 15) * 4; const LAS float* s = outF + q * 64 + d4;
      v2u o; o.x = pk2(s[0], s[1]); o.y = pk2(s[2], s[3]);
      *(v2u*)(WSP(bf16, WS_MIX) + (size_t)(MP + b * DT + (q >> 2)) * DM + (g * 4 + (q & 3)) * 64 + d4) = o; }
    __syncthreads();
}

constexpr int SCN_STEPS = 32, SCN_CH = SCN_STEPS * 384 * 4  , SCN_Y = 2 * SCN_CH, SCN_END = SCN_Y + 2 * SCN_STEPS * 32 * 4;
struct ScanOps { f32x4 w0, w1, k0, k1, b0, b1, m0, m1, r0, r1; float v; };
DI ScanOps scan_ld(const LAS float* ch, int st, int cj, int irow) { const LAS float* c = ch + st * 384 + cj * 8; ScanOps o;
    o.w0 = *(const LAS f32x4*)(c); o.w1 = *(const LAS f32x4*)(c + 4); o.k0 = *(const LAS f32x4*)(c + 64); o.k1 = *(const LAS f32x4*)(c + 68); o.b0 = *(const LAS f32x4*)(c + 128); o.b1 = *(const LAS f32x4*)(c + 132);
    o.m0 = *(const LAS f32x4*)(c + 192); o.m1 = *(const LAS f32x4*)(c + 196); o.r0 = *(const LAS f32x4*)(c + 256); o.r1 = *(const LAS f32x4*)(c + 260); o.v = ch[st * 384 + 320 + irow]; return o; }
DI float dot8(const f32x4 a0, const f32x4 a1, const f32x4 b0, const f32x4 b1) { const f32x4 p = a0 * b0 + a1 * b1; return (p.x + p.y) + (p.z + p.w); }
DI float scan_step(f32x4& s0, f32x4& s1, const ScanOps& o) {
    float sa = dot8(s0, s1, o.k0, o.k1);
    const f32x4 t0 = s0 * o.w0 + o.m0 * o.v, t1 = s1 * o.w1 + o.m1 * o.v;
    sa = sum8(sa);
    s0 = t0 - o.b0 * sa; s1 = t1 - o.b1 * sa;
    return sum8(dot8(s0, s1, o.r0, o.r1));
}
struct ScanRaw { f32x4 w; v2u b[5]; };
DI void scan_stage_load(const unsigned char* rec, int c4, ScanRaw& pre) { pre.w = *(const f32x4*)(rec + 16 * c4);
#pragma unroll
    for (int k = 0; k < 5; ++k) pre.b[k] = *(const v2u*)(rec + SCR_KK + 128 * k + 8 * c4); }
DI f32x4 unpk4(const v2u w) { return (f32x4){bflo(w.x), bfhi(w.x), bflo(w.y), bfhi(w.y)}; }
DI void scan_stage_store(LAS float* rec, int c4, const ScanRaw& pre, const f32x4 ka) { LAS float* p = rec + 4 * c4;
    const f32x4 kk = unpk4(pre.b[0]), a = unpk4(pre.b[1]), k = unpk4(pre.b[2]);
    *(LAS f32x4*)(p) = pre.w; *(LAS f32x4*)(p + 64) = kk; *(LAS f32x4*)(p + 128) = kk * a; *(LAS f32x4*)(p + 192) = k * ((a - 1.0f) * ka + 1.0f); *(LAS f32x4*)(p + 256) = unpk4(pre.b[3]); *(LAS f32x4*)(p + 320) = unpk4(pre.b[4]); }
typedef short bf16x4 __attribute__((ext_vector_type(4)));
#define MFMA16(a, b, c) __builtin_amdgcn_mfma_f32_16x16x16bf16_1k((a), (b), (c), 0, 0, 0)
DI bf16x4 pack4(const f32x4 v) { v2u r; r.x = pk2(v.x, v.y); r.y = pk2(v.z, v.w); return __builtin_bit_cast(bf16x4, r); }
constexpr int CK_L = 16, CK_NB = 5, CK_PA = 68  , CK_PS = 20  ;
constexpr int CKO_AL = 0, CKO_RH = CKO_AL + 16 * CK_PA * 2, CKO_BR = CKO_RH + 16 * CK_PA * 2, CKO_MR = CKO_BR + 16 * CK_PA * 2, CKO_NBC = CKO_MR + 16 * CK_PA * 2, CKO_MUC = CKO_NBC + 64 * CK_PS * 2,
              CKO_VTB = CKO_MUC + 64 * CK_PS * 2, CKO_QT = CKO_VTB + 64 * CK_PS * 2, CKO_NT = CKO_QT + 16 * CK_PS * 2, CKO_NT1 = CKO_NT + 16 * CK_PS * 2, CKO_T2T = CKO_NT1 + 16 * CK_PS * 2, CKO_GL = CKO_T2T + 16 * CK_PS * 2,
              CK_BUF = CKO_GL + 64 * 4, CK_PF = CK_NB * CK_BUF  , CK_END = CK_PF + 4 * 16 * 17 * 4;
static_assert(CK_BUF % 16 == 0 && CK_END <= RING_BYTES, "chunked scan LDS map");
DI void scan_prompt_unit(Frame& F, int b, int h, int li) {
    const int w = F.wave, lane = F.lane, l15 = lane & 15, g4 = (lane >> 4) * 4;
    LAS unsigned char* lds = F.lds + RING_OFF;
    constexpr int NCH = SEQ / CK_L;
    float* YR = WSP(float, WS_YRAW);
    f32x4 T[4];
#pragma unroll
    for (int c = 0; c < 4; ++c) T[c] = (f32x4){0.f, 0.f, 0.f, 0.f};
    float hw_w[16]; unsigned hw_ka[16], hw_kr[16], hw_v[8];
    const int hw = w - 4;
    const float kaj = (w >= 4) ? KIN(I_KA)[li * 512 + h * 64 + lane] : 0.f;
    for (int k = 0; k < NCH + 4; ++k) {
        if (w < 4) {
            const int c0 = k - 4;
            if (c0 >= 0) {
                const LAS unsigned char* cb = lds + (c0 % CK_NB) * CK_BUF; const int row0 = b * SEQ + c0 * CK_L;
                bf16x4 tb[4];
#pragma unroll
                for (int c = 0; c < 4; ++c) tb[c] = pack4(T[c]);
                f32x4 a1 = (f32x4){0.f, 0.f, 0.f, 0.f}, a2 = a1;
#pragma unroll
                for (int c = 0; c < 4; ++c) { const bf16x4 fa = *(const LAS bf16x4*)(cb + CKO_AL + (l15 * CK_PA + 16 * c + g4) * 2), fr = *(const LAS bf16x4*)(cb + CKO_RH + (l15 * CK_PA + 16 * c + g4) * 2);
                    a1 = MFMA16(fa, tb[c], a1); a2 = MFMA16(fr, tb[c], a2); }
                const bf16x4 vt = *(const LAS bf16x4*)(cb + CKO_VTB + ((16 * w + l15) * CK_PS + g4) * 2);
                a1 = MFMA16(*(const LAS bf16x4*)(cb + CKO_QT + (l15 * CK_PS + g4) * 2), vt, a1);
                const f32x4 z4 = (f32x4){0.f, 0.f, 0.f, 0.f};
                const f32x4 U = MFMA16(*(const LAS bf16x4*)(cb + CKO_NT + (l15 * CK_PS + g4) * 2), pack4(a1), z4);
                const bf16x4 ub = pack4(U);
                a2 = MFMA16(*(const LAS bf16x4*)(cb + CKO_NT1 + (l15 * CK_PS + g4) * 2), ub, a2);
                a2 = MFMA16(*(const LAS bf16x4*)(cb + CKO_T2T + (l15 * CK_PS + g4) * 2), vt, a2);
                float* yp = YR + (size_t)(row0 + g4) * 512 + h * 64 + 16 * w + l15;
                yp[0] = a2.x; yp[512] = a2.y; yp[1024] = a2.z; yp[1536] = a2.w;
#pragma unroll
                for (int c = 0; c < 4; ++c) { T[c] = MFMA16(*(const LAS bf16x4*)(cb + CKO_NBC + ((16 * c + l15) * CK_PS + g4) * 2), ub, T[c]);
                    T[c] = MFMA16(*(const LAS bf16x4*)(cb + CKO_MUC + ((16 * c + l15) * CK_PS + g4) * 2), vt, T[c]);
                    T[c] = T[c] * *(const LAS f32x4*)(cb + CKO_GL + (16 * c + g4) * 4); }
            }
        } else {
            const int ph = (k - hw) & 3, c1 = k - ph;
            if (k >= hw && c1 < NCH) {
                LAS unsigned char* cb = lds + (c1 % CK_NB) * CK_BUF; const int row0 = b * SEQ + c1 * CK_L;
                LAS float* PF = (LAS float*)(lds + CK_PF) + hw * (16 * 17);
                if (ph == 0) {
#pragma unroll
                    for (int t = 0; t < 16; ++t) { const unsigned char* rec = SCREC(row0 + t, h);
                        hw_w[t] = *(const float*)(rec + 4 * lane); hw_ka[t] = (unsigned)*(const bf16*)(rec + SCR_KK + 2 * lane) | ((unsigned)*(const bf16*)(rec + SCR_A + 2 * lane) << 16);
                        hw_kr[t] = (unsigned)*(const bf16*)(rec + SCR_K + 2 * lane) | ((unsigned)*(const bf16*)(rec + SCR_R + 2 * lane) << 16);
                        const unsigned vv = *(const bf16*)(rec + SCR_V + 2 * lane); if (t & 1) hw_v[t >> 1] |= vv << 16; else hw_v[t >> 1] = vv; }
                } else if (ph == 1) {
                    float gm = 1.0f;
#pragma unroll
                    for (int t = 0; t < 16; ++t) {
                        const float kap = bflo(hw_ka[t]), av = bfhi(hw_ka[t]);
                        const float al = kap * gm; gm *= hw_w[t]; const float ig = __builtin_amdgcn_rcpf(gm);
                        const float be = kap * av * ig, mu = bflo(hw_kr[t]) * ((av - 1.0f) * kaj + 1.0f) * ig, rh = bfhi(hw_kr[t]) * gm;
                        const bf16 beb = (bf16)(pk2(be, 0.f) & 0xffffu), mub = (bf16)(pk2(mu, 0.f) & 0xffffu);
                        *(LAS bf16*)(cb + CKO_AL + (t * CK_PA + lane) * 2) = (bf16)(pk2(al, 0.f) & 0xffffu); *(LAS bf16*)(cb + CKO_RH + (t * CK_PA + lane) * 2) = (bf16)(pk2(rh, 0.f) & 0xffffu);
                        *(LAS bf16*)(cb + CKO_BR + (t * CK_PA + lane) * 2) = beb; *(LAS bf16*)(cb + CKO_MR + (t * CK_PA + lane) * 2) = mub;
                        *(LAS bf16*)(cb + CKO_NBC + (lane * CK_PS + t) * 2) = (bf16)(beb ^ 0x8000u); *(LAS bf16*)(cb + CKO_MUC + (lane * CK_PS + t) * 2) = mub;
                        if (t & 1) *(LAS unsigned*)(cb + CKO_VTB + (lane * CK_PS + t - 1) * 2) = hw_v[t >> 1]; }
                    *(LAS float*)(cb + CKO_GL + lane * 4) = gm;
                } else if (ph == 2) {
                    f32x4 gp = (f32x4){0.f, 0.f, 0.f, 0.f}, gq = gp, g1 = gp, g2 = gp;
#pragma unroll
                    for (int ks = 0; ks < 4; ++ks) { const int o = (l15 * CK_PA + 16 * ks + g4) * 2;
                        const bf16x4 fb = *(const LAS bf16x4*)(cb + CKO_BR + o), fm = *(const LAS bf16x4*)(cb + CKO_MR + o), fa = *(const LAS bf16x4*)(cb + CKO_AL + o), fr = *(const LAS bf16x4*)(cb + CKO_RH + o);
                        gp = MFMA16(fb, fa, gp); gq = MFMA16(fm, fa, gq); g1 = MFMA16(fb, fr, g1); g2 = MFMA16(fm, fr, g2); }
                    f32x4 q4, n1, t2;
#pragma unroll
                    for (int e = 0; e < 4; ++e) { const int tau = g4 + e; PF[tau * 17 + l15] = tau < l15 ? gp[e] : 0.f; q4[e] = tau < l15 ? gq[e] : 0.f; n1[e] = tau <= l15 ? -g1[e] : 0.f; t2[e] = tau <= l15 ? g2[e] : 0.f; }
                    *(LAS bf16x4*)(cb + CKO_QT + (l15 * CK_PS + g4) * 2) = pack4(q4); *(LAS bf16x4*)(cb + CKO_NT1 + (l15 * CK_PS + g4) * 2) = pack4(n1); *(LAS bf16x4*)(cb + CKO_T2T + (l15 * CK_PS + g4) * 2) = pack4(t2);
                } else {
                    if (lane < 16) { float n[16];
#pragma unroll
                        for (int t = 0; t < 16; ++t) { float acc = (lane == t) ? 1.0f : 0.f;
#pragma unroll
                            for (int tau = 0; tau < 16; ++tau) if (tau < t) acc -= n[tau] * PF[tau * 17 + t];
                            n[t] = acc; }
#pragma unroll
                        for (int tp = 0; tp < 16; ++tp) *(LAS bf16*)(cb + CKO_NT + (tp * CK_PS + lane) * 2) = (bf16)(pk2(n[tp], 0.f) & 0xffffu); }
                }
            }
        }
        __syncthreads();
    }
    if (w < 4) {
        float* so = OUTF + O_WKVP + ((size_t)((b * 2 + li) * 8 + h) * 64 + 16 * w + l15) * 64;
#pragma unroll
        for (int c = 0; c < 4; ++c) *(f32x4*)(so + 16 * c + g4) = T[c]; }
}
DI void scan_post_phase(Frame& F, int li) {
    const float* YR = WSP(float, WS_YRAW);
    const int i0 = (F.tid & 15) * 4;
    for (int it0 = F.bid * (NTHREADS / 16) + (F.tid >> 4); it0 < MP * 8; it0 += 2 * F.G * (NTHREADS / 16)) {
        f32x4 y[2], r[2], kraw[2], av[2], v[2], gg[2];
#pragma unroll
        for (int q = 0; q < 2; ++q) { const int it = it0 + q * F.G * (NTHREADS / 16), row = it >> 3, h = it & 7; const unsigned char* c = SCREC(row, h) + i0 * 2;
            y[q] = *(const f32x4*)(YR + (size_t)row * 512 + h * 64 + i0); r[q] = unpk4(*(const v2u*)(c + SCR_R)); kraw[q] = unpk4(*(const v2u*)(c + SCR_K)); av[q] = unpk4(*(const v2u*)(c + SCR_A)); v[q] = unpk4(*(const v2u*)(c + SCR_V));
            gg[q] = *(const f32x4*)(WSP(float, WS_G) + (size_t)row * 512 + h * 64 + i0); }
#pragma unroll
        for (int q = 0; q < 2; ++q) { const int it = it0 + q * F.G * (NTHREADS / 16), row = it >> 3, h = it & 7;
            const float mu = sum16((y[q].x + y[q].y) + (y[q].z + y[q].w)) * (1.f / 64.f);
            const f32x4 dv = y[q] - mu;
            const float var = sum16((dv.x * dv.x + dv.y * dv.y) + (dv.z * dv.z + dv.w * dv.w)) * (1.f / 64.f);
            const float rs = __builtin_amdgcn_rsqf(var + GN_EPS);
            const f32x4 km = kraw[q] * ((av[q] - 1.0f) * *(const f32x4*)(KIN(I_KA) + (size_t)li * 512 + h * 64 + i0) + 1.0f);
            const f32x4 rk = *(const f32x4*)(KIN(I_RK) + (size_t)(li * 8 + h) * 64 + i0);
            const float bon = sum16((r[q].x * km.x * rk.x + r[q].y * km.y * rk.y) + (r[q].z * km.z * rk.z + r[q].w * km.w * rk.w));
            const f32x4 lw = *(const f32x4*)(KIN(I_LNW) + (size_t)li * 512 + h * 64 + i0), lb = *(const f32x4*)(KIN(I_LNB) + (size_t)li * 512 + h * 64 + i0);
            const f32x4 o = (dv * rs * lw + lb + v[q] * bon) * gg[q];
            v2u pk; pk.x = pk2(o.x, o.y); pk.y = pk2(o.z, o.w);
            *(v2u*)(WSP(bf16, WS_MIX) + (size_t)row * DM + 512 + h * 64 + i0) = pk; }
    }
}
DI void scan_sample_unit(Frame& F, int b, int li) {
    const int h = F.wave, lane = F.lane;
    LAS float* ch = (LAS float*)(F.lds + RING_OFF) + h * (DT * 384);
    LAS float* yb = (LAS float*)(F.lds + RING_OFF + 8 * DT * 384 * 4) + h * (DT * 64);
#pragma unroll
    for (int k = 0; k < 2; ++k) { const int it = lane + 64 * k, tk = it >> 4, c4 = it & 15; ScanRaw pre;
        scan_stage_load(SCREC(MP + b * DT + tk, h), c4, pre);
        scan_stage_store(ch + tk * 384, c4, pre, *(const f32x4*)(KIN(I_KA) + (size_t)li * 512 + h * 64 + 4 * c4)); }
    float s[64];
    const float* s0 = KIN(I_SWKV) + ((size_t)((b * 2 + li) * 8 + h) * 64 + lane) * 64;
#pragma unroll
    for (int j = 0; j < 16; ++j) { const f32x4 x = ((const f32x4*)s0)[j]; s[4 * j] = x.x; s[4 * j + 1] = x.y; s[4 * j + 2] = x.z; s[4 * j + 3] = x.w; }
    LDS_WAIT(); asm volatile("" ::: "memory");
    for (int st = 0; st < DT; ++st) {
        const LAS float* c = ch + st * 384;
        float sa = 0.f;
#pragma unroll
        for (int j = 0; j < 64; ++j) sa += s[j] * c[64 + j];
        sa = -sa;
        const float v = c[320 + lane];
        float y = 0.f;
#pragma unroll
        for (int j = 0; j < 64; ++j) { s[j] = s[j] * c[j] + sa * c[128 + j] + v * c[192 + j]; y += s[j] * c[256 + j]; }
        yb[st * 64 + lane] = y;
    }
    float* so = OUTF + O_WKVS + ((size_t)((b * 2 + li) * 8 + h) * 64 + lane) * 64;
#pragma unroll
    for (int j = 0; j < 16; ++j) ((f32x4*)so)[j] = (f32x4){s[4 * j], s[4 * j + 1], s[4 * j + 2], s[4 * j + 3]};
    LDS_WAIT(); asm volatile("" ::: "memory");
#pragma unroll
    for (int ps = 0; ps < 2; ++ps) {
        const int tok = ps * 4 + (lane >> 4), i0 = (lane & 15) * 4;
        const LAS float* c = ch + tok * 384;
        const f32x4 y = *(const LAS f32x4*)(yb + tok * 64 + i0);
        const float mu = sum16((y.x + y.y) + (y.z + y.w)) * (1.f / 64.f);
        const f32x4 dv = y - mu;
        const float var = sum16((dv.x * dv.x + dv.y * dv.y) + (dv.z * dv.z + dv.w * dv.w)) * (1.f / 64.f);
        const float rs = 1.0f / sqrtf(var + GN_EPS);
        const f32x4 r = *(const LAS f32x4*)(c + 4 * 64 + i0), km = *(const LAS f32x4*)(c + 3 * 64 + i0), v = *(const LAS f32x4*)(c + 5 * 64 + i0);
        const f32x4 rk = *(const f32x4*)(KIN(I_RK) + (size_t)(li * 8 + h) * 64 + i0);
        const float bon = sum16((r.x * km.x * rk.x + r.y * km.y * rk.y) + (r.z * km.z * rk.z + r.w * km.w * rk.w));
        const f32x4 lw = *(const f32x4*)(KIN(I_LNW) + (size_t)li * 512 + h * 64 + i0), lb = *(const f32x4*)(KIN(I_LNB) + (size_t)li * 512 + h * 64 + i0);
        const int row = MP + b * DT + tok;
        const f32x4 gg = *(const f32x4*)(WSP(float, WS_G) + (size_t)row * 512 + h * 64 + i0);
        const f32x4 o = (dv * rs * lw + lb + v * bon) * gg;
        v2u pk; pk.x = pk2(o.x, o.y); pk.y = pk2(o.z, o.w);
        *(v2u*)(WSP(bf16, WS_MIX) + (size_t)row * DM + 512 + h * 64 + i0) = pk;
    }
    __syncthreads();
}

extern __shared__ __attribute__((aligned(16))) unsigned char g_lds[];
DI int take_ticket(Frame& F, int word) {
    volatile LAS unsigned* tk = F.MISC + 16;
    __syncthreads();
    if (F.tid == 0) tk[0] = __hip_atomic_fetch_add((unsigned*)(F.ctl + word), 1u, RLX_AGENT);
    __syncthreads();
    return __builtin_amdgcn_readfirstlane((int)tk[0]);
}

struct EpiStoreBf16 { static constexpr int PID = 16;
    static constexpr bool PERM = true, AFTER_DRAIN = false;
    bf16* O; int ldc;
    DI void operator()(const f32x4 (&acc)[2][2][4][2], const pg8::Unit& u, int wr, int wc, int fr, int fq) const {
        const int row0 = u.pm * 256 + wr * 64 + fr, col0 = u.pn * 256 + wc * 32 + 8 * fq;
#pragma unroll
        for (int ai = 0; ai < 2; ++ai)
#pragma unroll
            for (int m = 0; m < 4; ++m) { bf16* rowp = O + (size_t)(row0 + ai * 128 + m * 16) * ldc + col0;
#pragma unroll
                for (int bj = 0; bj < 2; ++bj) { const f32x4 v0 = acc[ai][bj][m][0], v1 = acc[ai][bj][m][1];
                    v4u w; w.x = pk2(v0[0], v0[1]); w.y = pk2(v0[2], v0[3]); w.z = pk2(v1[0], v1[1]); w.w = pk2(v1[2], v1[3]);
                    *(v4u*)(rowp + bj * 128) = w; } }
    }
};
struct EpiPart { static constexpr int PID = 20;
    static constexpr bool PERM = false, AFTER_DRAIN = false;
    float* C;
    DI void operator()(const f32x4 (&acc)[2][2][4][2], const pg8::Unit& u, int wr, int wc, int fr, int fq) const {
        const int row0 = u.pm * 256 + wr * 64 + fr, col0 = wc * 32 + 4 * fq;
#pragma unroll
        for (int ai = 0; ai < 2; ++ai)
#pragma unroll
            for (int m = 0; m < 4; ++m) { float* rowp = C + (size_t)(row0 + ai * 128 + m * 16) * 256 + col0;
#pragma unroll
                for (int bj = 0; bj < 2; ++bj)
#pragma unroll
                    for (int n = 0; n < 2; ++n) *(f32x4*)(rowp + bj * 128 + n * 16) = acc[ai][bj][m][n]; }
    }
};
struct EpiResid { static constexpr int PID = 18;
    static constexpr bool PERM = false, AFTER_DRAIN = false;
    const float* baseF;
    bf16* XB; float* Xout;
    unsigned long long* ssq;
    DI void operator()(const f32x4 (&acc)[2][2][4][2], const pg8::Unit& u, int wr, int wc, int fr, int fq) const {
        const int row0 = u.pm * 256 + wr * 64 + fr, col0 = u.pn * 256 + wc * 32 + 4 * fq;
        if (baseF) {
#pragma unroll
            for (int ai = 0; ai < 2; ++ai)
#pragma unroll
                for (int m = 0; m < 4; ++m) { const int row = row0 + ai * 128 + m * 16; const size_t off = (size_t)row * DM + col0; float sq = 0.f;
#pragma unroll
                    for (int bj = 0; bj < 2; ++bj)
#pragma unroll
                        for (int n = 0; n < 2; ++n) { const size_t o2 = off + bj * 128 + n * 16; const f32x4 x = *(const f32x4*)(baseF + o2) + acc[ai][bj][m][n];
                            v2u o; o.x = pk2(x[0], x[1]); o.y = pk2(x[2], x[3]); *(v2u*)(XB + o2) = o; sq += (x[0] * x[0] + x[1] * x[1]) + (x[2] * x[2] + x[3] * x[3]); }
                    sq += __shfl_xor(sq, 16); sq += __shfl_xor(sq, 32); if (fq == 0) __hip_atomic_fetch_add(ssq + row, (unsigned long long)(sq * SSQ_SCALE + 0.5f), RLX_AGENT);
                    if (m & 1) asm volatile("" ::: "memory"); }
            return;
        }
        v2u bw[2][4][2][2];
#pragma unroll
        for (int ai = 0; ai < 2; ++ai)
#pragma unroll
            for (int m = 0; m < 4; ++m)
#pragma unroll
                for (int bj = 0; bj < 2; ++bj)
#pragma unroll
                    for (int n = 0; n < 2; ++n) bw[ai][m][bj][n] = *(const v2u*)(XB + (size_t)(row0 + ai * 128 + m * 16) * DM + col0 + bj * 128 + n * 16);
#pragma unroll
        for (int ai = 0; ai < 2; ++ai)
#pragma unroll
            for (int m = 0; m < 4; ++m) { const int row = row0 + ai * 128 + m * 16; const size_t off = (size_t)row * DM + col0; float sq = 0.f;
#pragma unroll
                for (int bj = 0; bj < 2; ++bj)
#pragma unroll
                    for (int n = 0; n < 2; ++n) { const size_t o2 = off + bj * 128 + n * 16; const v2u wv = bw[ai][m][bj][n];
                        const f32x4 x = (f32x4){bflo(wv.x), bfhi(wv.x), bflo(wv.y), bfhi(wv.y)} + acc[ai][bj][m][n];
                        if (Xout) *(f32x4*)(Xout + o2) = x;
                        else { v2u o; o.x = pk2(x[0], x[1]); o.y = pk2(x[2], x[3]); *(v2u*)(XB + o2) = o; sq += (x[0] * x[0] + x[1] * x[1]) + (x[2] * x[2] + x[3] * x[3]); } }
                if (!Xout) { sq += __shfl_xor(sq, 16); sq += __shfl_xor(sq, 32); if (fq == 0) __hip_atomic_fetch_add(ssq + row, (unsigned long long)(sq * SSQ_SCALE + 0.5f), RLX_AGENT); } }
    }
};
struct EpiLora { static constexpr int PID = 19;
    static constexpr bool PERM = false, AFTER_DRAIN = false;
    unsigned char* SC; float* G; const float *w0, *a0;
    DI void operator()(const f32x4 (&acc)[2][2][4][2], const pg8::Unit& u, int wr, int wc, int fr, int fq) const {
        const int row0 = u.pm * 256 + wr * 64 + fr, seg = u.pn >> 1, cb = (u.pn & 1) * 256 + wc * 32 + 4 * fq;
#pragma unroll
        for (int bj = 0; bj < 2; ++bj)
#pragma unroll
            for (int n = 0; n < 2; ++n) {
                const int colh = cb + bj * 128 + n * 16, h = colh >> 6, d = colh & 63;
                f32x4 c0 = (f32x4){0.f, 0.f, 0.f, 0.f};
                if (seg == 0) c0 = *(const f32x4*)(w0 + colh); else if (seg == 1) c0 = *(const f32x4*)(a0 + colh);
#pragma unroll
                for (int ai = 0; ai < 2; ++ai)
#pragma unroll
                    for (int m = 0; m < 4; ++m) { const int row = row0 + ai * 128 + m * 16; const f32x4 a = acc[ai][bj][m][n];
                        unsigned char* scb = SC + ((size_t)row * 8 + h) * SCR_BYTES;
                        if (seg == 0) { f32x4 o;
#pragma unroll
                            for (int i = 0; i < 4; ++i) { const float y = -(c0[i] + a[i]); const float sp = fmaxf(y, 0.f) + __logf(1.0f + __expf(-fabsf(y))); o[i] = __expf(-__expf(-sp - 0.5f)); }
                            *(f32x4*)(scb + d * 4) = o; }
                        else if (seg == 1) { f32x4 o;
#pragma unroll
                            for (int i = 0; i < 4; ++i) o[i] = sigmoidf_(c0[i] + a[i]);
                            v2u ob; ob.x = pk2(o[0], o[1]); ob.y = pk2(o[2], o[3]); *(v2u*)(scb + SCR_A + d * 2) = ob; }
                        else *(f32x4*)(G + (size_t)row * 512 + colh) = a;
                    }
            }
    }
};
template <int CTRL> DI f32x4 dpp4(const f32x4 v) { return (f32x4){dppf<CTRL>(v.x), dppf<CTRL>(v.y), dppf<CTRL>(v.z), dppf<CTRL>(v.w)}; }
template <int CTRL> DI float dppf_old(float old, float x) { return __builtin_bit_cast(float, __builtin_amdgcn_update_dpp(__builtin_bit_cast(int, old), __builtin_bit_cast(int, x), CTRL, 0xf, 0xf, false)); }
template <int CTRL> DI f32x4 dpp4_old(const f32x4 o, const f32x4 v) { return (f32x4){dppf_old<CTRL>(o.x, v.x), dppf_old<CTRL>(o.y, v.y), dppf_old<CTRL>(o.z, v.z), dppf_old<CTRL>(o.w, v.w)}; }
DI f32x4 silu4_mul(const f32x4 y, const f32x4 u) { return (f32x4){y.x * sigmoidf_(y.x) * u.x, y.y * sigmoidf_(y.y) * u.y, y.z * sigmoidf_(y.z) * u.z, y.w * sigmoidf_(y.w) * u.w}; }
struct EpiFfnAct { static constexpr int PID = 17;
    static constexpr bool PERM = false, AFTER_DRAIN = false;
    bf16* H; float* HALO; const float* cw  ; const unsigned long long* ssq; const float* state  ; float* outP; float* outS; int l;
    DI void operator()(const f32x4 (&acc)[2][2][4][2], const pg8::Unit& u, int wr, int wc, int fr, int fq) const {
        const bool samp = u.pm >= MP / 256;
        float rinv[2][4];
#pragma unroll
        for (int ai = 0; ai < 2; ++ai)
#pragma unroll
            for (int m = 0; m < 4; ++m) rinv[ai][m] = rinv_of(ssq, u.pm * 256 + ai * 128 + wr * 64 + m * 16 + fr);
#pragma unroll
        for (int n = 0; n < 2; ++n) {
            const int ch = u.pn * 128 + wc * 32 + 16 * n + 4 * fq;
            const f32x4 w0 = *(const f32x4*)(cw + ch), w1 = *(const f32x4*)(cw + DFF + ch), w2 = *(const f32x4*)(cw + 2 * DFF + ch);
#pragma unroll
            for (int ai = 0; ai < 2; ++ai) {
                f32x4 pa = (f32x4){0.f, 0.f, 0.f, 0.f};
#pragma unroll
                for (int m = 0; m < 4; ++m) {
                    const int row = u.pm * 256 + ai * 128 + wr * 64 + m * 16 + fr;
                    const float rin = rinv[ai][m];
                    const f32x4 a = acc[ai][0][m][n] * rin, uu = acc[ai][1][m][n] * rin;
                    const f32x4 r1 = dpp4<0x121>(pa), r2 = dpp4<0x122>(pa);
                    f32x4 a1 = dpp4_old<0x111>(r1, a), a2 = dpp4_old<0x112>(r2, a);
                    if (samp) { const int t = fr & 7, b = (row - MP) >> 3;
                        if (t < 2) { const float* st = state + (size_t)b * (4 * 2 * DFF) + ch; const f32x4 st0 = *(const f32x4*)st, st1 = *(const f32x4*)(st + DFF);
                            if (t == 0) { a1 = st1; a2 = st0; } else a2 = st1; }
                        if (t >= 6) *(f32x4*)(outS + ((size_t)(b * 4 + l) * 2 + (t - 6)) * DFF + ch) = a;
                    } else {
                        const int blk = row >> 6;
                        if (m == 3) { if (fr >= 14) { *(f32x4*)(HALO + ((size_t)blk * 6 + (fr - 14)) * DFF + ch) = a;
                            if ((row & (SEQ - 1)) >= SEQ - 2) *(f32x4*)(outP + ((size_t)((row >> 11) * 4 + l) * 2 + ((row & (SEQ - 1)) - (SEQ - 2))) * DFF + ch) = a; } }
                        if (m == 0) { if (fr < 2) { *(f32x4*)(HALO + ((size_t)blk * 6 + 2 + fr) * DFF + ch) = a; *(f32x4*)(HALO + ((size_t)blk * 6 + 4 + fr) * DFF + ch) = uu; } }
                    }
                    const f32x4 y = w0 * a2 + w1 * a1 + w2 * a;
                    const f32x4 hv = silu4_mul(y, uu);
                    v2u o; o.x = pk2(hv.x, hv.y); o.y = pk2(hv.z, hv.w);
                    *(v2u*)(H + (size_t)row * DFF + ch) = o;
                    pa = a;
                }
            }
        }
    }
};
DI void ffn_fix_panel(Frame& F, int l, int pm) {
    const float* HALO = WSP(float, WS_HALO); const float* cw = KIN(I_FCONV) + (size_t)l * 3 * DFF; bf16* H = WSP(bf16, WS_H);
    constexpr int NC4 = DFF / 4;
    for (int it = F.tid; it < 4 * 2 * NC4; it += NTHREADS) {
        const int ch = (it % NC4) * 4, bj = it / NC4, blk = pm * 4 + (bj >> 1), j = bj & 1; const bool s0 = (blk & 31) == 0;
        const f32x4 z = (f32x4){0.f, 0.f, 0.f, 0.f};
        const f32x4 a = *(const f32x4*)(HALO + ((size_t)blk * 6 + 2 + j) * DFF + ch), uu = *(const f32x4*)(HALO + ((size_t)blk * 6 + 4 + j) * DFF + ch);
        f32x4 a1, a2;
        if (j == 1) { a1 = *(const f32x4*)(HALO + ((size_t)blk * 6 + 2) * DFF + ch); a2 = s0 ? z : *(const f32x4*)(HALO + ((size_t)(blk - 1) * 6 + 1) * DFF + ch); }
        else { a1 = s0 ? z : *(const f32x4*)(HALO + ((size_t)(blk - 1) * 6 + 1) * DFF + ch); a2 = s0 ? z : *(const f32x4*)(HALO + ((size_t)(blk - 1) * 6 + 0) * DFF + ch); }
        const f32x4 w0 = *(const f32x4*)(cw + ch), w1 = *(const f32x4*)(cw + DFF + ch), w2 = *(const f32x4*)(cw + 2 * DFF + ch);
        const f32x4 hv = silu4_mul(w0 * a2 + w1 * a1 + w2 * a, uu);
        v2u o; o.x = pk2(hv.x, hv.y); o.y = pk2(hv.z, hv.w);
        *(v2u*)(H + (size_t)(blk * 64 + j) * DFF + ch) = o;
    }
    asm volatile("s_waitcnt vmcnt(0)" ::: "memory"); __syncthreads();
    if (F.tid == 0) { __builtin_amdgcn_fence(__ATOMIC_ACQUIRE, "agent"); asm volatile("s_waitcnt vmcnt(0)" ::: "memory"); }
    __syncthreads();
}
template <int K> DI void gemm64_sample_phase(Frame& F, const bf16* A  , const bf16* Bt  , const float* baseF  , bf16* XB, float* Xout  , unsigned long long* ssq) {
    static_assert(K % 128 == 0, "K split over 8 waves in 16-wide steps");
    constexpr int KW = K / 8, NS = KW / 16;
    const int w = F.wave, lane = F.lane, kl = lane & 31, h = lane >> 5;
    LAS float* part = (LAS float*)(F.lds + RING_OFF);
    for (int tile = F.bid; tile < 256; tile += F.G) {
        const int x = tile & 7, r = tile >> 3, tm = 4 * (x & 3) + (r & 3), tn = 8 * (x >> 2) + (r >> 2);
        const bf16* ap = A + (size_t)(tm * 64 + kl) * K + w * KW + 8 * h; const bf16* bp = Bt + (size_t)(tn * 64 + kl) * K + w * KW + 8 * h;
        f32x16 acc[2][2];
#pragma unroll
        for (int i = 0; i < 16; ++i) { acc[0][0][i] = 0.f; acc[0][1][i] = 0.f; acc[1][0][i] = 0.f; acc[1][1][i] = 0.f; }
#pragma unroll 8
        for (int s = 0; s < NS; ++s) {
            const bf16x8 a0 = *(const bf16x8*)(ap + 16 * s), a1 = *(const bf16x8*)(ap + (size_t)32 * K + 16 * s);
            const bf16x8 b0 = *(const bf16x8*)(bp + 16 * s), b1 = *(const bf16x8*)(bp + (size_t)32 * K + 16 * s);
            acc[0][0] = MFMA32(a0, b0, acc[0][0]); acc[0][1] = MFMA32(a0, b1, acc[0][1]); acc[1][0] = MFMA32(a1, b0, acc[1][0]); acc[1][1] = MFMA32(a1, b1, acc[1][1]);
        }
        __syncthreads();
#pragma unroll
        for (int rb = 0; rb < 2; ++rb)
#pragma unroll
            for (int cb = 0; cb < 2; ++cb)
#pragma unroll
                for (int i = 0; i < 16; ++i) part[w * 4096 + (rb * 32 + crow(i, h)) * 64 + cb * 32 + kl] = acc[rb][cb][i];
        __syncthreads();
        { const int r = F.tid >> 3, c0 = (F.tid & 7) * 8; float o[8];
#pragma unroll
          for (int j = 0; j < 8; ++j) o[j] = 0.f;
#pragma unroll
          for (int ww = 0; ww < 8; ++ww) { const f32x4 p0 = *(const LAS f32x4*)(part + ww * 4096 + r * 64 + c0), p1 = *(const LAS f32x4*)(part + ww * 4096 + r * 64 + c0 + 4);
              o[0] += p0.x; o[1] += p0.y; o[2] += p0.z; o[3] += p0.w; o[4] += p1.x; o[5] += p1.y; o[6] += p1.z; o[7] += p1.w; }
          const int row = tm * 64 + r; const size_t off = (size_t)row * DM + tn * 64 + c0;
          float bsv[8]; if (baseF) ld8f(baseF + off, bsv); else ld8bf(XB + off, bsv); float sq = 0.f;
#pragma unroll
          for (int j = 0; j < 8; ++j) { o[j] += bsv[j]; sq += o[j] * o[j]; }
          if (Xout) store8f(Xout + off, o);
          else { v4u pk; pk.x = pk2(o[0], o[1]); pk.y = pk2(o[2], o[3]); pk.z = pk2(o[4], o[5]); pk.w = pk2(o[6], o[7]); *(v4u*)(XB + off) = pk;
              sq = sum8(sq); if ((F.tid & 7) == 0) __hip_atomic_fetch_add(ssq + row, (unsigned long long)(sq * SSQ_SCALE + 0.5f), RLX_AGENT); }
        }
    }
    __syncthreads();
}
struct CmpOrder {
    int G, c;
    DI bool next(int i, pg8::Unit& u) const { const int L = i * G + c; if (L >= CS_ROWS / 256) return false; u.pm = L; u.pn = (L < 128) ? 0 : (L < 256 ? 1 : (L < 264 ? 0 : 1)); return true; }
    DI void a_ready(const pg8::Unit&) const {}
    DI void done(const pg8::Unit&) const {}
};

#ifndef REPSCAN
#define REPSCAN 1
#endif
#ifndef REPATP
#define REPATP 1
#endif
#ifndef REPATS
#define REPATS 1
#endif
DI void sub_barrier(Frame& F, int word, unsigned n, int mode  ) {
    asm volatile("s_waitcnt vmcnt(0)" ::: "memory");
    __syncthreads();
    if (F.tid == 0) {
        unsigned* w = (unsigned*)(F.ctl + word);
        if (mode != 1) { __builtin_amdgcn_fence(__ATOMIC_RELEASE, "agent"); asm volatile("s_waitcnt vmcnt(0)" ::: "memory"); __hip_atomic_fetch_add(w, 1u, RLX_AGENT); }
        unsigned sp = 0;
        while (mode != 2 && __hip_atomic_load(w, RLX_AGENT) < n) { __builtin_amdgcn_s_sleep(2); if (++sp > (1u << 22)) { __hip_atomic_store(F.ctl + CW_TMO, 0xDEAD0000u | (unsigned)word, RLX_AGENT); break; } }
        __builtin_amdgcn_fence(__ATOMIC_ACQUIRE, "agent");
        asm volatile("s_waitcnt vmcnt(0)" ::: "memory");
    }
    __syncthreads();
}
struct CmpOwnOrder {
    int r;
    DI bool next(int i, pg8::Unit& u) const { if (i == 0) { u.pm = r; u.pn = 0; return true; } if (i == 1) { u.pm = 128 + r; u.pn = 1; return true; }
        if (i == 2 && r < 16) { u.pm = 256 + r; u.pn = r >> 3; return true; } return false; }
    DI void a_ready(const pg8::Unit&) const {}
    DI void done(const pg8::Unit&) const {}
};
DI void mix_even_phase(Frame& F, int li, int rep) {
    const int qw = CW_QUEUE + 256 * li + 1024 * rep, sw = 2048 + 256 * (li * 2 + rep);
    const int NSC = 64;
    const int t0 = take_ticket(F, qw);
    if (t0 < NSC) { LAUNDER(F); PROBE_T0(1) scan_prompt_unit(F, t0 >> 3, t0 & 7, li); PROBE_T1(1)
        sub_barrier(F, sw + 128, (unsigned)NSC, 2); }
    else if (t0 < NSC + 128) {
        const int rank = t0 - NSC; LAUNDER(F);
        { pg8::Gemm g{WSP(bf16, WS_CSEG), WSP(bf16, WS_PHI1) + (size_t)li * 512 * 1024, CS_ROWS, 512, 1024};
          CmpOwnOrder S{rank}; EpiPart E{WSP(float, WS_PART)};
          pg8::gemm_phase<EpiPart, CmpOwnOrder, true, true>(F.lds + RING_OFF, g, S, E); }
        if (rank < 16) sub_barrier(F, sw, 16u, 2);
        asm volatile("s_waitcnt vmcnt(0)" ::: "memory"); __syncthreads();
        if (F.tid == 0) { __builtin_amdgcn_fence(__ATOMIC_ACQUIRE, "agent"); asm volatile("s_waitcnt vmcnt(0)" ::: "memory"); }
        __syncthreads(); LAUNDER(F);
        compress2_stage_w2(F, li);
        compress2_unit(F, 2 * rank, li); compress2_unit(F, 2 * rank + 1, li);
        if (rank < 16) { sub_barrier(F, sw, 16u, 1); LAUNDER(F); compress2_unit(F, 256 + rank, li); sub_barrier(F, sw + 64, 16u, 2); }
        asm volatile("s_waitcnt vmcnt(0)" ::: "memory"); __syncthreads();
        if (F.tid == 0) { __builtin_amdgcn_fence(__ATOMIC_ACQUIRE, "agent"); asm volatile("s_waitcnt vmcnt(0)" ::: "memory"); }
        __syncthreads();
        for (int g = 0; g < 2; ++g) { LAUNDER(F); PROBE_T0(4) attn_sample_unit(F, rank, g, li); PROBE_T1(4) }
    }
    else { LAUNDER(F); }
    for (int r2 = 0; r2 < REPSCAN; ++r2) for (;;) { const int u = take_ticket(F, qw + 64 + 2048 * r2); if (u >= DB) break; LAUNDER(F); PROBE_T0(9) scan_sample_unit(F, u, li); PROBE_T1(9) }
    sub_barrier(F, sw + 64, 16u, 1); LAUNDER(F);
    for (int r2 = 0; r2 < REPATP; ++r2) for (;;) { const int u = take_ticket(F, qw + 128 + 2048 * r2); if (u >= 512) break; LAUNDER(F);
        const int bg = u & 15, c = 31 - (u >> 4);
        PROBE_T0(3) attn_prompt_unit(F, bg >> 1, bg & 1, c, li); PROBE_T1(3) }
    sub_barrier(F, sw + 128, (unsigned)NSC, 1); LAUNDER(F);
    scan_post_phase(F, li);
}

#ifndef MK_PER_PHASE
#define MK_PER_PHASE 0
#endif
constexpr int PH_PER_LAYER = 12, N_PHASES = 1 + DEPTH * PH_PER_LAYER;
#ifndef REP0
#define REP0 1
#endif
#ifndef REP1
#define REP1 1
#endif
#ifndef REP3
#define REP3 1
#endif
#ifndef REP4
#define REP4 1
#endif
#ifndef REP6
#define REP6 1
#endif
#ifndef REP7
#define REP7 1
#endif
#ifndef REP8
#define REP8 1
#endif
__global__ void __launch_bounds__(NTHREADS, 2) mk_fwd(Args args) {
    Frame F;
    F.lds = (LAS unsigned char*)g_lds;
    F.MISC = (volatile LAS unsigned*)(F.lds + MISC_OFF);
    F.tid = threadIdx.x; F.lane = F.tid & 63; F.wave = __builtin_amdgcn_readfirstlane(F.tid >> 6);
    F.G = gridDim.x; F.bid = blockIdx.x;
    F.out = (GAS float*)args.out; F.ws = (GAS unsigned char*)args.ws; F.ctl = (gu32*)(args.ws + WS_CTL); F.ka = (unsigned long long)__builtin_amdgcn_kernarg_segment_ptr();
    for (int u = F.tid; u < (LDS_BYTES - LDSCTL_OFF) / 4; u += NTHREADS) ((LAS unsigned*)(F.lds + LDSCTL_OFF))[u] = 0u;
    __syncthreads();
    XcdBarrier bar; bar.bar = (unsigned*)(F.ctl + CW_BAR); bar.x = 0; bar.st = nullptr;
    if (!MK_PER_PHASE) bar = xcd_barrier_post((unsigned*)(F.ctl + CW_BAR), F.MISC + 8);
    const int lo = args.ph_lo, hi = args.ph_hi;
#define IN(k) (lo <= (k) && (k) < hi)
#define SEAM(k) do { if (IN((k) + 1)) { if (MK_PER_PHASE) { if (F.tid == 0) __hip_atomic_store(F.ctl + CW_TMO, 0xBADBA0u, RLX_AGENT); } else { asm volatile("" : "+s"(bar.bar)); asm volatile("" : "+s"(bar.x)); xcd_barrier(bar); } } } while (0)
    LAS unsigned char* ring = F.lds + RING_OFF;

    if (IN(0)) { LAUNDER(F); PROBE_T0(7) p0_prologue(F); SEAM(0); PROBE_T1(7) }

    for (int l = 0; l < DEPTH; ++l) {
        const int li = l >> 1; const bool even = (l & 1) == 0; const int pb = 1 + l * PH_PER_LAYER;
        if (IN(pb + 0)) for (int rep = 0; rep < REP0; ++rep) { LAUNDER(F); PROBE_T0(11)
            constexpr int NGEMM = 224, BG_QUOTA = 3;
            const int N = even ? NE : NO;
            if (F.G == 256 && l < 3 && F.bid >= NGEMM) { bg_units(F, l == 0 ? 0 : 1, BG_QUOTA); }
            else {
            const int gg = (F.G == 256 && l < 3) ? NGEMM : F.G;
            pg8::Gemm g{WSP(bf16, WS_XN), even ? WSP(bf16, WS_WIE) + (size_t)li * NE * DM : WSP(bf16, WS_WIO) + (size_t)li * NO * DM, MT, N, DM};
            pg8::StaticOrder S; S.init(MT, N, gg, F.bid);
            EpiStoreBf16 E{WSP(bf16, WS_ZB), N};
            pg8::gemm_phase<EpiStoreBf16, pg8::StaticOrder, true, true>(ring, g, S, E);
            }
            SEAM(pb + 0); PROBE_T1(11)
        }
        if (IN(pb + 1)) for (int rep = 0; rep < REP1; ++rep) { LAUNDER(F); PROBE_T0(5) PROBE_T0(10) if (even) { post_even_phase(F, li, l); SEAM(pb + 1); PROBE_T1(5) } else { odd_mix_phase(F, li, l); SEAM(pb + 1); PROBE_T1(10) } }
        if (even) {
            if (IN(pb + 2)) { LAUNDER(F); PROBE_T0(15)
                { int kdim = KLORA; asm volatile("" : "+s"(kdim));
                  pg8::Gemm g{WSP(bf16, WS_LA), WSP(bf16, WS_LORA) + (size_t)li * NLORA * KLORA, MT, NLORA, kdim};
                  pg8::StaticOrder S; S.init(MT, NLORA, F.G, F.bid);
                  EpiLora E{WSP(unsigned char, WS_SC), WSP(float, WS_G), KIN(I_W0) + li * 512, KIN(I_A0) + li * 512};
                  pg8::gemm_phase<EpiLora, pg8::StaticOrder, true, true>(ring, g, S, E); }
                SEAM(pb + 2); PROBE_T1(15)
            }
            if (IN(pb + 4)) for (int rep = 0; rep < REP4; ++rep) { LAUNDER(F); PROBE_T0(2) mix_even_phase(F, li, rep); SEAM(pb + 4); PROBE_T1(2) }
        }
        if (IN(pb + 6)) { LAUNDER(F); PROBE_T0(12)
            const bf16* Wt = even ? WSP(bf16, WS_WOE) + (size_t)li * DM * DM : WSP(bf16, WS_WOO) + (size_t)li * DM * DM;
            pg8::Gemm g{WSP(bf16, WS_MIX), Wt, MP, DM, DM};
            pg8::StaticOrder S; S.init(MP, DM, F.G, F.bid);
            EpiResid E{l == 0 ? KIN(I_XP) : nullptr, WSP(bf16, WS_XN), nullptr, SSQP(2 * l + 1)};
            pg8::gemm_phase<EpiResid, pg8::StaticOrder, true, true>(ring, g, S, E);
            __syncthreads(); LAUNDER(F);
            gemm64_sample_phase<DM>(F, WSP(bf16, WS_MIX) + (size_t)MP * DM, Wt, l == 0 ? KIN(I_XS) : nullptr, WSP(bf16, WS_XN) + (size_t)MP * DM, nullptr, SSQP(2 * l + 1) + MP);
            SEAM(pb + 6); PROBE_T1(12)
        }
        if (IN(pb + 8)) for (int rep = 0; rep < REP7; ++rep) { LAUNDER(F); PROBE_T0(13)
            pg8::Gemm g{WSP(bf16, WS_XN), WSP(bf16, WS_WUP) + (size_t)l * NUP * DM, MT, NUP, DM};
            pg8::StaticOrder S; S.init(MT, NUP, F.G, F.bid);
            EpiFfnAct E{WSP(bf16, WS_H), WSP(float, WS_HALO), KIN(I_FCONV) + (size_t)l * 3 * DFF, SSQP(2 * l + 1), KIN(I_SFFN) + (size_t)l * 2 * DFF, OUTF + O_FFP, OUTF + O_FFS, l};
            pg8::gemm_phase<EpiFfnAct, pg8::StaticOrder, true, true>(ring, g, S, E);
            SEAM(pb + 8); PROBE_T1(13)
        }
        if (IN(pb + 10)) { LAUNDER(F); PROBE_T0(14)
            pg8::Gemm g{WSP(bf16, WS_H), WSP(bf16, WS_WDN) + (size_t)l * DM * DFF, MP, DM, DFF};
            pg8::StaticOrder S; S.init(MP, DM, F.G, F.bid);
            for (int i = 0;; ++i) {
                const int nM = MP / 256, nN = DM / 256, nwg = nM * nN; const long L = (long)i * F.G + F.bid; if (L >= nwg) break;
                int wgid = (int)L; { const int q = nwg / 8, r = nwg % 8, xcd = wgid % 8, off = wgid / 8; wgid = (xcd < r ? xcd * (q + 1) : r * (q + 1) + (xcd - r) * q) + off; }
                const int nig = 8 * nN, gid = wgid / nig, fm = gid * 8, gsz = (nM - fm) < 8 ? (nM - fm) : 8;
                ffn_fix_panel(F, l, fm + ((wgid % nig) % gsz)); }
            LAUNDER(F);
            EpiResid E{nullptr, WSP(bf16, WS_XN), l + 1 < DEPTH ? nullptr : OUTF, SSQP(2 * l + 2 < 8 ? 2 * l + 2 : 0)};
            pg8::gemm_phase<EpiResid, pg8::StaticOrder, true, true>(ring, g, S, E);
            __syncthreads(); LAUNDER(F);
            gemm64_sample_phase<DFF>(F, WSP(bf16, WS_H) + (size_t)MP * DFF, WSP(bf16, WS_WDN) + (size_t)l * DM * DFF, nullptr, WSP(bf16, WS_XN) + (size_t)MP * DM, l + 1 < DEPTH ? nullptr : OUTF + (size_t)MP * DM, SSQP(2 * l + 2 < 8 ? 2 * l + 2 : 0) + MP);
            if (l + 1 < DEPTH) SEAM(pb + 10); PROBE_T1(14)
        }
    }
#undef IN
#undef SEAM
#ifdef PROBE_SUM
    if (PROBE_ID != 0) { __syncthreads(); if (F.tid == 0) __hip_atomic_fetch_add((unsigned*)(F.ctl + 40), (unsigned)F.MISC[20], RLX_AGENT);
        asm volatile("" : "+s"(bar.bar)); asm volatile("" : "+s"(bar.x)); xcd_barrier(bar);
        if (F.bid == 0 && F.tid == 0) { const unsigned long long t0 = __builtin_amdgcn_s_memrealtime(), dt = (unsigned long long)__hip_atomic_load((unsigned*)(F.ctl + 40), RLX_AGENT) * PROBE_MUL / 256;
            while (__builtin_amdgcn_s_memrealtime() - t0 < dt) __builtin_amdgcn_s_sleep(8); } }
#else
    if (PROBE_ID != 0) { __syncthreads(); if (F.tid == 0) { const unsigned long long t0 = __builtin_amdgcn_s_memrealtime(), dt = (unsigned long long)F.MISC[20] * PROBE_MUL;
        while (__builtin_amdgcn_s_memrealtime() - t0 < dt) __builtin_amdgcn_s_sleep(8); } }
#endif
}

extern "C" void kernel_launch(void* const* d_in, const int* in_sizes, int n_in, void* d_out, int out_size, void* d_ws, size_t ws_size, hipStream_t stream) {
    static int grid = 0;
    if (grid == 0) {
        if (n_in != N_IN || (size_t)out_size != O_END || ws_size < WS_END) { fprintf(stderr, "kernel_launch: unexpected shapes: n_in %d out %d ws %zu (need %zu)\n", n_in, out_size, ws_size, (size_t)WS_END); grid = -1; return; }
        int dev = 0, cus = 0, per_cu = 0;
        if (hipGetDevice(&dev) != hipSuccess || hipDeviceGetAttribute(&cus, hipDeviceAttributeMultiprocessorCount, dev) != hipSuccess) { grid = -1; return; }
        if (hipFuncSetAttribute((const void*)mk_fwd, hipFuncAttributeMaxDynamicSharedMemorySize, LDS_BYTES) != hipSuccess) { fprintf(stderr, "kernel_launch: hipFuncSetAttribute failed\n"); grid = -1; return; }
        if (hipOccupancyMaxActiveBlocksPerMultiprocessor(&per_cu, (const void*)mk_fwd, NTHREADS, LDS_BYTES) != hipSuccess || per_cu < 1) { fprintf(stderr, "kernel_launch: occupancy query says %d\n", per_cu); }
        (void)hipGetLastError();
        grid = cus;
        if (cus != 256) { fprintf(stderr, "kernel_launch: built for a 256-CU device (the mix phase splits the grid 128 + 128), found %d CUs\n", cus); if (cus > 256) grid = 256; }
    }
    if (grid < 0) return;
    if (hipMemsetAsync((char*)d_ws + WS_CTL, 0, CTL_RESERVED, stream) != hipSuccess) return;
    Args a{};
    for (int i = 0; i < N_IN; ++i) a.in[i] = (const float*)d_in[i];
    a.out = (float*)d_out; a.ws = (unsigned char*)d_ws;
#if MK_PER_PHASE
    for (int p = 0; p < N_PHASES; ++p) {
        if (p > 0) { const int l = (p - 1) / PH_PER_LAYER, q = (p - 1) % PH_PER_LAYER; if ((l & 1) && q >= 2 && q <= 5) continue; if (l == DEPTH - 1 && q == 11) continue; }
        a.ph_lo = p; a.ph_hi = p + 1;
        hipLaunchKernelGGL(mk_fwd, dim3(grid), dim3(NTHREADS), LDS_BYTES, stream, a);
    }
#else
    a.ph_lo = 0; a.ph_hi = N_PHASES;
    hipLaunchKernelGGL(mk_fwd, dim3(grid), dim3(NTHREADS), LDS_BYTES, stream, a);
#endif
    const hipError_t le = hipPeekAtLastError();
    if (le != hipSuccess) fprintf(stderr, "kernel_launch: launch failed: %s\n", hipGetErrorName(le));
}
```

```cpp
#include <hip/hip_runtime.h>
#include <cstdio>
#include <cstdint>

namespace pg8 {
#define PG8_LAS __attribute__((address_space(3)))
typedef unsigned short bf16_t;
typedef short bf16x8 __attribute__((ext_vector_type(8)));
typedef float f32x4 __attribute__((ext_vector_type(4)));
typedef unsigned u32x4 __attribute__((ext_vector_type(4)));
constexpr int BM = 256, BK = 64, HALF = 128, HTB = HALF * BK * 2  , STAGE_BYTES = 8 * HTB, NXCD = 8, WGM = 8;

__host__ __device__ __forceinline__ int lds_byte(int r, int c) { const int st = (r >> 4) * 2 + (c >> 5), rr = r & 15, cc = c & 31, ob = rr * 64 + cc * 2; return st * 1024 + (ob ^ (((ob >> 9) & 1) << 5)); }
__host__ __device__ __forceinline__ void stage_rc(int b, int& R, int& C) { const int st = b / 1024, sb = b % 1024, swz = sb ^ (((sb >> 9) & 1) << 5); R = (st >> 1) * 16 + swz / 64; C = (st & 1) * 32 + (swz % 64) / 2; }
__host__ __device__ __forceinline__ int perm32(int rho) { const int n = rho >> 4, i = rho & 15; return 8 * (i >> 2) + 4 * n + (i & 3); }

struct Unit { int pm, pn; };
struct Gemm { const bf16_t* A; const bf16_t* Bt; int M, N, K; };

struct StaticOrder {
    int nM, nN, nwg, G, c;
    __host__ __device__ void init(int M, int N, int G_, int c_) { nM = M / BM; nN = N / BM; nwg = nM * nN; G = G_; c = c_; }
    __host__ __device__ bool next(int i, Unit& u) const {
        const long L = (long)i * G + c; if (L >= nwg) return false;
        int wgid = (int)L; { const int q = nwg / NXCD, r = nwg % NXCD, xcd = wgid % NXCD, off = wgid / NXCD; wgid = (xcd < r ? xcd * (q + 1) : r * (q + 1) + (xcd - r) * q) + off; }
        const int nig = WGM * nN, gid = wgid / nig, fm = gid * WGM, gsz = (nM - fm) < WGM ? (nM - fm) : WGM;
        u.pm = fm + ((wgid % nig) % gsz); u.pn = (wgid % nig) / gsz; return true;
    }
    __device__ __forceinline__ void a_ready(const Unit&) const {}
    __device__ __forceinline__ void done(const Unit&) const {}
};

__device__ __forceinline__ unsigned cvt_pk_bf16(float lo, float hi) { unsigned r; asm volatile("v_cvt_pk_bf16_f32 %0, %1, %2" : "=v"(r) : "v"(lo), "v"(hi)); return r; }
template <class Epi, class Sched, bool ALIGN_EPI = false, bool SP2 = false>
__device__ __forceinline__ void gemm_phase(PG8_LAS unsigned char* lds, const Gemm g, const Sched& S, const Epi& E) {
    int tid_ = threadIdx.x; asm volatile("" : "+v"(tid_));
    const int tid = tid_, wid = __builtin_amdgcn_readfirstlane(tid >> 6), lane = tid & 63, wr = wid >> 2, wc = wid & 3, fr = lane & 15, fq = lane >> 4;
    const int K = g.K, nt = K / BK;
    unsigned voffA[2], voffB[2];
#pragma unroll
    for (int i = 0; i < 2; ++i) { int R, C; stage_rc(tid * 16 + i * 8192, R, C); const int Rb = Epi::PERM ? ((R & ~31) + perm32(R & 31)) : R;
        voffA[i] = (unsigned)(R * K + C) * 2u; voffB[i] = (unsigned)(Rb * K + C) * 2u; }
    const size_t kstep = (size_t)(BK * 2);
    const size_t hstep = (size_t)HALF * K * 2;
    const size_t tstep = 2 * hstep;
    const unsigned ldsw = (unsigned)wid * 1024u;
    const int aoff = lds_byte(wr * 64 + fr, fq * 8), boff = lds_byte(wc * 32 + fr, fq * 8);
#define PG8_SA(b, h) (((b) * 2 + (h)) * HTB)
#define PG8_SB(b, h) ((4 + (b) * 2 + (h)) * HTB)
#define PG8_STAGE(bufoff, gbase, voff) do { _Pragma("unroll") for (int _i = 0; _i < 2; ++_i) \
        __builtin_amdgcn_global_load_lds((const unsigned*)((const char*)(gbase) + (voff)[_i]), (PG8_LAS unsigned*)(lds + (bufoff) + ldsw + _i * 8192), 16, 0, 0); } while (0)
#define PG8_LDA(dst, b, h) do { _Pragma("unroll") for (int m = 0; m < 4; ++m) _Pragma("unroll") for (int k = 0; k < 2; ++k) dst[m][k] = *(const PG8_LAS bf16x8*)(lds + PG8_SA(b, h) + aoff + m * 2048 + k * 1024); } while (0)
#define PG8_LDB(dst, b, h) do { _Pragma("unroll") for (int n = 0; n < 2; ++n) _Pragma("unroll") for (int k = 0; k < 2; ++k) dst[n][k] = *(const PG8_LAS bf16x8*)(lds + PG8_SB(b, h) + boff + n * 2048 + k * 1024); } while (0)
#define PG8_MMA(ai, bj, At, Bt) do { __builtin_amdgcn_s_setprio(1); _Pragma("unroll") for (int m = 0; m < 4; ++m) _Pragma("unroll") for (int n = 0; n < 2; ++n) _Pragma("unroll") for (int k = 0; k < 2; ++k) \
        acc[ai][bj][m][n] = __builtin_amdgcn_mfma_f32_16x16x32_bf16(Bt[n][k], At[m][k], acc[ai][bj][m][n], 0, 0, 0); __builtin_amdgcn_s_setprio(0); } while (0)
#define PG8_WAIT_V(n) asm volatile("s_waitcnt vmcnt(" #n ")" ::: "memory")
#define PG8_WAIT_L(n) asm volatile("s_waitcnt lgkmcnt(" #n ")" ::: "memory")
#define PG8_BAR __builtin_amdgcn_s_barrier()
#define PG8_SCHED __builtin_amdgcn_sched_barrier(0)
    Unit cur, nxt; int ui = 0;
    if (!S.next(0, cur)) return;
    f32x4 acc[2][2][4][2];
#pragma unroll
    for (int a = 0; a < 2; ++a)
#pragma unroll
        for (int b = 0; b < 2; ++b)
#pragma unroll
            for (int m = 0; m < 4; ++m)
#pragma unroll
                for (int n = 0; n < 2; ++n) acc[a][b][m][n] = (f32x4){0.f, 0.f, 0.f, 0.f};
    bf16x8 At[4][2], B0[2][2], B1[2][2];
    const char* cA = (const char*)g.A + (size_t)cur.pm * tstep; const char* cB = (const char*)g.Bt + (size_t)cur.pn * tstep;
    S.a_ready(cur);
    if constexpr (SP2) {
        PG8_STAGE(PG8_SB(0, 0), cB, voffB); PG8_STAGE(PG8_SB(0, 1), cB + hstep, voffB); PG8_STAGE(PG8_SA(0, 0), cA, voffA); PG8_STAGE(PG8_SA(0, 1), cA + hstep, voffA);
        if (wr == 1) PG8_BAR;
        PG8_WAIT_V(2); PG8_BAR;
        PG8_STAGE(PG8_SB(1, 0), cB + kstep, voffB); PG8_STAGE(PG8_SA(1, 0), cA + kstep, voffA); PG8_STAGE(PG8_SB(1, 1), cB + hstep + kstep, voffB);
        PG8_WAIT_V(6); PG8_BAR;
    } else {
        PG8_STAGE(PG8_SB(0, 0), cB, voffB); PG8_STAGE(PG8_SA(0, 0), cA, voffA); PG8_STAGE(PG8_SB(0, 1), cB + hstep, voffB); PG8_STAGE(PG8_SA(0, 1), cA + hstep, voffA);
        if (wr == 1) PG8_BAR;
        PG8_WAIT_V(4); PG8_BAR;
        PG8_STAGE(PG8_SB(1, 0), cB + kstep, voffB); PG8_STAGE(PG8_SA(1, 0), cA + kstep, voffA); PG8_STAGE(PG8_SB(1, 1), cB + hstep + kstep, voffB);
        PG8_WAIT_V(6); PG8_BAR;
    }
    for (;;) {
        const bool has_next = S.next(ui + 1, nxt);
        const char* nA = has_next ? (const char*)g.A + (size_t)nxt.pm * tstep : cA; const char* nB = has_next ? (const char*)g.Bt + (size_t)nxt.pn * tstep : cB;
        for (int t = 0; t < nt; t += 2) {
            const bool last = (t == nt - 2);
            const char* a1 = cA + (size_t)(t + 1) * kstep;
            const char* a2 = last ? nA : cA + (size_t)(t + 2) * kstep; const char* b2 = last ? nB : cB + (size_t)(t + 2) * kstep;
            const char* a3 = a2 + kstep; const char* b3 = b2 + kstep;
            if (last && has_next) S.a_ready(nxt);
            if constexpr (SP2) {
            PG8_LDB(B0, 0, 0); PG8_LDB(B1, 0, 1); PG8_SCHED; PG8_LDA(At, 0, 0); PG8_STAGE(PG8_SA(1, 1), a1 + hstep, voffA);
            PG8_WAIT_V(8); PG8_WAIT_L(0); PG8_BAR; PG8_MMA(0, 0, At, B0); PG8_MMA(0, 1, At, B1); PG8_BAR; PG8_SCHED;
            PG8_LDA(At, 0, 1); PG8_STAGE(PG8_SB(0, 0), b2, voffB); PG8_STAGE(PG8_SB(0, 1), b2 + hstep, voffB); PG8_STAGE(PG8_SA(0, 0), a2, voffA);
            PG8_WAIT_V(8); PG8_WAIT_L(0); PG8_BAR; PG8_MMA(1, 0, At, B0); PG8_MMA(1, 1, At, B1); PG8_BAR; PG8_SCHED;
            PG8_LDB(B0, 1, 0); PG8_LDB(B1, 1, 1); PG8_SCHED; PG8_LDA(At, 1, 0); PG8_STAGE(PG8_SA(0, 1), a2 + hstep, voffA);
            PG8_WAIT_V(8); PG8_WAIT_L(0); PG8_BAR; PG8_MMA(0, 0, At, B0); PG8_MMA(0, 1, At, B1); PG8_BAR; PG8_SCHED;
            PG8_LDA(At, 1, 1); PG8_STAGE(PG8_SB(1, 0), b3, voffB); PG8_STAGE(PG8_SB(1, 1), b3 + hstep, voffB); PG8_STAGE(PG8_SA(1, 0), a3, voffA);
            PG8_WAIT_V(8); PG8_WAIT_L(0); PG8_BAR; PG8_MMA(1, 0, At, B0); PG8_MMA(1, 1, At, B1); PG8_BAR; PG8_SCHED;
            } else {
            PG8_LDB(B0, 0, 0); PG8_SCHED; PG8_LDA(At, 0, 0); PG8_STAGE(PG8_SA(1, 1), a1 + hstep, voffA);
            PG8_WAIT_L(8); PG8_BAR; PG8_WAIT_L(0); PG8_MMA(0, 0, At, B0); PG8_BAR; PG8_SCHED;
            PG8_LDB(B1, 0, 1); PG8_STAGE(PG8_SB(0, 0), b2, voffB);
            PG8_BAR; PG8_WAIT_L(0); PG8_MMA(0, 1, At, B1); PG8_BAR;
            PG8_LDA(At, 0, 1); PG8_STAGE(PG8_SA(0, 0), a2, voffA);
            PG8_BAR; PG8_WAIT_L(0); PG8_MMA(1, 0, At, B0); PG8_BAR; PG8_SCHED;
            PG8_STAGE(PG8_SB(0, 1), b2 + hstep, voffB);
            PG8_WAIT_V(6); PG8_BAR; PG8_MMA(1, 1, At, B1); PG8_BAR;
            PG8_LDB(B0, 1, 0); PG8_SCHED; PG8_LDA(At, 1, 0); PG8_STAGE(PG8_SA(0, 1), a2 + hstep, voffA);
            PG8_WAIT_L(8); PG8_BAR; PG8_WAIT_L(0); PG8_MMA(0, 0, At, B0); PG8_BAR; PG8_SCHED;
            PG8_LDB(B1, 1, 1); PG8_STAGE(PG8_SB(1, 0), b3, voffB);
            PG8_BAR; PG8_WAIT_L(0); PG8_MMA(0, 1, At, B1); PG8_BAR;
            PG8_LDA(At, 1, 1); PG8_STAGE(PG8_SA(1, 0), a3, voffA);
            PG8_BAR; PG8_WAIT_L(0); PG8_MMA(1, 0, At, B0); PG8_BAR; PG8_SCHED;
            PG8_STAGE(PG8_SB(1, 1), b3 + hstep, voffB);
            PG8_WAIT_V(6); PG8_BAR; PG8_MMA(1, 1, At, B1); PG8_BAR;
            }
        }
        if constexpr (ALIGN_EPI) { if (wr == 0) PG8_BAR; }
#if defined(PROBE_ID) && (PROBE_ID >= 16 && PROBE_ID <= 20)
        unsigned long long pt0_ = 0; if (PROBE_ID == Epi::PID) { __builtin_amdgcn_s_barrier(); pt0_ = __builtin_amdgcn_s_memrealtime(); }
#endif
        if constexpr (!Epi::AFTER_DRAIN) { E(acc, cur, wr, wc, fr, fq); S.done(cur); }
#if defined(PROBE_ID) && (PROBE_ID >= 16 && PROBE_ID <= 20)
        if (PROBE_ID == Epi::PID) { asm volatile("s_waitcnt vmcnt(0)" ::: "memory"); __builtin_amdgcn_s_barrier(); if (threadIdx.x == 0) ((volatile PG8_LAS unsigned*)(lds + 131072 + 320))[20] += (unsigned)(__builtin_amdgcn_s_memrealtime() - pt0_); }
#endif
        if (!has_next) break;
#pragma unroll
        for (int a = 0; a < 2; ++a)
#pragma unroll
            for (int b = 0; b < 2; ++b)
#pragma unroll
                for (int m = 0; m < 4; ++m)
#pragma unroll
                    for (int n = 0; n < 2; ++n) acc[a][b][m][n] = (f32x4){0.f, 0.f, 0.f, 0.f};
        cur = nxt; cA = nA; cB = nB; ++ui;
        if constexpr (ALIGN_EPI) { if (wr == 1) PG8_BAR; }
    }
    PG8_WAIT_V(0);
    if constexpr (!ALIGN_EPI) { if (wr == 0) PG8_BAR; }
    PG8_BAR;
    if constexpr (Epi::AFTER_DRAIN) { E.fused(acc, cur, wr, wc, fr, fq, lds, wid, lane); S.done(cur); }
#undef PG8_SA
#undef PG8_SB
#undef PG8_STAGE
#undef PG8_LDA
#undef PG8_LDB
#undef PG8_MMA
#undef PG8_WAIT_V
#undef PG8_WAIT_L
#undef PG8_BAR
#undef PG8_SCHED
}
}

constexpr int DM = 1024, NB = 8, SEQ = 2048, DEPTH = 4, DB = 128, DT = 8, PAST = 2048, PAGE = 128, NPAGE = 16, NPOOL = 2560;
constexpr int HD = 64, NCMP = 127, WIN = 512;
constexpr int MP = NB * SEQ, MS = DB * DT, MT = MP + MS;
constexpr int NE_ORIG = 3096, NE = 3328, RWP = 1792, NO = 3072, DFF = 2816, NUP = 2 * DFF;
constexpr int NLORA = 1536, KLORA = 256;
constexpr float RMS_EPS = 1e-6f, GN_EPS = 64e-5f, LOG2E = 1.4426950408889634f;
constexpr int NWAVES = 8, NTHREADS = 512;

enum { I_XP = 0, I_XS, I_CCMP, I_CSLC, I_CWIN, I_SWKV, I_SSHIFT, I_SCONV, I_SFFN, I_PT, I_NMIX, I_NFFN, I_RELB, I_WINE, I_WOUTE, I_QN, I_KN,
       I_PPE, I_PW1, I_PW2, I_MU, I_W0, I_W2, I_A0, I_A2, I_G2, I_KKW, I_KA, I_RK, I_LNW, I_LNB, I_WINO, I_CONVW, I_WOUTO, I_FUP, I_FCONV, I_FDOWN, N_IN };

constexpr size_t O_YP = 0, O_YS = O_YP + (size_t)MP * DM, O_CMPP = O_YS + (size_t)MS * DM, O_CMPS = O_CMPP + (size_t)NB * 2 * SEQ * 256,
    O_SLCP = O_CMPS + (size_t)DB * 2 * DT * 256, O_SLCS = O_SLCP + (size_t)NB * 2 * SEQ * 256, O_WINP = O_SLCS + (size_t)DB * 2 * DT * 256,
    O_WINS = O_WINP + (size_t)NB * 2 * WIN * 256, O_WKVP = O_WINS + (size_t)DB * 2 * WIN * 256, O_WKVS = O_WKVP + (size_t)NB * 2 * 8 * 4096,
    O_SHP = O_WKVS + (size_t)DB * 2 * 8 * 4096, O_SHS = O_SHP + (size_t)NB * 2 * RWP, O_CVP = O_SHS + (size_t)DB * 2 * RWP, O_CVS = O_CVP + (size_t)NB * 2 * 2 * DM,
    O_FFP = O_CVS + (size_t)DB * 2 * 2 * DM, O_FFS = O_FFP + (size_t)NB * 4 * 2 * DFF, O_END = O_FFS + (size_t)DB * 4 * 2 * DFF;

constexpr size_t al256(size_t x) { return (x + 255) & ~(size_t)255; }
constexpr size_t WS_CTL = 0, CTL_ZERO_BYTES = 1u << 20, CTL_RESERVED = 2u << 20;
constexpr size_t WS_WIE = CTL_RESERVED;
constexpr size_t WS_WOE = WS_WIE + (size_t)2 * NE * DM * 2;
constexpr size_t WS_WIO = WS_WOE + (size_t)2 * DM * DM * 2;
constexpr size_t WS_WOO = WS_WIO + (size_t)2 * NO * DM * 2;
constexpr size_t WS_WUP = WS_WOO + (size_t)2 * DM * DM * 2;
constexpr size_t WS_WDN = WS_WUP + (size_t)4 * NUP * DM * 2;
constexpr size_t WS_PHI1 = WS_WDN + (size_t)4 * DM * DFF * 2;
constexpr size_t WS_LORA = WS_PHI1 + (size_t)2 * 512 * 1024 * 2;
constexpr size_t WS_PEC = WS_LORA + (size_t)2 * NLORA * KLORA * 2;
constexpr size_t WS_XN = al256(WS_PEC + 4 * 128 * 4);
constexpr size_t WS_ZB = WS_XN + (size_t)MT * DM * 2;
constexpr size_t WS_QB = WS_ZB + (size_t)MT * NUP * 2;
constexpr size_t WS_CSEG = WS_QB + (size_t)MT * 512 * 2;
constexpr int CS_SK = 0, CS_SV = 32768, CS_PK = 65536, CS_PV = 67584, CS_ROWS = 69632;
constexpr size_t WS_PART = WS_CSEG + (size_t)CS_ROWS * 1024 * 2;
constexpr size_t WS_KC = WS_PART + (size_t)CS_ROWS * 256 * 4;
constexpr size_t WS_VCT = WS_KC + (size_t)272 * 128 * 64 * 2;
constexpr size_t WS_KS = WS_VCT + (size_t)272 * 128 * 64 * 2;
constexpr size_t WS_KW = WS_KS + (size_t)NB * 2 * SEQ * 64 * 2;
constexpr size_t WS_VST = WS_KW + (size_t)NB * 2 * SEQ * 64 * 2;
constexpr size_t WS_VWT = WS_VST + (size_t)NB * 2 * SEQ * 64 * 2;
constexpr size_t WS_GATE = WS_VWT + (size_t)NB * 2 * SEQ * 64 * 2;
constexpr size_t WS_SC = WS_GATE + (size_t)MT * 32 * 4;
constexpr int SCR_BYTES = 896, SCR_KK = 256, SCR_A = 384, SCR_K = 512, SCR_R = 640, SCR_V = 768;
#define SCREC(row, h) ((unsigned char*)(F.ws + WS_SC + ((size_t)(row) * 8 + (h)) * SCR_BYTES))
constexpr size_t WS_G = WS_SC + (size_t)MT * 8 * 6 * 64 * 4;
constexpr size_t WS_LA = WS_G + (size_t)MT * 512 * 4;
constexpr size_t WS_MIX = WS_LA + (size_t)MT * 256 * 2;
constexpr size_t WS_H = WS_MIX + (size_t)MT * DM * 2;
constexpr size_t WS_YRAW = WS_H + (size_t)MT * DFF * 2;
constexpr size_t WS_HALO = WS_YRAW + (size_t)MP * 512 * 4;
constexpr size_t WS_PECP = WS_HALO + (size_t)256 * 6 * DFF * 4;
constexpr size_t WS_END = WS_PECP + (size_t)32 * 512 * 4;

constexpr int CW_TMO = 0, CW_CODE = 1;
constexpr int CW_QUEUE = 64;
constexpr int CW_BAR = 4096;
constexpr size_t CTL_SSQ_BYTE = 65536; constexpr float SSQ_SCALE = 1048576.f;
static_assert(CTL_SSQ_BYTE + (size_t)8 * MT * 8 <= CTL_ZERO_BYTES * 2, "SSQ inside the memset region");
#define SSQP(k) ((unsigned long long*)(F.ws + WS_CTL + CTL_SSQ_BYTE) + (size_t)(k) * MT)


constexpr int RING_OFF = 0, RING_BYTES = 131072;
constexpr int LDSCTL_OFF = RING_BYTES, MISC_OFF = LDSCTL_OFF + 320;
constexpr int LDS_BYTES = 147456;

#define GAS __attribute__((address_space(1)))
#define LAS __attribute__((address_space(3)))
typedef unsigned short bf16;
typedef unsigned v4u __attribute__((ext_vector_type(4)));
typedef unsigned v2u __attribute__((ext_vector_type(2)));
typedef float f32x4 __attribute__((ext_vector_type(4)));
typedef float f32x2 __attribute__((ext_vector_type(2)));
typedef float f32x16 __attribute__((ext_vector_type(16)));
typedef short bf16x8 __attribute__((ext_vector_type(8)));
typedef GAS unsigned gu32;
#define RLX_AGENT __ATOMIC_RELAXED, __HIP_MEMORY_SCOPE_AGENT
#define LDS_WAIT() asm volatile("s_waitcnt lgkmcnt(0)" ::: "memory")
#define VM_WAIT() asm volatile("s_waitcnt vmcnt(0)" ::: "memory")
#define DI __device__ __forceinline__
#define MFMA32(a, b, c) __builtin_amdgcn_mfma_f32_32x32x16_bf16((a), (b), (c), 0, 0, 0)

DI float bf2f(unsigned b) { return __builtin_bit_cast(float, b << 16); }
DI float bflo(unsigned w) { return __builtin_bit_cast(float, w << 16); }
DI float bfhi(unsigned w) { return __builtin_bit_cast(float, w & 0xffff0000u); }
DI unsigned pk2(float lo, float hi) {
    typedef __bf16 bf2v __attribute__((ext_vector_type(2)));
    f32x2 v = {lo, hi}; bf2v r = __builtin_convertvector(v, bf2v); return __builtin_bit_cast(unsigned, r);
}
DI float rbf(float x) { return bflo(pk2(x, 0.f) & 0xffffu); }
DI float fexp2(float x) { return __builtin_amdgcn_exp2f(x); }
DI float fexp(float x) { return __builtin_amdgcn_exp2f(x * LOG2E); }
DI float frcp(float x) { return __builtin_amdgcn_rcpf(x); }
DI float sigmoidf_(float x) { return __builtin_amdgcn_rcpf(1.0f + __expf(-x)); }
DI float tanhf_(float x) { const float e = __expf(2.0f * x); return 1.0f - 2.0f * __builtin_amdgcn_rcpf(e + 1.0f); }
template <int CTRL> DI float dppf(float x) { return __builtin_bit_cast(float, __builtin_amdgcn_mov_dpp(__builtin_bit_cast(int, x), CTRL, 0xf, 0xf, true)); }
template <int CTRL> DI unsigned dppu(unsigned x) { return (unsigned)__builtin_amdgcn_mov_dpp((int)x, CTRL, 0xf, 0xf, true); }
constexpr int XOR1 = 0xB1, XOR2 = 0x4E, HMIR = 0x141, ROR8 = 0x128;
DI float sum4(float v) { v += dppf<XOR1>(v); v += dppf<XOR2>(v); return v; }
DI float sum8(float v) { v = sum4(v); v += dppf<HMIR>(v); return v; }
DI float sum16(float v) { v = sum8(v); v += dppf<ROR8>(v); return v; }
DI float wave_sum(float v) {
#pragma unroll
    for (int o = 1; o < 64; o <<= 1) v += __shfl_xor(v, o);
    return v;
}
DI float rinv_of(const unsigned long long* ssq, int row) { return __builtin_amdgcn_rsqf((float)ssq[row] * (1.f / (SSQ_SCALE * DM)) + RMS_EPS); }
DI int crow(int i, int h) { return (i & 3) + 8 * (i >> 2) + 4 * h; }

#define XB_TMO      128
#define XB_XCNT(j)  (256  + 64 * (j))
#define XB_XSUB(j)  (1280 + 64 * (j))
#define XB_XGEN(j)  (2304 + 64 * (j))
#define XB_TOP      3328
#define XB_TOPGEN   3392
#define XCD_BAR_WORDS 3456
#define XB_SPIN_CAP (1u << 18)

__device__ __forceinline__ unsigned xb_ld(unsigned* p)              { return __hip_atomic_load(p, __ATOMIC_RELAXED, __HIP_MEMORY_SCOPE_AGENT); }
__device__ __forceinline__ unsigned xb_add(unsigned* p, unsigned v) { return __hip_atomic_fetch_add(p, v, __ATOMIC_RELAXED, __HIP_MEMORY_SCOPE_AGENT); }
__device__ __forceinline__ unsigned xb_xcc_id() { return (unsigned)__builtin_amdgcn_s_getreg((3 << 11) | 20) & 0xFu; }
#define XB_SPIN(cond, bar) do { unsigned _sp = 0; while (cond) { __builtin_amdgcn_s_sleep(1); \
    if ((++_sp & 255u) == 0u) { if (xb_ld(&(bar)[XB_TMO])) break; if (_sp > XB_SPIN_CAP) { atomicAdd(&(bar)[XB_TMO], 1u); break; } } } } while (0)

struct XcdBarrier { unsigned* bar; unsigned x; volatile LAS unsigned* st; };

__device__ __forceinline__ XcdBarrier xcd_barrier_post(unsigned* bar, volatile LAS unsigned* st) {
    XcdBarrier b; b.bar = bar; b.x = xb_xcc_id(); b.st = st;
    if (threadIdx.x == 0) (void)xb_add(&bar[XB_XCNT(b.x)], 1u);
    return b;
}
__device__ __forceinline__ void xcd_barrier_complete(unsigned* bar, unsigned x, unsigned& nloc, unsigned& nx) {
    const unsigned G = gridDim.x * gridDim.y * gridDim.z;
    unsigned sum, cnt, mine, sp = 0u;
    for (;;) {
        sum = 0u; cnt = 0u; mine = 0u;
#pragma unroll
        for (unsigned j = 0; j < 16; ++j) { const unsigned c = xb_ld(&bar[XB_XCNT(j)]); sum += c; cnt += (c > 0u) ? 1u : 0u; mine = (j == x) ? c : mine; }
        if (sum == G) break;
        __builtin_amdgcn_s_sleep(1);
        if ((++sp & 255u) == 0u) { if (xb_ld(&bar[XB_TMO])) break; if (sp > XB_SPIN_CAP) { atomicAdd(&bar[XB_TMO], 1u); break; } }
    }
    nloc = mine > 0u ? mine : 1u; nx = cnt > 0u ? cnt : 1u;
}
__device__ __forceinline__ void xcd_barrier(const XcdBarrier& b) {
    asm volatile("s_waitcnt vmcnt(0)" ::: "memory");
    __syncthreads();
    if (threadIdx.x == 0) {
        unsigned* bar = b.bar;
        __builtin_amdgcn_s_waitcnt(0);
        unsigned nloc = b.st[0], nx = b.st[1];
        if (nloc == 0u) { xcd_barrier_complete(bar, b.x, nloc, nx); b.st[0] = nloc; b.st[1] = nx; }
        const unsigned old = xb_add(&bar[XB_XSUB(b.x)], 1u);
        const unsigned gen = old / nloc;
        if (old + 1u == (gen + 1u) * nloc) {
            __builtin_amdgcn_fence(__ATOMIC_RELEASE, "agent");
            asm volatile("s_waitcnt vmcnt(0)" ::: "memory");
            const unsigned og = xb_add(&bar[XB_TOP], 1u);
            const unsigned tg = og / nx;
            if (og + 1u == (tg + 1u) * nx) xb_add(&bar[XB_TOPGEN], 1u);
            else XB_SPIN(xb_ld(&bar[XB_TOPGEN]) == tg, bar);
            __builtin_amdgcn_fence(__ATOMIC_ACQUIRE, "agent");
            xb_add(&bar[XB_XGEN(b.x)], 1u);
            asm volatile("s_waitcnt vmcnt(0)" ::: "memory");
        } else {
            XB_SPIN(xb_ld(&bar[XB_XGEN(b.x)]) == gen, bar);
            __builtin_amdgcn_fence(__ATOMIC_ACQUIRE, "agent");
            asm volatile("s_waitcnt vmcnt(0)" ::: "memory");
        }
    }
    __syncthreads();
}

struct Frame {
    LAS unsigned char* lds;
    volatile LAS unsigned* MISC;
    gu32* ctl;
    int tid, lane, wave, G, bid;
    GAS float* out;
    GAS unsigned char* ws;
    unsigned long long ka;
};
#define LAUNDER(F) do { asm volatile("" : "+s"((F).ws)); asm volatile("" : "+s"((F).out)); asm volatile("" : "+s"((F).ka)); asm volatile("" : "+s"((F).bid)); asm volatile("" : "+s"((F).G)); asm volatile("" : "+v"((F).tid)); (F).lane = (F).tid & 63; (F).wave = __builtin_amdgcn_readfirstlane((F).tid >> 6); } while (0)
#define WSP(T, off) ((T*)(F.ws + (off)))
#define OUTF ((float*)F.out)
struct Args { const float* in[N_IN]; float* out; unsigned char* ws; int ph_lo, ph_hi; };
struct KArgs { const GAS float* in[N_IN]; GAS float* out; GAS unsigned char* ws; int ph_lo, ph_hi; };
#define KIN(i) ((const float*)(((const __attribute__((address_space(4))) KArgs*)(F.ka))->in[i]))

#ifndef PROBE_ID
#define PROBE_ID 0
#endif
#ifndef PROBE_MUL
#define PROBE_MUL 8
#endif
#define PROBE_T0(id) unsigned long long _pt0_##id = 0; if (PROBE_ID == (id)) { __syncthreads(); _pt0_##id = __builtin_amdgcn_s_memrealtime(); }
#define PROBE_T1(id) if (PROBE_ID == (id)) { __syncthreads(); if (F.tid == 0) F.MISC[20] += (unsigned)(__builtin_amdgcn_s_memrealtime() - _pt0_##id); }
template <class SRC> DI void tr_load(const SRC& src, int N, int item, int lane, float (&tv)[32]) {
    const int nblk = N / 32, kb = item / nblk, nb = item % nblk, k0 = 64 * kb, n0 = 32 * nb;
#pragma unroll
    for (int i = 0; i < 32; ++i) tv[i] = src(k0 + 2 * i + (lane >> 5), n0 + (lane & 31));
}
DI void tr_store(const float (&tv)[32], int K, int N, bf16* WT, LAS float* scr, int item, int lane) {
    const int nblk = N / 32, kb = item / nblk, nb = item % nblk, k0 = 64 * kb, n0 = 32 * nb;
#pragma unroll
    for (int i = 0; i < 32; ++i) scr[(2 * i + (lane >> 5)) * 33 + (lane & 31)] = tv[i];
    LDS_WAIT(); asm volatile("" ::: "memory");
    const int c = lane & 7;
#pragma unroll
    for (int j = 0; j < 4; ++j) { const int n = (lane >> 3) + 8 * j; const LAS float* s = scr + (8 * c) * 33 + n;
        v4u o; o.x = pk2(s[0 * 33], s[1 * 33]); o.y = pk2(s[2 * 33], s[3 * 33]); o.z = pk2(s[4 * 33], s[5 * 33]); o.w = pk2(s[6 * 33], s[7 * 33]);
        *(v4u*)(WT + (size_t)(n0 + n) * K + k0 + 8 * c) = o; }
    LDS_WAIT(); asm volatile("" ::: "memory");
}
template <class SRC> DI void tr_item(const SRC& src, int K, int N, bf16* WT, LAS float* scr, int item, int lane) { float tv[32]; tr_load(src, N, item, lane, tv); tr_store(tv, K, N, WT, scr, item, lane); }
template <class SRC> DI void tr_matrix(const SRC& src, int K, int N, bf16* WT, LAS float* scr, int first, int stride, int count, int lane) {
    if (first >= count) return;
    float cur[32], nxt[32]; tr_load(src, N, first, lane, cur);
    for (int it = first; it < count; it += stride) {
        const bool more = it + stride < count;
        if (more) tr_load(src, N, it + stride, lane, nxt);
        tr_store(cur, K, N, WT, scr, it, lane);
        if (more) {
#pragma unroll
            for (int i = 0; i < 32; ++i) cur[i] = nxt[i]; }
    }
}
struct SrcPlain { const float* W; int N; DI float operator()(int k, int n) const { return W[(size_t)k * N + n]; } };
struct SrcGain { const float* W; int N; const float* g; DI float operator()(int k, int n) const { return W[(size_t)k * N + n] * g[k]; } };
struct SrcWie { const float* W; const float* g; DI float operator()(int k, int n) const {
    int c; if (n < 1280) c = n; else if (n < 3072) c = n + 24; else if (n < 3096) c = n - 3072 + 1280; else c = -1;
    return c < 0 ? 0.f : W[(size_t)k * NE_ORIG + c] * g[k]; } };
struct SrcUp { const float* W; const float* g; DI float operator()(int k, int n) const {
    const int c = ((n >> 7) & 1) * DFF + (n >> 8) * 128 + (n & 127); return W[(size_t)k * NUP + c] * g[k]; } };
struct SrcPhi { const float* W; DI float operator()(int k, int n) const {
    const int kv = n >> 8, r = (n >> 7) & 1, e = n & 127; return W[(size_t)kv * 262144 + (size_t)r * 131072 + (size_t)k * 128 + e]; } };
struct SrcLora { const float *w2, *a2, *g2; DI float operator()(int k, int n) const {
    const int seg = n >> 9, c = n & 511;
    if (seg == 0) return k < 64 ? w2[k * 512 + c] : 0.f;
    if (seg == 1) return (k >= 64 && k < 128) ? a2[(k - 64) * 512 + c] : 0.f;
    return k >= 128 ? g2[(k - 128) * 512 + c] : 0.f; } };

DI void row_to_bf16_ssq(const float* xrow, bf16* orow, unsigned long long* ssq, int lane) {
    const f32x4* xr = (const f32x4*)xrow + lane;
    f32x4 v[4]; float s = 0.f;
#pragma unroll
    for (int j = 0; j < 4; ++j) { v[j] = xr[64 * j]; s += (v[j].x * v[j].x + v[j].y * v[j].y) + (v[j].z * v[j].z + v[j].w * v[j].w); }
    s = wave_sum(s);
    v2u* o8 = (v2u*)orow + lane;
#pragma unroll
    for (int j = 0; j < 4; ++j) { v2u o; o.x = pk2(v[j].x, v[j].y); o.y = pk2(v[j].z, v[j].w); o8[64 * j] = o; }
    if (lane == 0) *ssq = (unsigned long long)(s * SSQ_SCALE + 0.5f);
}
DI const float* xin_row(Frame& F, int row) { return row < MP ? KIN(I_XP) + (size_t)row * DM : KIN(I_XS) + (size_t)(row - MP) * DM; }

DI void p0_prologue(Frame& F) {
    LAS float* scr = (LAS float*)(F.lds + RING_OFF + F.wave * 16384);
    const int gw = F.bid * NWAVES + F.wave, NGW = F.G * NWAVES, lane = F.lane;
    constexpr int I_WIE = 16 * (NE / 32), I_SQ = 16 * 32, I_WIO = 16 * (NO / 32), I_UP = 16 * (NUP / 32), I_DN = (DFF / 64) * 32, I_PHI = 16 * 16, I_LORA = 4 * (NLORA / 32);
    int rot = 0;
#define TR_MAT(srcexpr, K_, N_, dst, cnt) do { auto s_ = srcexpr; const int f_ = (gw + NGW - (rot % NGW)) % NGW; tr_matrix(s_, K_, N_, dst, scr, f_, NGW, cnt, lane); rot += (cnt); } while (0)
    for (int li = 0; li < 2; ++li) TR_MAT((SrcWie{KIN(I_WINE) + (size_t)li * DM * NE_ORIG, KIN(I_NMIX) + (2 * li) * DM}), DM, NE, WSP(bf16, WS_WIE) + (size_t)li * NE * DM, I_WIE);
    for (int li = 0; li < 2; ++li) TR_MAT((SrcPlain{KIN(I_WOUTE) + (size_t)li * DM * DM, DM}), DM, DM, WSP(bf16, WS_WOE) + (size_t)li * DM * DM, I_SQ);
    for (int li = 0; li < 2; ++li) TR_MAT((SrcGain{KIN(I_WINO) + (size_t)li * DM * NO, NO, KIN(I_NMIX) + (2 * li + 1) * DM}), DM, NO, WSP(bf16, WS_WIO) + (size_t)li * NO * DM, I_WIO);
    for (int li = 0; li < 2; ++li) TR_MAT((SrcPlain{KIN(I_WOUTO) + (size_t)li * DM * DM, DM}), DM, DM, WSP(bf16, WS_WOO) + (size_t)li * DM * DM, I_SQ);
    for (int l = 0; l < 4; ++l) TR_MAT((SrcUp{KIN(I_FUP) + (size_t)l * DM * NUP, KIN(I_NFFN) + l * DM}), DM, NUP, WSP(bf16, WS_WUP) + (size_t)l * NUP * DM, I_UP);
    for (int l = 0; l < 4; ++l) TR_MAT((SrcPlain{KIN(I_FDOWN) + (size_t)l * DFF * DM, DM}), DFF, DM, WSP(bf16, WS_WDN) + (size_t)l * DM * DFF, I_DN);
    for (int li = 0; li < 2; ++li) TR_MAT((SrcPhi{KIN(I_PW1) + (size_t)li * 2 * 262144}), 1024, 512, WSP(bf16, WS_PHI1) + (size_t)li * 512 * 1024, I_PHI);
    for (int li = 0; li < 2; ++li) TR_MAT((SrcLora{KIN(I_W2) + (size_t)li * 64 * 512, KIN(I_A2) + (size_t)li * 64 * 512, KIN(I_G2) + (size_t)li * 128 * 512}), KLORA, NLORA, WSP(bf16, WS_LORA) + (size_t)li * NLORA * KLORA, I_LORA);
#undef TR_MAT
    if (F.wave == NWAVES - 1 && F.bid < 256) { const int q = F.bid, jc = q >> 3, lk = (q >> 1) & 3, e = (q & 1) * 64 + lane; const float* pe = KIN(I_PPE) + (size_t)lk * 2048 + jc * 64; const float* w1 = KIN(I_PW1) + (size_t)lk * 262144 + (size_t)jc * 64 * 128;
        float a = 0.f;
#pragma unroll 16
        for (int jd = 0; jd < 64; ++jd) a += pe[jd] * w1[(size_t)jd * 128 + e];
        WSP(float, WS_PECP)[(jc * 4 + lk) * 128 + e] = a; }
    for (int m = gw; m < MT; m += NGW) row_to_bf16_ssq(xin_row(F, m), WSP(bf16, WS_XN) + (size_t)m * DM, SSQP(0) + m, lane);
}

DI void store8f(float* p, const float (&v)[8]) { *(f32x4*)p = (f32x4){v[0], v[1], v[2], v[3]}; *(f32x4*)(p + 4) = (f32x4){v[4], v[5], v[6], v[7]}; }
DI void ld8bf(const bf16* p, float (&v)[8]) { const v4u w = *(const v4u*)p; v[0] = bflo(w.x); v[1] = bfhi(w.x); v[2] = bflo(w.y); v[3] = bfhi(w.y); v[4] = bflo(w.z); v[5] = bfhi(w.z); v[6] = bflo(w.w); v[7] = bfhi(w.w); }
DI void ld8f(const float* p, float (&v)[8]) { const f32x4 a = *(const f32x4*)p, b = *(const f32x4*)(p + 4); v[0] = a.x; v[1] = a.y; v[2] = a.z; v[3] = a.w; v[4] = b.x; v[5] = b.y; v[6] = b.z; v[7] = b.w; }

struct RowRawA { v4u q; v2u kv[3]; unsigned gate; unsigned long long sq; };
struct RowRawB { v4u z[4]; unsigned long long sq; };
DI RowRawA load_row_a(const bf16* zr, const unsigned long long* sq, int lane) { RowRawA r; r.sq = *sq; r.q = *(const v4u*)(zr + lane * 8);
#pragma unroll
    for (int c = 0; c < 3; ++c) r.kv[c] = *(const v2u*)(zr + 512 + c * 256 + lane * 4);
    r.gate = zr[3072 + lane]; return r; }
DI RowRawB load_row_b(const bf16* zr, const unsigned long long* sq, int lane) { RowRawB r; r.sq = *sq;
#pragma unroll
    for (int p = 0; p < 4; ++p) r.z[p] = *(const v4u*)(zr + 1280 + p * 512 + lane * 8);
    return r; }
DI void unpk8(const v4u w, float (&v)[8]) { v[0] = bflo(w.x); v[1] = bfhi(w.x); v[2] = bflo(w.y); v[3] = bfhi(w.y); v[4] = bflo(w.z); v[5] = bfhi(w.z); v[6] = bflo(w.w); v[7] = bfhi(w.w); }
DI void post_even_run(Frame& F, int li, int l, bool samp, int b, int tbase, int row0, int ntok) {
    const int lane = F.lane;
    LAS bf16* vts = (LAS bf16*)(F.lds + RING_OFF);
    LAS bf16* vtw = vts + 2 * 64 * 66;
    const bf16* ZB = WSP(bf16, WS_ZB);
    float kn1[4], kn2[4];
    { const f32x4 a = *(const f32x4*)(KIN(I_KN) + (li * 3 + 1) * 64 + (lane & 15) * 4), c = *(const f32x4*)(KIN(I_KN) + (li * 3 + 2) * 64 + (lane & 15) * 4);
      kn1[0] = a.x; kn1[1] = a.y; kn1[2] = a.z; kn1[3] = a.w; kn2[0] = c.x; kn2[1] = c.y; kn2[2] = c.z; kn2[3] = c.w; }
    const unsigned long long* ssq = SSQP(2 * l);
    float qg[8]; ld8f(KIN(I_QN) + li * 64 + (lane & 7) * 8, qg);
    RowRawA nx = load_row_a(ZB + (size_t)row0 * NE, ssq + row0, lane);
    for (int i8 = 0; i8 < ntok; ++i8) {
        const int t = tbase + i8, row = row0 + i8;
        const RowRawA cu = nx;
        if (i8 < ntok - 1) nx = load_row_a(ZB + (size_t)(row + 1) * NE, ssq + row + 1, lane);
        const float rin = __builtin_amdgcn_rsqf((float)cu.sq * (1.f / (SSQ_SCALE * DM)) + RMS_EPS);
        { float x[8]; unpk8(cu.q, x); float ss = 0.f;
#pragma unroll
          for (int i = 0; i < 8; ++i) x[i] *= rin;
#pragma unroll
          for (int i = 0; i < 8; ++i) ss += x[i] * x[i];
          ss = sum8(ss); const float rinv = 1.0f / sqrtf(ss * (1.f / 64.f) + RMS_EPS);
          v4u o; o.x = pk2(x[0] * rinv * qg[0], x[1] * rinv * qg[1]); o.y = pk2(x[2] * rinv * qg[2], x[3] * rinv * qg[3]); o.z = pk2(x[4] * rinv * qg[4], x[5] * rinv * qg[5]); o.w = pk2(x[6] * rinv * qg[6], x[7] * rinv * qg[7]);
          *(v4u*)(WSP(bf16, WS_QB) + (size_t)row * 512 + lane * 8) = o; }
#pragma unroll
        for (int c = 0; c < 3; ++c) {
            const v2u wv = cu.kv[c];
            float x[4] = {bflo(wv.x) * rin, bfhi(wv.x) * rin, bflo(wv.y) * rin, bfhi(wv.y) * rin};
            const int g = (lane >> 4) & 1, dd = (lane & 15) * 4; const bool isv = lane >= 32;
            if (c > 0) { float ss = (x[0] * x[0] + x[1] * x[1]) + (x[2] * x[2] + x[3] * x[3]); ss = sum16(ss);
                if (!isv) { const float rinv = 1.0f / sqrtf(ss * (1.f / 64.f) + RMS_EPS);
#pragma unroll
                    for (int i = 0; i < 4; ++i) x[i] = x[i] * rinv * (c == 1 ? kn1[i] : kn2[i]); } }
            float* op = nullptr;
            if (c == 0) op = OUTF + (samp ? O_CMPS + ((size_t)(b * 2 + li) * DT + t) * 256 : O_CMPP + ((size_t)(b * 2 + li) * SEQ + t) * 256);
            else if (c == 1) op = OUTF + (samp ? O_SLCS + ((size_t)(b * 2 + li) * DT + t) * 256 : O_SLCP + ((size_t)(b * 2 + li) * SEQ + t) * 256);
            else { if (samp) op = OUTF + O_WINS + ((size_t)(b * 2 + li) * WIN + (WIN - DT) + t) * 256; else if (t >= SEQ - WIN) op = OUTF + O_WINP + ((size_t)(b * 2 + li) * WIN + (t - (SEQ - WIN))) * 256; }
            if (op) *(f32x4*)(op + lane * 4) = (f32x4){x[0], x[1], x[2], x[3]};
            if (!samp) {
                v2u pk; pk.x = pk2(x[0], x[1]); pk.y = pk2(x[2], x[3]);
                if (c == 0) { const int rw = (isv ? CS_PV : CS_PK) + (b * 2 + g) * 128 + (t >> 4);
                    *(v2u*)(WSP(bf16, WS_CSEG) + (size_t)rw * 1024 + (t & 15) * 64 + dd) = pk; }
                else if (!isv) { *(v2u*)(WSP(bf16, c == 1 ? WS_KS : WS_KW) + ((size_t)(b * 2 + g) * SEQ + t) * 64 + dd) = pk; }
                else { LAS bf16* vt = (c == 1 ? vts : vtw) + (g * 64 + dd) * 66 + (t & 63);
                    vt[0] = (bf16)(pk.x & 0xffffu); vt[66] = (bf16)(pk.x >> 16); vt[132] = (bf16)(pk.y & 0xffffu); vt[198] = (bf16)(pk.y >> 16); }
            }
        }
        if (lane < 24) WSP(float, WS_GATE)[(size_t)row * 32 + lane] = sigmoidf_(bf2f(cu.gate) * rin);
    }
    float zp[4][8];
#pragma unroll
    for (int p = 0; p < 4; ++p) {
        const bool act = (p < 3 || lane < 32);
        if (!act) { for (int i = 0; i < 8; ++i) zp[p][i] = 0.f; }
        else if (tbase == 0) { if (samp) ld8f(KIN(I_SSHIFT) + (size_t)(b * 2 + li) * RWP + p * 512 + lane * 8, zp[p]); else { for (int i = 0; i < 8; ++i) zp[p][i] = 0.f; } }
        else { ld8bf(ZB + (size_t)(row0 - 1) * NE + 1280 + p * 512 + lane * 8, zp[p]); const float rp = rinv_of(ssq, row0 - 1);
#pragma unroll
            for (int i = 0; i < 8; ++i) zp[p][i] *= rp; }
    }
    float mu[4][8], kkw[8]; ld8f(KIN(I_KKW) + li * 512 + lane * 8, kkw);
#pragma unroll
    for (int p = 0; p < 4; ++p) { if (p < 3 || lane < 32) ld8f(KIN(I_MU) + li * RWP + p * 512 + lane * 8, mu[p]); else { for (int i = 0; i < 8; ++i) mu[p][i] = 0.f; } }
    RowRawB nb = load_row_b(ZB + (size_t)row0 * NE, ssq + row0, lane);
    for (int i8 = 0; i8 < ntok; ++i8) {
        const int t = tbase + i8, row = row0 + i8;
        const RowRawB cu = nb;
        if (i8 < ntok - 1) nb = load_row_b(ZB + (size_t)(row + 1) * NE, ssq + row + 1, lane);
        const float rin = __builtin_amdgcn_rsqf((float)cu.sq * (1.f / (SSQ_SCALE * DM)) + RMS_EPS);
        const bool lastt = samp ? (t == DT - 1) : (t == SEQ - 1);
#pragma unroll
        for (int p = 0; p < 4; ++p) {
            if (p < 3 || lane < 32) {
                float z[8], zz[8]; unpk8(cu.z[p], z);
#pragma unroll
                for (int i = 0; i < 8; ++i) z[i] *= rin;

#pragma unroll
                for (int i = 0; i < 8; ++i) { zz[i] = z[i] + (zp[p][i] - z[i]) * mu[p][i]; zp[p][i] = z[i]; }
                if (lastt) store8f(OUTF + (samp ? O_SHS : O_SHP) + (size_t)(b * 2 + li) * RWP + p * 512 + lane * 8, z);
                const int h = lane >> 3, d = (lane & 7) * 8;
                unsigned char* scb = (unsigned char*)SCREC(row, h) + d * 2;
                v4u zb; zb.x = pk2(zz[0], zz[1]); zb.y = pk2(zz[2], zz[3]); zb.z = pk2(zz[4], zz[5]); zb.w = pk2(zz[6], zz[7]);
                if (p == 0) *(v4u*)(scb + SCR_R) = zb;
                else if (p == 2) *(v4u*)(scb + SCR_V) = zb;
                else if (p == 1) { *(v4u*)(scb + SCR_K) = zb; float kk[8]; float ss = 0.f;
#pragma unroll
                    for (int i = 0; i < 8; ++i) { kk[i] = zz[i] * kkw[i]; ss += kk[i] * kk[i]; }
                    ss = sum8(ss); const float rinv = 1.0f / sqrtf(fmaxf(ss, 1e-24f));
#pragma unroll
                    for (int i = 0; i < 8; ++i) kk[i] *= rinv;
                    v4u kb; kb.x = pk2(kk[0], kk[1]); kb.y = pk2(kk[2], kk[3]); kb.z = pk2(kk[4], kk[5]); kb.w = pk2(kk[6], kk[7]); *(v4u*)(scb + SCR_KK) = kb; }
                else { float o[8];
#pragma unroll
                    for (int i = 0; i < 8; ++i) o[i] = lane < 8 ? tanhf_(zz[i]) : (lane < 16 ? zz[i] : sigmoidf_(zz[i]));
                    v4u pk; pk.x = pk2(o[0], o[1]); pk.y = pk2(o[2], o[3]); pk.z = pk2(o[4], o[5]); pk.w = pk2(o[6], o[7]);
                    *(v4u*)(WSP(bf16, WS_LA) + (size_t)row * 256 + lane * 8) = pk; }
            }
        }
    }
}
DI void post_even_tile(Frame& F, int tt, int li, int l) {
    const int w = F.wave, b = tt >> 5, blk = tt & 31;
    post_even_run(F, li, l, false, b, blk * 64 + 8 * w, b * SEQ + blk * 64 + 8 * w, 8);
    if (w < 4) { const int st = tt * 4 + w; post_even_run(F, li, l, true, st >> 3, st & 7, MP + st, 1); }
    LAS bf16* vts = (LAS bf16*)(F.lds + RING_OFF); LAS bf16* vtw = vts + 2 * 64 * 66;
    {
        __syncthreads();
#pragma unroll
        for (int a = 0; a < 2; ++a) { const LAS bf16* vt = a ? vtw : vts; const int ri = F.tid >> 2, q4 = F.tid & 3;
            const LAS unsigned* s = (const LAS unsigned*)(vt + ri * 66 + q4 * 16);
            v4u o0, o1; o0.x = s[0]; o0.y = s[1]; o0.z = s[2]; o0.w = s[3]; o1.x = s[4]; o1.y = s[5]; o1.z = s[6]; o1.w = s[7];
            bf16* dst = WSP(bf16, a ? WS_VWT : WS_VST) + (((size_t)(b * 2 + (ri >> 6)) * 32 + blk) * 64 + (ri & 63)) * 64 + q4 * 16;
            *(v4u*)dst = o0; *(v4u*)(dst + 8) = o1; }
        __syncthreads();
    }
}
DI void cseg_page_load(Frame& F, int u, int li, f32x4 (&v)[8][2]) {
    const int b = u >> 4, p = u & 15; const int pg = ((const int*)KIN(I_PT))[b * NPAGE + p];
    const float* src = KIN(I_CCMP) + ((size_t)pg * 2 + li) * (PAGE * 256);
#pragma unroll
    for (int k = 0; k < 8; ++k) { const int q = k * NTHREADS + F.tid; const f32x4* sp = (const f32x4*)(src + (size_t)(q >> 5) * 256 + (q & 31) * 8);
        v[k][0] = __builtin_nontemporal_load(sp); v[k][1] = __builtin_nontemporal_load(sp + 1); }
}
DI void cseg_page_store(Frame& F, int u, const f32x4 (&v)[8][2]) {
    const int b = u >> 4, p = u & 15; bf16* CS = WSP(bf16, WS_CSEG);
#pragma unroll
    for (int k = 0; k < 8; ++k) { const int q = k * NTHREADS + F.tid; const int r = q >> 5, c = q & 31;
        const int kv = c >> 4, g = (c >> 3) & 1, d0 = (c & 7) * 8;
        v4u o; o.x = pk2(v[k][0].x, v[k][0].y); o.y = pk2(v[k][0].z, v[k][0].w); o.z = pk2(v[k][1].x, v[k][1].y); o.w = pk2(v[k][1].z, v[k][1].w);
        *(v4u*)(CS + ((size_t)((kv ? CS_SV : CS_SK) + (b * 2 + g) * 128 + p * 8 + (r >> 4))) * 1024 + (r & 15) * 64 + d0) = o; }
}
DI void cseg_page_unit(Frame& F, int u, int li) { f32x4 v[8][2]; cseg_page_load(F, u, li, v); cseg_page_store(F, u, v); }
DI void win_copy_unit(Frame& F, int u, int li) {
    const int b = u / 9, q = u % 9;
    const f32x4* src = (const f32x4*)(KIN(I_CWIN) + ((size_t)(b * 2 + li) * WIN + DT + q * 56) * 256) + F.tid;
    f32x4* dst = (f32x4*)(OUTF + O_WINS + ((size_t)(b * 2 + li) * WIN + q * 56) * 256) + F.tid;
    f32x4 v[7];
#pragma unroll
    for (int k = 0; k < 7; ++k) v[k] = __builtin_nontemporal_load(src + k * NTHREADS);
#pragma unroll
    for (int k = 0; k < 7; ++k) __builtin_nontemporal_store(v[k], dst + k * NTHREADS);
}
DI void bg_units(Frame& F, int li, int max_tickets) {
    constexpr int NTK = (DB * NPAGE + DB * 9) / 4;
    volatile LAS unsigned* tk = F.MISC + 17;
    for (int n = 0; n < max_tickets; ++n) {
        __syncthreads();
        if (F.tid == 0) tk[0] = __hip_atomic_fetch_add((unsigned*)(F.ctl + CW_QUEUE + 16 + 32 * li), 1u, RLX_AGENT);
        __syncthreads();
        const int t4 = __builtin_amdgcn_readfirstlane((int)tk[0]);
        if (t4 >= NTK) break;
#pragma unroll 1
        for (int k = 0; k < 4; ++k) { LAUNDER(F); const int u = t4 * 4 + k; if (u < DB * NPAGE) cseg_page_unit(F, u, li); else win_copy_unit(F, u - DB * NPAGE, li); }
    }
}
DI void post_even_phase(Frame& F, int li, int l) {
    for (int u = F.bid; u < 256; u += F.G) post_even_tile(F, u, li, l);
    bg_units(F, li, 1 << 30);
}

DI float gelu_tanh(float x) { const float u = 0.7978845608028654f * (x + 0.044715f * x * x * x); return 0.5f * x * (1.0f + tanhf_(u)); }
DI void compress2_stage_w2(Frame& F, int li) {
    LAS bf16* w2t = (LAS bf16*)(F.lds + RING_OFF);
    const float* w2 = KIN(I_PW2) + (size_t)li * 2 * 128 * 64;
    for (int i = F.tid; i < 2 * 128 * 64; i += NTHREADS) { const int kv = i >> 13, e = (i >> 6) & 127, d = i & 63; w2t[(kv * 64 + d) * 136 + e] = (bf16)(pk2(w2[i], 0.f) & 0xffffu); }
    if (F.tid < 256) { float a = 0.f; const float* pp = WSP(float, WS_PECP) + li * 256 + F.tid;
#pragma unroll 8
        for (int jc = 0; jc < 32; ++jc) a += pp[jc * 512];
        ((LAS float*)(F.lds + RING_OFF + 36864))[F.tid] = a; }
    __syncthreads();
}
DI void compress2_unit(Frame& F, int cu, int li) {
    const int w = F.wave, lane = F.lane, kl = lane & 31, h = lane >> 5, kv = w >> 2, n = (w & 3) * 32 + kl;
    const LAS bf16* w2t = (const LAS bf16*)(F.lds + RING_OFF) + kv * 64 * 136;
    const bool prm = cu >= 256; const int bg = prm ? cu - 256 : cu;
    const size_t rb = (size_t)(prm ? (kv ? CS_PV : CS_PK) : (kv ? CS_SV : CS_SK)) + (size_t)bg * 128;
    const float* p0 = WSP(float, WS_PART) + (rb + n) * 256 + 8 * h; const float* p1 = p0 + 256 + 128; const LAS float* pec = (const LAS float*)(F.lds + RING_OFF + 36864) + kv * 128 + 8 * h;
    f32x16 C[2];
#pragma unroll
    for (int i = 0; i < 16; ++i) { C[0][i] = 0.f; C[1][i] = 0.f; }
#pragma unroll
    for (int ks = 0; ks < 8; ++ks) {
        float x0[8], x1[8], pc[8]; ld8f(p0 + 16 * ks, x0); ld8f(p1 + 16 * ks, x1);
#pragma unroll
        for (int j = 0; j < 8; ++j) pc[j] = pec[16 * ks + j];
        v4u bv; bv.x = pk2(gelu_tanh(pc[0] + x0[0] + x1[0]), gelu_tanh(pc[1] + x0[1] + x1[1])); bv.y = pk2(gelu_tanh(pc[2] + x0[2] + x1[2]), gelu_tanh(pc[3] + x0[3] + x1[3]));
        bv.z = pk2(gelu_tanh(pc[4] + x0[4] + x1[4]), gelu_tanh(pc[5] + x0[5] + x1[5])); bv.w = pk2(gelu_tanh(pc[6] + x0[6] + x1[6]), gelu_tanh(pc[7] + x0[7] + x1[7]));
        const bf16x8 bf = __builtin_bit_cast(bf16x8, bv);
#pragma unroll
        for (int dt = 0; dt < 2; ++dt) { const bf16x8 a = *(const LAS bf16x8*)(w2t + (dt * 32 + kl) * 136 + 16 * ks + 8 * h); C[dt] = MFMA32(a, bf, C[dt]); }
    }
    const bool valid = n < NCMP;
    if (kv == 0) {
        float ss = 0.f;
#pragma unroll
        for (int dt = 0; dt < 2; ++dt)
#pragma unroll
            for (int i = 0; i < 16; ++i) ss += C[dt][i] * C[dt][i];
        ss += __shfl_xor(ss, 32);
        const float rinv = valid ? 1.0f / sqrtf(ss * (1.f / 64.f) + RMS_EPS) : 0.f;
        bf16* KC = WSP(bf16, WS_KC) + (size_t)cu * 8192 + n * 64; const float* kn = KIN(I_KN) + (li * 3 + 0) * 64;
#pragma unroll
        for (int dt = 0; dt < 2; ++dt)
#pragma unroll
            for (int a = 0; a < 4; ++a) { const int d0 = dt * 32 + 8 * a + 4 * h; const f32x4 g = *(const f32x4*)(kn + d0);
                v2u o; o.x = pk2(C[dt][4 * a] * rinv * g.x, C[dt][4 * a + 1] * rinv * g.y); o.y = pk2(C[dt][4 * a + 2] * rinv * g.z, C[dt][4 * a + 3] * rinv * g.w); if (!valid) { o.x = 0u; o.y = 0u; } *(v2u*)(KC + d0) = o; }
    } else {
        bf16* VCT = WSP(bf16, WS_VCT) + (size_t)cu * 8192 + n;
#pragma unroll
        for (int dt = 0; dt < 2; ++dt)
#pragma unroll
            for (int i = 0; i < 16; ++i) VCT[(dt * 32 + crow(i, h)) * 128] = (bf16)(pk2(valid ? C[dt][i] : 0.f, 0.f) & 0xffffu);
    }
}
DI void compress2_phase(Frame& F, int li) { compress2_stage_w2(F, li); for (int u = F.bid; u < 272; u += F.G) compress2_unit(F, u, li); __syncthreads(); }

DI void odd_mix_phase(Frame& F, int li, int l) {
    const unsigned long long* ssq = SSQP(2 * l);
    const bf16* ZB = WSP(bf16, WS_ZB); bf16* MIX = WSP(bf16, WS_MIX);
    const float* cw = KIN(I_CONVW) + (size_t)li * 3 * DM;
    constexpr int NCG = DM / 8, NRUN = MT / 8;
    for (int it = F.bid * NTHREADS + F.tid; it < NRUN * NCG; it += F.G * NTHREADS) {
        const int run = it / NCG, ch = (it % NCG) * 8;
        const bool samp = run >= MP / 8; const int b = samp ? run - MP / 8 : run >> 8, t0 = samp ? 0 : (run & 255) * 8, row0 = run * 8;
        v4u rb[8], rc[10], rx[10]; unsigned long long sq[10];
        const bool halo = t0 != 0;
#pragma unroll
        for (int j = 0; j < 10; ++j) { const int rr = halo ? row0 - 2 + j : (j < 2 ? row0 : row0 - 2 + j); const bf16* zr = ZB + (size_t)rr * NO;
            rc[j] = *(const v4u*)(zr + DM + ch); rx[j] = *(const v4u*)(zr + 2 * DM + ch); sq[j] = ssq[rr]; if (j >= 2) rb[j - 2] = *(const v4u*)(zr + ch); }
        float w0[8], w1[8], w2[8], p2[8], p1[8];
        ld8f(cw + ch, w0); ld8f(cw + DM + ch, w1); ld8f(cw + 2 * DM + ch, w2);
        if (!halo) { if (samp) { ld8f(KIN(I_SCONV) + ((size_t)(b * 2 + li) * 2 + 0) * DM + ch, p2); ld8f(KIN(I_SCONV) + ((size_t)(b * 2 + li) * 2 + 1) * DM + ch, p1); }
                     else { for (int i = 0; i < 8; ++i) { p2[i] = 0.f; p1[i] = 0.f; } } }
        else { float a[8], c[8]; float rr = __builtin_amdgcn_rsqf((float)sq[0] * (1.f / (SSQ_SCALE * DM)) + RMS_EPS); rr *= rr; unpk8(rc[0], a); unpk8(rx[0], c); for (int i = 0; i < 8; ++i) p2[i] = a[i] * c[i] * rr;
               rr = __builtin_amdgcn_rsqf((float)sq[1] * (1.f / (SSQ_SCALE * DM)) + RMS_EPS); rr *= rr; unpk8(rc[1], a); unpk8(rx[1], c); for (int i = 0; i < 8; ++i) p1[i] = a[i] * c[i] * rr; }
#pragma unroll
        for (int j = 0; j < 8; ++j) {
            float bgv[8], cg[8], xi[8], p[8], o[8]; unpk8(rb[j], bgv); unpk8(rc[j + 2], cg); unpk8(rx[j + 2], xi);
            const float rin = __builtin_amdgcn_rsqf((float)sq[j + 2] * (1.f / (SSQ_SCALE * DM)) + RMS_EPS), rin2 = rin * rin;
#pragma unroll
            for (int i = 0; i < 8; ++i) { p[i] = cg[i] * xi[i] * rin2; o[i] = bgv[i] * rin * (w0[i] * p2[i] + w1[i] * p1[i] + w2[i] * p[i]); p2[i] = p1[i]; p1[i] = p[i]; }
            v4u pk; pk.x = pk2(o[0], o[1]); pk.y = pk2(o[2], o[3]); pk.z = pk2(o[4], o[5]); pk.w = pk2(o[6], o[7]);
            *(v4u*)(MIX + (size_t)(row0 + j) * DM + ch) = pk;
            const int t = t0 + j; const int tl = samp ? DT : SEQ;
            if (t >= tl - 2) store8f(OUTF + (samp ? O_CVS : O_CVP) + ((size_t)(b * 2 + li) * 2 + (t - (tl - 2))) * DM + ch, p);
        }
    }
}
DI void ffn_act_phase(Frame& F, int l) {
    const unsigned long long* ssq = SSQP(2 * l + 1);
    const bf16* AU = WSP(bf16, WS_ZB); bf16* H = WSP(bf16, WS_H);
    const float* cw = KIN(I_FCONV) + (size_t)l * 3 * DFF;
    constexpr int NCG = DFF / 8, NRUN = MT / 8;
    for (int it = F.bid * NTHREADS + F.tid; it < NRUN * NCG; it += F.G * NTHREADS) {
        const int run = it / NCG, ch = (it % NCG) * 8;
        const bool samp = run >= MP / 8; const int b = samp ? run - MP / 8 : run >> 8, t0 = samp ? 0 : (run & 255) * 8, row0 = run * 8;
        float w0[8], w1[8], w2[8], a2[8], a1[8];
        ld8f(cw + ch, w0); ld8f(cw + DFF + ch, w1); ld8f(cw + 2 * DFF + ch, w2);
        if (t0 == 0) { if (samp) { ld8f(KIN(I_SFFN) + ((size_t)(b * 4 + l) * 2 + 0) * DFF + ch, a2); ld8f(KIN(I_SFFN) + ((size_t)(b * 4 + l) * 2 + 1) * DFF + ch, a1); }
                       else { for (int i = 0; i < 8; ++i) { a2[i] = 0.f; a1[i] = 0.f; } } }
        else { ld8bf(AU + (size_t)(row0 - 2) * NUP + ch, a2); ld8bf(AU + (size_t)(row0 - 1) * NUP + ch, a1); const float r2 = rinv_of(ssq, row0 - 2), r1 = rinv_of(ssq, row0 - 1); for (int i = 0; i < 8; ++i) { a2[i] *= r2; a1[i] *= r1; } }
#pragma unroll
        for (int j = 0; j < 8; ++j) {
            const bf16* zr = AU + (size_t)(row0 + j) * NUP; float a[8], uu[8], o[8];
            ld8bf(zr + ch, a); ld8bf(zr + DFF + ch, uu);
            const float rin = rinv_of(ssq, row0 + j);
#pragma unroll
            for (int i = 0; i < 8; ++i) { a[i] *= rin; const float y = w0[i] * a2[i] + w1[i] * a1[i] + w2[i] * a[i]; o[i] = y * sigmoidf_(y) * uu[i] * rin; a2[i] = a1[i]; a1[i] = a[i]; }
            v4u pk; pk.x = pk2(o[0], o[1]); pk.y = pk2(o[2], o[3]); pk.z = pk2(o[4], o[5]); pk.w = pk2(o[6], o[7]);
            *(v4u*)(H + (size_t)(row0 + j) * DFF + ch) = pk;
            const int t = t0 + j; const int tl = samp ? DT : SEQ;
            if (t >= tl - 2) store8f(OUTF + (samp ? O_FFS : O_FFP) + ((size_t)(b * 4 + l) * 2 + (t - (tl - 2))) * DFF + ch, a);
        }
    }
}

DI int rel_bucket(int d) {
    if (d < 16) return d;
    int bkt = 16;
    bkt += (d >= 19) + (d >= 21) + (d >= 24) + (d >= 27) + (d >= 31) + (d >= 35) + (d >= 40) + (d >= 46) + (d >= 52) + (d >= 59) + (d >= 67) + (d >= 77) + (d >= 87) + (d >= 99) + (d >= 113);
    return bkt;
}
DI void fill_bias_table(Frame& F, LAS float* biasT, int g) {
    const int hq = F.tid >> 7, d = F.tid & 127;
    biasT[F.tid] = KIN(I_RELB)[rel_bucket(d) * 8 + g * 4 + hq] * LOG2E;
}
DI bf16x8 pack_p(const f32x16& p, int s) {
    v4u r; r.x = pk2(p[8 * s + 0], p[8 * s + 1]); r.y = pk2(p[8 * s + 2], p[8 * s + 3]); r.z = pk2(p[8 * s + 4], p[8 * s + 5]); r.w = pk2(p[8 * s + 6], p[8 * s + 7]);
    return __builtin_bit_cast(bf16x8, r);
}
DI float xhalf_max(float x) { return fmaxf(x, __shfl_xor(x, 32)); }
DI float xhalf_sum(float x) { return x + __shfl_xor(x, 32); }
constexpr float SC2 = 0.125f * LOG2E;
constexpr float NEG_BIG = -1e30f;

constexpr float SREF = 8.0f;
DI void softmax_pv(f32x16& s, float& l, f32x16 (&O)[2], const bf16x8 (&vf)[2][2]) {
    float ps0 = 0.f, ps1 = 0.f;
#pragma unroll
    for (int i = 0; i < 16; i += 2) { s[i] = fexp2(s[i]); s[i + 1] = fexp2(s[i + 1]); ps0 += s[i]; ps1 += s[i + 1]; }
    l += ps0 + ps1;
    const bf16x8 p0 = pack_p(s, 0), p1 = pack_p(s, 1);
#pragma unroll
    for (int dt = 0; dt < 2; ++dt) { O[dt] = MFMA32(vf[dt][0], p0, O[dt]); O[dt] = MFMA32(vf[dt][1], p1, O[dt]); }
}

DI void cmp_branch(const bf16x8 (&qf)[4], const bf16* kc, const bf16* vct, int t, int ccur, const LAS float* biasT, int lane, LAS float* scr, f32x16 (&Oc)[2], unsigned& selmask) {
    const int kl = lane & 31, h = lane >> 5, hq = kl & 3, tl = kl >> 2;
    f32x16 S[4];
#pragma unroll
    for (int kt = 0; kt < 4; ++kt) {
#pragma unroll
        for (int i = 0; i < 16; ++i) S[kt][i] = 0.f;
#pragma unroll
        for (int ks = 0; ks < 4; ++ks) { const bf16x8 a = *(const bf16x8*)(kc + (32 * kt + kl) * 64 + 16 * ks + 8 * h); S[kt] = MFMA32(a, qf[ks], S[kt]); }
    }
    const int nmax = (t - 31) >> 4;
    float mx = NEG_BIG;
#pragma unroll
    for (int kt = 0; kt < 4; ++kt) {
        float bv[16];
#pragma unroll
        for (int i = 0; i < 16; ++i) { const int n = 32 * kt + crow(i, h); const int dist = t - (16 * n + 31); const int idx = dist < 0 ? 0 : (dist > 127 ? 127 : dist); bv[i] = biasT[hq * 128 + idx]; }
#pragma unroll
        for (int i = 0; i < 16; ++i) { const int n = 32 * kt + crow(i, h); float v = S[kt][i] * SC2 + bv[i]; v = (n <= nmax) ? v : -INFINITY; S[kt][i] = v; mx = fmaxf(mx, v); }
    }
    mx = xhalf_max(mx);
    float sum = 0.f;
#pragma unroll
    for (int kt = 0; kt < 4; ++kt)
#pragma unroll
        for (int i = 0; i < 16; ++i) { const float e = fexp2(S[kt][i] - mx); S[kt][i] = e; sum += e; }
    sum = xhalf_sum(sum);
    const float inv = sum > 0.f ? 1.0f / sum : 0.f;
#pragma unroll
    for (int kt = 0; kt < 4; ++kt) S[kt] = S[kt] * inv;
    f32x16 I;
#pragma unroll
    for (int i = 0; i < 16; ++i) { Oc[0][i] = 0.f; Oc[1][i] = 0.f; I[i] = 0.f; }
#pragma unroll
    for (int kt = 0; kt < 4; ++kt)
#pragma unroll
        for (int st = 0; st < 2; ++st) {
            const bf16x8 ph = pack_p(S[kt], st);
            f32x16 lo = S[kt];
#pragma unroll
            for (int j = 0; j < 8; ++j) { const unsigned short hb = (unsigned short)ph[j]; lo[8 * st + j] = S[kt][8 * st + j] - bf2f(hb); }
            const bf16x8 pl = pack_p(lo, st);
#pragma unroll
            for (int dt = 0; dt < 2; ++dt) { const bf16* vr = vct + (dt * 32 + kl) * 128 + 32 * kt + 16 * st + 4 * h;
                const v2u a0 = *(const v2u*)vr, a1 = *(const v2u*)(vr + 8); v4u av; av.x = a0.x; av.y = a0.y; av.z = a1.x; av.w = a1.y;
                Oc[dt] = MFMA32(__builtin_bit_cast(bf16x8, av), ph, Oc[dt]); }
            bf16x8 ov;
#pragma unroll
            for (int j = 0; j < 8; ++j) { const int n = 32 * kt + 16 * st + 8 * (j >> 2) + 4 * h + (j & 3); ov[j] = (n >= 4 * kl - 1 && n <= 4 * kl + 3) ? (short)0x3F80 : (short)0; }
            I = MFMA32(ov, ph, I); I = MFMA32(ov, pl, I);
        }
#pragma unroll
    for (int i = 0; i < 16; ++i) I[i] = sum4(I[i]);
    if (hq == 0) {
#pragma unroll
        for (int i = 0; i < 16; ++i) { const int sb = crow(i, h); scr[tl * 33 + sb] = (sb >= 1 && sb <= ccur - 2) ? I[i] : -INFINITY; }
    }
    LDS_WAIT(); asm volatile("" ::: "memory");
    float v[32];
#pragma unroll
    for (int s = 0; s < 32; ++s) v[s] = scr[tl * 33 + s];
    const int sub = hq + 4 * h;
    unsigned bits = 0u;
#pragma unroll
    for (int k = 0; k < 4; ++k) { const int sk = 4 * sub + k; const float x = scr[tl * 33 + sk]; int cnt = 0;
#pragma unroll
        for (int s = 0; s < 32; ++s) cnt += (v[s] > x || (v[s] == x && s < sk)) ? 1 : 0;
        if (sk >= 1 && sk <= ccur - 2 && cnt < 13) bits |= 1u << sk; }
    LDS_WAIT(); asm volatile("" ::: "memory");
    bits |= dppu<XOR1>(bits); bits |= dppu<XOR2>(bits); bits |= (unsigned)__shfl_xor((int)bits, 32);
    unsigned forced = 1u;
    if (ccur < 32) forced |= 1u << ccur;
    if (ccur >= 1) forced |= 1u << (ccur - 1);
    selmask = bits | forced;
}

constexpr int KV_PITCH = 72;
constexpr int AT_KBUF = 0, AT_VBUF = 2 * 64 * KV_PITCH * 2, AT_BIAS = 2 * AT_VBUF, AT_SCR = AT_BIAS + 2048, AT_OUT = AT_SCR + 8 * 8 * 33 * 4, AT_END = AT_OUT + 8 * 64 * 32 * 4;
template <int MODE>
DI void prompt_branch(Frame& F, const bf16* Kg, const bf16* Vg, int s_lo, int s_hi, int c, int t, unsigned sel, const bf16x8 (&qf)[4], const LAS float* biasT, float gate, LAS float* outw) {
    const int lane = F.lane, kl = lane & 31, h = lane >> 5, hq = kl & 3;
    LAS bf16* Kb = (LAS bf16*)(F.lds + RING_OFF + AT_KBUF); LAS bf16* Vb = (LAS bf16*)(F.lds + RING_OFF + AT_VBUF);
    const int srow = F.tid >> 3, spc = F.tid & 7;
    f32x16 O[2]; float l = 0.f;
#pragma unroll
    for (int i = 0; i < 16; ++i) { O[0][i] = 0.f; O[1][i] = 0.f; }
    const float bfar = biasT[hq * 128 + 127] - SREF;
    v4u kr = *(const v4u*)(Kg + ((size_t)s_lo * 64 + srow) * 64 + spc * 8), vr = *(const v4u*)(Vg + ((size_t)s_lo * 64 + srow) * 64 + spc * 8);
    *(LAS v4u*)(Kb + srow * KV_PITCH + spc * 8) = kr; *(LAS v4u*)(Vb + srow * KV_PITCH + spc * 8) = vr;
    __syncthreads();
    int buf = 0;
    for (int s = s_lo; s <= s_hi; ++s) {
        if (s < s_hi) { kr = *(const v4u*)(Kg + ((size_t)(s + 1) * 64 + srow) * 64 + spc * 8); vr = *(const v4u*)(Vg + ((size_t)(s + 1) * 64 + srow) * 64 + spc * 8); }
        const bool act = (MODE == 1) ? true : (((sel >> s) & 1u) != 0u);
        if (__any(act)) {
            const LAS bf16* kb = Kb + buf * 64 * KV_PITCH; const LAS bf16* vb = Vb + buf * 64 * KV_PITCH;
            const bool near = s >= c - 2;
#pragma unroll
            for (int kt = 0; kt < 2; ++kt) {
                f32x16 S;
#pragma unroll
                for (int i = 0; i < 16; ++i) S[i] = 0.f;
#pragma unroll
                for (int ks = 0; ks < 4; ++ks) { const bf16x8 a = *(const LAS bf16x8*)(kb + (32 * kt + kl) * KV_PITCH + 16 * ks + 8 * h); S = MFMA32(a, qf[ks], S); }
                bf16x8 vf[2][2];
#pragma unroll
                for (int dt = 0; dt < 2; ++dt)
#pragma unroll
                    for (int st = 0; st < 2; ++st) { const LAS bf16* vp = vb + (dt * 32 + kl) * KV_PITCH + 32 * kt + 16 * st + 4 * h;
                        const v2u a0 = *(const LAS v2u*)vp, a1 = *(const LAS v2u*)(vp + 8); v4u av; av.x = a0.x; av.y = a0.y; av.z = a1.x; av.w = a1.y; vf[dt][st] = __builtin_bit_cast(bf16x8, av); }
                const int key0 = 64 * s + 32 * kt;
                if (near) {
                    float bv[16];
#pragma unroll
                    for (int i = 0; i < 16; ++i) { const int dist = t - (key0 + crow(i, h)); const int idx = dist < 0 ? 0 : (dist > 127 ? 127 : dist); bv[i] = biasT[hq * 128 + idx]; }
#pragma unroll
                    for (int i = 0; i < 16; ++i) { const int dist = t - (key0 + crow(i, h)); const bool ok = act && dist >= 0 && (MODE == 0 || dist < WIN); const float v = S[i] * SC2 + (bv[i] - SREF); S[i] = ok ? v : -INFINITY; }
                } else if (MODE == 1 && s == c - 8) {
#pragma unroll
                    for (int i = 0; i < 16; ++i) { const int dist = t - (key0 + crow(i, h)); const float v = S[i] * SC2 + bfar; S[i] = dist < WIN ? v : -INFINITY; }
                } else {
                    const float addc = act ? bfar : -INFINITY;
#pragma unroll
                    for (int i = 0; i < 16; ++i) S[i] = S[i] * SC2 + addc;
                }
                softmax_pv(S, l, O, vf);
            }
        }
        if (s < s_hi) { *(LAS v4u*)(Kb + (buf ^ 1) * 64 * KV_PITCH + srow * KV_PITCH + spc * 8) = kr; *(LAS v4u*)(Vb + (buf ^ 1) * 64 * KV_PITCH + srow * KV_PITCH + spc * 8) = vr; }
        __syncthreads();
        buf ^= 1;
    }
    l = xhalf_sum(l);
    const float sc = l > 0.f ? gate / l : 0.f;
#pragma unroll
    for (int dt = 0; dt < 2; ++dt)
#pragma unroll
        for (int i = 0; i < 16; ++i) outw[(dt * 32 + crow(i, h)) * 32 + kl] += O[dt][i] * sc;
}
DI void attn_prompt_unit(Frame& F, int b, int g, int c, int li) {
    const int w = F.wave, lane = F.lane, kl = lane & 31, h = lane >> 5, hq = kl & 3, tl = kl >> 2, hd = g * 4 + hq;
    LAS float* biasT = (LAS float*)(F.lds + RING_OFF + AT_BIAS); LAS float* scr = (LAS float*)(F.lds + RING_OFF + AT_SCR) + w * 8 * 33;
    fill_bias_table(F, biasT, g);
    const int t = 64 * c + 8 * w + tl, row = b * SEQ + t;
    bf16x8 qf[4];
#pragma unroll
    for (int ks = 0; ks < 4; ++ks) qf[ks] = *(const bf16x8*)(WSP(bf16, WS_QB) + (size_t)row * 512 + hd * 64 + 16 * ks + 8 * h);
    const float* gp = WSP(float, WS_GATE) + (size_t)row * 32 + hd * 3; const float g0 = gp[0], g1 = gp[1], g2 = gp[2];
    __syncthreads();
    unsigned sel;
    LAS float* outw = (LAS float*)(F.lds + RING_OFF + AT_OUT) + w * 2048;
    { f32x16 Oc[2];
      const int cu = 256 + b * 2 + g;
      cmp_branch(qf, WSP(bf16, WS_KC) + (size_t)cu * 8192, WSP(bf16, WS_VCT) + (size_t)cu * 8192, t, c, biasT, lane, scr, Oc, sel);
#pragma unroll
      for (int dt = 0; dt < 2; ++dt)
#pragma unroll
          for (int i = 0; i < 16; ++i) outw[(dt * 32 + crow(i, h)) * 32 + kl] = Oc[dt][i] * g0; }
    const size_t kvo = (size_t)(b * 2 + g) * SEQ * 64;
    prompt_branch<0>(F, WSP(bf16, WS_KS) + kvo, WSP(bf16, WS_VST) + kvo, 0, c, c, t, sel, qf, biasT, g1, outw);
    prompt_branch<1>(F, WSP(bf16, WS_KW) + kvo, WSP(bf16, WS_VWT) + kvo, c > 8 ? c - 8 : 0, c, c, t, sel, qf, biasT, g2, outw);
    bf16* mix = WSP(bf16, WS_MIX) + (size_t)row * DM + hd * 64;
#pragma unroll
    for (int dt = 0; dt < 2; ++dt)
#pragma unroll
        for (int a = 0; a < 4; ++a) { const LAS float* o4 = outw + (dt * 32 + 8 * a + 4 * h) * 32 + kl;
            v2u o; o.x = pk2(o4[0], o4[32]); o.y = pk2(o4[64], o4[96]); *(v2u*)(mix + dt * 32 + 8 * a + 4 * h) = o; }
}

constexpr int SA_BIAS = 0, SA_SCR = 2048, SA_ML = SA_SCR + 8 * 8 * 33 * 4, SA_OUT = SA_ML + 8 * 2 * 32 * 4, SA_RED = SA_OUT + 32 * 64 * 4, SA_END = SA_RED + 8 * 64 * 32 * 4;
struct SampTile { float v[2][2][8]; };
template <int MODE> DI const float* samp_tile_base(Frame& F, const int* pt, int b, int g, int li, int j, int ntile) {
    const bool fresh = (j == ntile - 1);
    if (MODE == 0) return fresh ? OUTF + O_SLCS + ((size_t)(b * 2 + li) * DT) * 256 + g * 64 : KIN(I_CSLC) + (((size_t)pt[j >> 2] * 2 + li) * PAGE + (j & 3) * 32) * 256 + g * 64;
    return fresh ? OUTF + O_WINS + ((size_t)(b * 2 + li) * WIN + (WIN - DT)) * 256 + g * 64 : KIN(I_CWIN) + ((size_t)(b * 2 + li) * WIN + 32 * j) * 256 + g * 64;
}
DI void samp_tile_load(SampTile& T, const float* base, int rmask, int kl, int h) {
#pragma unroll
    for (int st = 0; st < 2; ++st)
#pragma unroll
        for (int jj = 0; jj < 8; ++jj) { const int kr = (16 * st + 8 * (jj >> 2) + 4 * h + (jj & 3)) & rmask; const float* vp = base + (size_t)kr * 256 + 128 + kl; T.v[st][0][jj] = vp[0]; T.v[st][1][jj] = vp[32]; }
}
template <int MODE>
DI void sample_branch(Frame& F, int b, int g, int li, int t, unsigned sel, const bf16x8 (&qf)[4], const LAS float* biasT) {
    const int w = F.wave, lane = F.lane, kl = lane & 31, h = lane >> 5, hq = kl & 3;
    const int ntile = (MODE == 0) ? 65 : 17;
    f32x16 O[2]; float l = 0.f;
#pragma unroll
    for (int i = 0; i < 16; ++i) { O[0][i] = 0.f; O[1][i] = 0.f; }
    const int* pt = (const int*)KIN(I_PT) + b * NPAGE;
    SampTile T;
    samp_tile_load(T, samp_tile_base<MODE>(F, pt, b, g, li, w, ntile), (w == ntile - 1) ? 7 : 31, kl, h);
    for (int j = w; j < ntile; j += NWAVES) {
        const bool fresh = (j == ntile - 1);
        const int pos0 = fresh ? PAST : (MODE == 0 ? 32 * j : PAST - WIN + 32 * j);
        bf16x8 kf[4], vf[2][2];
        { const float* kp = samp_tile_base<MODE>(F, pt, b, g, li, j, ntile) + (size_t)(kl & (fresh ? 7 : 31)) * 256 + 8 * h;
#pragma unroll
          for (int ks = 0; ks < 4; ++ks) { const f32x4 x0 = *(const f32x4*)(kp + 16 * ks), x1 = *(const f32x4*)(kp + 16 * ks + 4); v4u av; av.x = pk2(x0.x, x0.y); av.y = pk2(x0.z, x0.w); av.z = pk2(x1.x, x1.y); av.w = pk2(x1.z, x1.w); kf[ks] = __builtin_bit_cast(bf16x8, av); } }
#pragma unroll
        for (int st = 0; st < 2; ++st)
#pragma unroll
            for (int dt = 0; dt < 2; ++dt) { v4u av; av.x = pk2(T.v[st][dt][0], T.v[st][dt][1]); av.y = pk2(T.v[st][dt][2], T.v[st][dt][3]); av.z = pk2(T.v[st][dt][4], T.v[st][dt][5]); av.w = pk2(T.v[st][dt][6], T.v[st][dt][7]); vf[dt][st] = __builtin_bit_cast(bf16x8, av); }
        if (j + NWAVES < ntile) samp_tile_load(T, samp_tile_base<MODE>(F, pt, b, g, li, j + NWAVES, ntile), (j + NWAVES == ntile - 1) ? 7 : 31, kl, h);
        f32x16 S;
#pragma unroll
        for (int i = 0; i < 16; ++i) S[i] = 0.f;
#pragma unroll
        for (int ks = 0; ks < 4; ++ks) S = MFMA32(kf[ks], qf[ks], S);
        { float bv[16];
#pragma unroll
          for (int i = 0; i < 16; ++i) { const int dist = t - (pos0 + crow(i, h)); const int idx = dist < 0 ? 0 : (dist > 127 ? 127 : dist); bv[i] = biasT[hq * 128 + idx]; }
          const bool blk_ok = (MODE == 1) || fresh || (((sel >> ((j >> 1) & 31)) & 1u) != 0u);
#pragma unroll
          for (int i = 0; i < 16; ++i) { const int ko = crow(i, h); const int dist = t - (pos0 + ko);
            const bool ok = blk_ok && dist >= 0 && (!fresh || ko < DT) && (MODE == 0 || dist < WIN);
            const float v = S[i] * SC2 + (bv[i] - SREF); S[i] = ok ? v : -INFINITY; } }
        softmax_pv(S, l, O, vf);
    }
    l += __shfl_xor(l, 32);
    LAS float* ml = (LAS float*)(F.lds + RING_OFF + SA_ML); LAS float* red = (LAS float*)(F.lds + RING_OFF + SA_RED) + w * 2048;
    if (h == 0) { ml[(w * 2 + 0) * 32 + kl] = 0.f; ml[(w * 2 + 1) * 32 + kl] = l; }
#pragma unroll
    for (int dt = 0; dt < 2; ++dt)
#pragma unroll
        for (int i = 0; i < 16; ++i) red[(dt * 32 + crow(i, h)) * 32 + kl] = O[dt][i];
}
DI void sample_combine(Frame& F, int b, int g, int gi) {
    const LAS float* ml = (const LAS float*)(F.lds + RING_OFF + SA_ML); const LAS float* red = (const LAS float*)(F.lds + RING_OFF + SA_RED);
    LAS float* outF = (LAS float*)(F.lds + RING_OFF + SA_OUT);
    const int q = F.tid & 31, d0 = (F.tid >> 5) * 4;
    float M = NEG_BIG;
#pragma unroll
    for (int w = 0; w < 8; ++w) M = fmaxf(M, ml[(w * 2) * 32 + q]);
    float L = 0.f, o[4] = {0.f, 0.f, 0.f, 0.f};
#pragma unroll
    for (int w = 0; w < 8; ++w) { const float f = fexp2(ml[(w * 2) * 32 + q] - M); L += ml[(w * 2 + 1) * 32 + q] * f;
#pragma unroll
        for (int k = 0; k < 4; ++k) o[k] += red[w * 2048 + (d0 + k) * 32 + q] * f; }
    const int row = MP + b * DT + (q >> 2), hd = g * 4 + (q & 3);
    const float gate = WSP(float, WS_GATE)[(size_t)row * 32 + hd * 3 + gi];
    const float sc = L > 0.f ? gate / L : 0.f;
#pragma unroll
    for (int k = 0; k < 4; ++k) outF[q * 64 + d0 + k] += o[k] * sc;
}
DI void attn_sample_unit(Frame& F, int b, int g, int li) {
    const int w = F.wave, lane = F.lane, kl = lane & 31, h = lane >> 5, hq = kl & 3, tl = kl >> 2, hd = g * 4 + hq;
    LAS float* biasT = (LAS float*)(F.lds + RING_OFF + SA_BIAS); LAS float* scr = (LAS float*)(F.lds + RING_OFF + SA_SCR) + w * 8 * 33;
    LAS float* outF = (LAS float*)(F.lds + RING_OFF + SA_OUT);
    fill_bias_table(F, biasT, g);
    const int t = PAST + tl, row = MP + b * DT + tl;
    bf16x8 qf[4];
#pragma unroll
    for (int ks = 0; ks < 4; ++ks) qf[ks] = *(const bf16x8*)(WSP(bf16, WS_QB) + (size_t)row * 512 + hd * 64 + 16 * ks + 8 * h);
    __syncthreads();
    f32x16 Oc[2]; unsigned sel;
    const int cu = b * 2 + g;
    cmp_branch(qf, WSP(bf16, WS_KC) + (size_t)cu * 8192, WSP(bf16, WS_VCT) + (size_t)cu * 8192, t, 32, biasT, lane, scr, Oc, sel);
    if (w == 0) { const float g0 = WSP(float, WS_GATE)[(size_t)row * 32 + hd * 3];
#pragma unroll
        for (int dt = 0; dt < 2; ++dt)
#pragma unroll
            for (int i = 0; i < 16; ++i) outF[kl * 64 + dt * 32 + crow(i, h)] = Oc[dt][i] * g0; }
    sample_branch<0>(F, b, g, li, t, sel, qf, biasT);
    __syncthreads();
    sample_combine(F, b, g, 1);
    __syncthreads();
    sample_branch<1>(F, b, g, li, t, sel, qf, biasT);
    __syncthreads();
    sample_combine(F, b, g, 2);
    __syncthreads();
    { const int q = F.tid >> 4, d4 = (F.tid & 15) * 4; const LAS float* s = outF + q * 64 + d4;
      v2u o; o.x = pk2(s[0], s[1]); o.y = pk2(s[2], s[3]);
      *(v2u*)(WSP(bf16, WS_MIX) + (size_t)(MP + b * DT + (q >> 2)) * DM + (g * 4 + (q & 3)) * 64 + d4) = o; }
    __syncthreads();
}

constexpr int SCN_STEPS = 32, SCN_CH = SCN_STEPS * 384 * 4  , SCN_Y = 2 * SCN_CH, SCN_END = SCN_Y + 2 * SCN_STEPS * 32 * 4;
struct ScanOps { f32x4 w0, w1, k0, k1, b0, b1, m0, m1, r0, r1; float v; };
DI ScanOps scan_ld(const LAS float* ch, int st, int cj, int irow) { const LAS float* c = ch + st * 384 + cj * 8; ScanOps o;
    o.w0 = *(const LAS f32x4*)(c); o.w1 = *(const LAS f32x4*)(c + 4); o.k0 = *(const LAS f32x4*)(c + 64); o.k1 = *(const LAS f32x4*)(c + 68); o.b0 = *(const LAS f32x4*)(c + 128); o.b1 = *(const LAS f32x4*)(c + 132);
    o.m0 = *(const LAS f32x4*)(c + 192); o.m1 = *(const LAS f32x4*)(c + 196); o.r0 = *(const LAS f32x4*)(c + 256); o.r1 = *(const LAS f32x4*)(c + 260); o.v = ch[st * 384 + 320 + irow]; return o; }
DI float dot8(const f32x4 a0, const f32x4 a1, const f32x4 b0, const f32x4 b1) { const f32x4 p = a0 * b0 + a1 * b1; return (p.x + p.y) + (p.z + p.w); }
DI float scan_step(f32x4& s0, f32x4& s1, const ScanOps& o) {
    float sa = dot8(s0, s1, o.k0, o.k1);
    const f32x4 t0 = s0 * o.w0 + o.m0 * o.v, t1 = s1 * o.w1 + o.m1 * o.v;
    sa = sum8(sa);
    s0 = t0 - o.b0 * sa; s1 = t1 - o.b1 * sa;
    return sum8(dot8(s0, s1, o.r0, o.r1));
}
struct ScanRaw { f32x4 w; v2u b[5]; };
DI void scan_stage_load(const unsigned char* rec, int c4, ScanRaw& pre) { pre.w = *(const f32x4*)(rec + 16 * c4);
#pragma unroll
    for (int k = 0; k < 5; ++k) pre.b[k] = *(const v2u*)(rec + SCR_KK + 128 * k + 8 * c4); }
DI f32x4 unpk4(const v2u w) { return (f32x4){bflo(w.x), bfhi(w.x), bflo(w.y), bfhi(w.y)}; }
DI void scan_stage_store(LAS float* rec, int c4, const ScanRaw& pre, const f32x4 ka) { LAS float* p = rec + 4 * c4;
    const f32x4 kk = unpk4(pre.b[0]), a = unpk4(pre.b[1]), k = unpk4(pre.b[2]);
    *(LAS f32x4*)(p) = pre.w; *(LAS f32x4*)(p + 64) = kk; *(LAS f32x4*)(p + 128) = kk * a; *(LAS f32x4*)(p + 192) = k * ((a - 1.0f) * ka + 1.0f); *(LAS f32x4*)(p + 256) = unpk4(pre.b[3]); *(LAS f32x4*)(p + 320) = unpk4(pre.b[4]); }
typedef short bf16x4 __attribute__((ext_vector_type(4)));
#define MFMA16(a, b, c) __builtin_amdgcn_mfma_f32_16x16x16bf16_1k((a), (b), (c), 0, 0, 0)
DI bf16x4 pack4(const f32x4 v) { v2u r; r.x = pk2(v.x, v.y); r.y = pk2(v.z, v.w); return __builtin_bit_cast(bf16x4, r); }
constexpr int CK_L = 16, CK_NB = 4, CK_PA = 68  , CK_PS = 20  ;
constexpr int CKO_AL = 0, CKO_RH = CKO_AL + 16 * CK_PA * 2, CKO_BR = CKO_RH + 16 * CK_PA * 2, CKO_MR = CKO_BR + 16 * CK_PA * 2, CKO_NBC = CKO_MR + 16 * CK_PA * 2, CKO_MUC = CKO_NBC + 64 * CK_PS * 2,
              CKO_VTB = CKO_MUC + 64 * CK_PS * 2, CKO_QT = CKO_VTB + 64 * CK_PS * 2, CKO_NT = CKO_QT + 16 * CK_PS * 2, CKO_NT1 = CKO_NT + 16 * CK_PS * 2, CKO_T2T = CKO_NT1 + 16 * CK_PS * 2, CKO_GL = CKO_T2T + 16 * CK_PS * 2,
              CK_BUF = CKO_GL + 64 * 4, CK_PRIV = CK_NB * CK_BUF  , CK_PRIVB = 8 * SCR_BYTES, CK_END = CK_PRIV + 4 * CK_PRIVB;
static_assert(CK_BUF % 16 == 0 && CK_PRIVB % 16 == 0 && CK_END <= RING_BYTES, "chunked scan LDS map");
#define CK_BAR() asm volatile("s_waitcnt lgkmcnt(0)\n\ts_barrier" ::: "memory")
template <int TB> DI void ck_h1_half(const LAS unsigned char* raw, LAS unsigned char* cb, int lane, float kaj, float& gm) {
    float hw_w[8]; unsigned hw_kk[8], hw_a[8], hw_k[8], hw_r[8], hw_v[8];
#pragma unroll
    for (int t = 0; t < 8; ++t) { const LAS unsigned char* rr = raw + t * SCR_BYTES;
        hw_w[t] = *(const LAS float*)(rr + 4 * lane); hw_kk[t] = *(const LAS bf16*)(rr + SCR_KK + 2 * lane); hw_a[t] = *(const LAS bf16*)(rr + SCR_A + 2 * lane);
        hw_k[t] = *(const LAS bf16*)(rr + SCR_K + 2 * lane); hw_r[t] = *(const LAS bf16*)(rr + SCR_R + 2 * lane); hw_v[t] = *(const LAS bf16*)(rr + SCR_V + 2 * lane); }
    asm volatile("s_waitcnt lgkmcnt(0)" ::: "memory");
    unsigned nb[4], mc[4], vc[4];
#pragma unroll
    for (int t = 0; t < 8; ++t) {
        const float kap = bf2f(hw_kk[t]), av = bf2f(hw_a[t]);
        const float al = kap * gm; gm *= hw_w[t]; const float ig = __builtin_amdgcn_rcpf(gm);
        const float be = kap * av * ig, mu = bf2f(hw_k[t]) * ((av - 1.0f) * kaj + 1.0f) * ig, rh = bf2f(hw_r[t]) * gm;
        const unsigned bm = pk2(be, mu), ar = pk2(al, rh);
        *(LAS bf16*)(cb + CKO_AL + ((TB + t) * CK_PA + lane) * 2) = (bf16)(ar & 0xffffu); *(LAS bf16*)(cb + CKO_RH + ((TB + t) * CK_PA + lane) * 2) = (bf16)(ar >> 16);
        *(LAS bf16*)(cb + CKO_BR + ((TB + t) * CK_PA + lane) * 2) = (bf16)(bm & 0xffffu); *(LAS bf16*)(cb + CKO_MR + ((TB + t) * CK_PA + lane) * 2) = (bf16)(bm >> 16);
        if (t & 1) { nb[t >> 1] |= ((bm & 0xffffu) ^ 0x8000u) << 16; mc[t >> 1] |= bm & 0xffff0000u; vc[t >> 1] |= hw_v[t] << 16; }
        else { nb[t >> 1] = (bm & 0xffffu) ^ 0x8000u; mc[t >> 1] = bm >> 16; vc[t >> 1] = hw_v[t]; } }
#pragma unroll
    for (int q = 0; q < 2; ++q) { v2u x; x.x = nb[2 * q]; x.y = nb[2 * q + 1]; *(LAS v2u*)(cb + CKO_NBC + (lane * CK_PS + TB + 4 * q) * 2) = x;
        x.x = mc[2 * q]; x.y = mc[2 * q + 1]; *(LAS v2u*)(cb + CKO_MUC + (lane * CK_PS + TB + 4 * q) * 2) = x; x.x = vc[2 * q]; x.y = vc[2 * q + 1]; *(LAS v2u*)(cb + CKO_VTB + (lane * CK_PS + TB + 4 * q) * 2) = x; }
}
DI void ck_gram_inverse(LAS unsigned char* cb, int l15, int g4) {
    f32x4 gp = (f32x4){0.f, 0.f, 0.f, 0.f}, gq = gp, g1 = gp, g2 = gp, gt = gp;
#pragma unroll
    for (int ks = 0; ks < 4; ++ks) { const int o = (l15 * CK_PA + 16 * ks + g4) * 2;
        const bf16x4 fb = *(const LAS bf16x4*)(cb + CKO_BR + o), fm = *(const LAS bf16x4*)(cb + CKO_MR + o), fa = *(const LAS bf16x4*)(cb + CKO_AL + o), fr = *(const LAS bf16x4*)(cb + CKO_RH + o);
        gp = MFMA16(fb, fa, gp); gq = MFMA16(fm, fa, gq); g1 = MFMA16(fb, fr, g1); g2 = MFMA16(fm, fr, g2); gt = MFMA16(fa, fb, gt); }
    f32x4 q4, n1, t2, p4, pt4, id;
#pragma unroll
    for (int e = 0; e < 4; ++e) { const int tau = g4 + e; q4[e] = tau < l15 ? gq[e] : 0.f; n1[e] = tau <= l15 ? -g1[e] : 0.f; t2[e] = tau <= l15 ? g2[e] : 0.f;
        p4[e] = tau < l15 ? gp[e] : 0.f; pt4[e] = l15 < tau ? gt[e] : 0.f; id[e] = tau == l15 ? 1.0f : 0.f; }
    *(LAS bf16x4*)(cb + CKO_QT + (l15 * CK_PS + g4) * 2) = pack4(q4); *(LAS bf16x4*)(cb + CKO_NT1 + (l15 * CK_PS + g4) * 2) = pack4(n1); *(LAS bf16x4*)(cb + CKO_T2T + (l15 * CK_PS + g4) * 2) = pack4(t2);
    const f32x4 z4 = (f32x4){0.f, 0.f, 0.f, 0.f};
    const bf16x4 Pb = pack4(p4), PTb = pack4(pt4);
    const f32x4 P2 = MFMA16(PTb, Pb, z4), P2T = MFMA16(Pb, PTb, z4);
    const bf16x4 P2b = pack4(P2), P2Tb = pack4(P2T);
    const f32x4 P4 = MFMA16(P2Tb, P2b, z4), P4T = MFMA16(P2b, P2Tb, z4);
    const f32x4 P8 = MFMA16(pack4(P4T), pack4(P4), z4);
    const bf16x4 M1Tb = pack4(id - pt4), M2b = pack4(id + P2), M4b = pack4(id + P4);
    const f32x4 R1T = MFMA16(M2b, M1Tb, z4);
    const f32x4 R2T = MFMA16(M4b, pack4(R1T), z4);
    const f32x4 N = MFMA16(pack4(R2T), pack4(id + P8), z4);
    *(LAS bf16x4*)(cb + CKO_NT + (l15 * CK_PS + g4) * 2) = pack4(N);
}
#define CK_HELPER_CHUNK(HC, HN, C1) { const int c1 = (C1); LAS unsigned char* cb = lds + (c1 % CK_NB) * CK_BUF; \
    { const int rown = b * SEQ + (c1 + 4 < NCH ? c1 + 4 : c1) * CK_L; _Pragma("unroll") for (int t = 0; t < 16; ++t) HN[t] = *(const f32x4*)(SCREC(rown + t, h) + 16 * (lane < 56 ? lane : 55)); } \
    _Pragma("unroll") for (int t = 0; t < 8; ++t) if (lane < 56) *(LAS f32x4*)(raw + t * SCR_BYTES + 16 * lane) = HC[t]; \
    float gm = 1.0f; ck_h1_half<0>(raw, cb, lane, kaj, gm); CK_BAR(); \
    _Pragma("unroll") for (int t = 0; t < 8; ++t) if (lane < 56) *(LAS f32x4*)(raw + t * SCR_BYTES + 16 * lane) = HC[8 + t]; \
    ck_h1_half<8>(raw, cb, lane, kaj, gm); *(LAS float*)(cb + CKO_GL + lane * 4) = gm; CK_BAR(); \
    ck_gram_inverse(cb, l15, g4); CK_BAR(); \
    CK_BAR(); }
DI void scan_prompt_unit(Frame& F, int b, int h, int li) {
    const int w = F.wave, lane = F.lane, l15 = lane & 15, g4 = (lane >> 4) * 4;
    LAS unsigned char* lds = F.lds + RING_OFF;
    constexpr int NCH = SEQ / CK_L;
    if (w < 4) {
        float* YR = WSP(float, WS_YRAW);
        f32x4 T[4];
#pragma unroll
        for (int c = 0; c < 4; ++c) T[c] = (f32x4){0.f, 0.f, 0.f, 0.f};
        CK_BAR(); CK_BAR(); CK_BAR();
        for (int c0 = 0; c0 < NCH; ++c0) {
            const LAS unsigned char* cb = lds + (c0 % CK_NB) * CK_BUF; const int row0 = b * SEQ + c0 * CK_L;
            bf16x4 tb[4];
#pragma unroll
            for (int c = 0; c < 4; ++c) tb[c] = pack4(T[c]);
            f32x4 a1 = (f32x4){0.f, 0.f, 0.f, 0.f}, a2 = a1;
#pragma unroll
            for (int c = 0; c < 4; ++c) { const bf16x4 fa = *(const LAS bf16x4*)(cb + CKO_AL + (l15 * CK_PA + 16 * c + g4) * 2), fr = *(const LAS bf16x4*)(cb + CKO_RH + (l15 * CK_PA + 16 * c + g4) * 2);
                a1 = MFMA16(fa, tb[c], a1); a2 = MFMA16(fr, tb[c], a2); }
            const bf16x4 vt = *(const LAS bf16x4*)(cb + CKO_VTB + ((16 * w + l15) * CK_PS + g4) * 2);
            a1 = MFMA16(*(const LAS bf16x4*)(cb + CKO_QT + (l15 * CK_PS + g4) * 2), vt, a1);
            const f32x4 z4 = (f32x4){0.f, 0.f, 0.f, 0.f};
            const f32x4 U = MFMA16(*(const LAS bf16x4*)(cb + CKO_NT + (l15 * CK_PS + g4) * 2), pack4(a1), z4);
            const bf16x4 ub = pack4(U);
            a2 = MFMA16(*(const LAS bf16x4*)(cb + CKO_NT1 + (l15 * CK_PS + g4) * 2), ub, a2);
            a2 = MFMA16(*(const LAS bf16x4*)(cb + CKO_T2T + (l15 * CK_PS + g4) * 2), vt, a2);
            float* yp = YR + (size_t)(row0 + g4) * 512 + h * 64 + 16 * w + l15;
            yp[0] = a2.x; yp[512] = a2.y; yp[1024] = a2.z; yp[1536] = a2.w;
#pragma unroll
            for (int c = 0; c < 4; ++c) { T[c] = MFMA16(*(const LAS bf16x4*)(cb + CKO_NBC + ((16 * c + l15) * CK_PS + g4) * 2), ub, T[c]);
                T[c] = MFMA16(*(const LAS bf16x4*)(cb + CKO_MUC + ((16 * c + l15) * CK_PS + g4) * 2), vt, T[c]);
                T[c] = T[c] * *(const LAS f32x4*)(cb + CKO_GL + (16 * c + g4) * 4); }
            CK_BAR();
        }
        float* so = OUTF + O_WKVP + ((size_t)((b * 2 + li) * 8 + h) * 64 + 16 * w + l15) * 64;
#pragma unroll
        for (int c = 0; c < 4; ++c) *(f32x4*)(so + 16 * c + g4) = T[c];
    } else {
        const int hw = w - 4;
        const float kaj = KIN(I_KA)[li * 512 + h * 64 + lane];
        LAS unsigned char* raw = lds + CK_PRIV + hw * CK_PRIVB;
        f32x4 ha[16], hb[16];
#pragma unroll
        for (int t = 0; t < 16; ++t) ha[t] = *(const f32x4*)(SCREC(b * SEQ + hw * CK_L + t, h) + 16 * (lane < 56 ? lane : 55));
        for (int i = 0; i < hw; ++i) CK_BAR();
        for (int c2 = hw; c2 < NCH; c2 += 8) { CK_HELPER_CHUNK(ha, hb, c2) CK_HELPER_CHUNK(hb, ha, c2 + 4) }
        for (int i = 0; i < 3 - hw; ++i) CK_BAR();
    }
}
DI void scan_post_phase(Frame& F, int li) {
    const float* YR = WSP(float, WS_YRAW);
    const int i0 = (F.tid & 15) * 4;
    for (int it0 = F.bid * (NTHREADS / 16) + (F.tid >> 4); it0 < MP * 8; it0 += 2 * F.G * (NTHREADS / 16)) {
        f32x4 y[2], r[2], kraw[2], av[2], v[2], gg[2];
#pragma unroll
        for (int q = 0; q < 2; ++q) { const int it = it0 + q * F.G * (NTHREADS / 16), row = it >> 3, h = it & 7; const unsigned char* c = SCREC(row, h) + i0 * 2;
            y[q] = *(const f32x4*)(YR + (size_t)row * 512 + h * 64 + i0); r[q] = unpk4(*(const v2u*)(c + SCR_R)); kraw[q] = unpk4(*(const v2u*)(c + SCR_K)); av[q] = unpk4(*(const v2u*)(c + SCR_A)); v[q] = unpk4(*(const v2u*)(c + SCR_V));
            gg[q] = *(const f32x4*)(WSP(float, WS_G) + (size_t)row * 512 + h * 64 + i0); }
#pragma unroll
        for (int q = 0; q < 2; ++q) { const int it = it0 + q * F.G * (NTHREADS / 16), row = it >> 3, h = it & 7;
            const float mu = sum16((y[q].x + y[q].y) + (y[q].z + y[q].w)) * (1.f / 64.f);
            const f32x4 dv = y[q] - mu;
            const float var = sum16((dv.x * dv.x + dv.y * dv.y) + (dv.z * dv.z + dv.w * dv.w)) * (1.f / 64.f);
            const float rs = __builtin_amdgcn_rsqf(var + GN_EPS);
            const f32x4 km = kraw[q] * ((av[q] - 1.0f) * *(const f32x4*)(KIN(I_KA) + (size_t)li * 512 + h * 64 + i0) + 1.0f);
            const f32x4 rk = *(const f32x4*)(KIN(I_RK) + (size_t)(li * 8 + h) * 64 + i0);
            const float bon = sum16((r[q].x * km.x * rk.x + r[q].y * km.y * rk.y) + (r[q].z * km.z * rk.z + r[q].w * km.w * rk.w));
            const f32x4 lw = *(const f32x4*)(KIN(I_LNW) + (size_t)li * 512 + h * 64 + i0), lb = *(const f32x4*)(KIN(I_LNB) + (size_t)li * 512 + h * 64 + i0);
            const f32x4 o = (dv * rs * lw + lb + v[q] * bon) * gg[q];
            v2u pk; pk.x = pk2(o.x, o.y); pk.y = pk2(o.z, o.w);
            *(v2u*)(WSP(bf16, WS_MIX) + (size_t)row * DM + 512 + h * 64 + i0) = pk; }
    }
}
DI void scan_sample_unit(Frame& F, int b, int li) {
    const int h = F.wave, lane = F.lane;
    LAS float* ch = (LAS float*)(F.lds + RING_OFF) + h * (DT * 384);
    LAS float* yb = (LAS float*)(F.lds + RING_OFF + 8 * DT * 384 * 4) + h * (DT * 64);
#pragma unroll
    for (int k = 0; k < 2; ++k) { const int it = lane + 64 * k, tk = it >> 4, c4 = it & 15; ScanRaw pre;
        scan_stage_load(SCREC(MP + b * DT + tk, h), c4, pre);
        scan_stage_store(ch + tk * 384, c4, pre, *(const f32x4*)(KIN(I_KA) + (size_t)li * 512 + h * 64 + 4 * c4)); }
    float s[64];
    const float* s0 = KIN(I_SWKV) + ((size_t)((b * 2 + li) * 8 + h) * 64 + lane) * 64;
#pragma unroll
    for (int j = 0; j < 16; ++j) { const f32x4 x = ((const f32x4*)s0)[j]; s[4 * j] = x.x; s[4 * j + 1] = x.y; s[4 * j + 2] = x.z; s[4 * j + 3] = x.w; }
    LDS_WAIT(); asm volatile("" ::: "memory");
    for (int st = 0; st < DT; ++st) {
        const LAS float* c = ch + st * 384;
        float sa = 0.f;
#pragma unroll
        for (int j = 0; j < 64; ++j) sa += s[j] * c[64 + j];
        sa = -sa;
        const float v = c[320 + lane];
        float y = 0.f;
#pragma unroll
        for (int j = 0; j < 64; ++j) { s[j] = s[j] * c[j] + sa * c[128 + j] + v * c[192 + j]; y += s[j] * c[256 + j]; }
        yb[st * 64 + lane] = y;
    }
    float* so = OUTF + O_WKVS + ((size_t)((b * 2 + li) * 8 + h) * 64 + lane) * 64;
#pragma unroll
    for (int j = 0; j < 16; ++j) ((f32x4*)so)[j] = (f32x4){s[4 * j], s[4 * j + 1], s[4 * j + 2], s[4 * j + 3]};
    LDS_WAIT(); asm volatile("" ::: "memory");
#pragma unroll
    for (int ps = 0; ps < 2; ++ps) {
        const int tok = ps * 4 + (lane >> 4), i0 = (lane & 15) * 4;
        const LAS float* c = ch + tok * 384;
        const f32x4 y = *(const LAS f32x4*)(yb + tok * 64 + i0);
        const float mu = sum16((y.x + y.y) + (y.z + y.w)) * (1.f / 64.f);
        const f32x4 dv = y - mu;
        const float var = sum16((dv.x * dv.x + dv.y * dv.y) + (dv.z * dv.z + dv.w * dv.w)) * (1.f / 64.f);
        const float rs = 1.0f / sqrtf(var + GN_EPS);
        const f32x4 r = *(const LAS f32x4*)(c + 4 * 64 + i0), km = *(const LAS f32x4*)(c + 3 * 64 + i0), v = *(const LAS f32x4*)(c + 5 * 64 + i0);
        const f32x4 rk = *(const f32x4*)(KIN(I_RK) + (size_t)(li * 8 + h) * 64 + i0);
        const float bon = sum16((r.x * km.x * rk.x + r.y * km.y * rk.y) + (r.z * km.z * rk.z + r.w * km.w * rk.w));
        const f32x4 lw = *(const f32x4*)(KIN(I_LNW) + (size_t)li * 512 + h * 64 + i0), lb = *(const f32x4*)(KIN(I_LNB) + (size_t)li * 512 + h * 64 + i0);
        const int row = MP + b * DT + tok;
        const f32x4 gg = *(const f32x4*)(WSP(float, WS_G) + (size_t)row * 512 + h * 64 + i0);
        const f32x4 o = (dv * rs * lw + lb + v * bon) * gg;
        v2u pk; pk.x = pk2(o.x, o.y); pk.y = pk2(o.z, o.w);
        *(v2u*)(WSP(bf16, WS_MIX) + (size_t)row * DM + 512 + h * 64 + i0) = pk;
    }
    __syncthreads();
}

extern __shared__ __attribute__((aligned(16))) unsigned char g_lds[];
DI int take_ticket(Frame& F, int word) {
    volatile LAS unsigned* tk = F.MISC + 16;
    __syncthreads();
    if (F.tid == 0) tk[0] = __hip_atomic_fetch_add((unsigned*)(F.ctl + word), 1u, RLX_AGENT);
    __syncthreads();
    return __builtin_amdgcn_readfirstlane((int)tk[0]);
}

struct EpiStoreBf16 { static constexpr int PID = 16;
    static constexpr bool PERM = true, AFTER_DRAIN = false;
    bf16* O; int ldc;
    DI void operator()(const f32x4 (&acc)[2][2][4][2], const pg8::Unit& u, int wr, int wc, int fr, int fq) const {
        const int row0 = u.pm * 256 + wr * 64 + fr, col0 = u.pn * 256 + wc * 32 + 8 * fq;
#pragma unroll
        for (int ai = 0; ai < 2; ++ai)
#pragma unroll
            for (int m = 0; m < 4; ++m) { bf16* rowp = O + (size_t)(row0 + ai * 128 + m * 16) * ldc + col0;
#pragma unroll
                for (int bj = 0; bj < 2; ++bj) { const f32x4 v0 = acc[ai][bj][m][0], v1 = acc[ai][bj][m][1];
                    v4u w; w.x = pk2(v0[0], v0[1]); w.y = pk2(v0[2], v0[3]); w.z = pk2(v1[0], v1[1]); w.w = pk2(v1[2], v1[3]);
                    *(v4u*)(rowp + bj * 128) = w; } }
    }
};
struct EpiPart { static constexpr int PID = 20;
    static constexpr bool PERM = false, AFTER_DRAIN = false;
    float* C;
    DI void operator()(const f32x4 (&acc)[2][2][4][2], const pg8::Unit& u, int wr, int wc, int fr, int fq) const {
        const int row0 = u.pm * 256 + wr * 64 + fr, col0 = wc * 32 + 4 * fq;
#pragma unroll
        for (int ai = 0; ai < 2; ++ai)
#pragma unroll
            for (int m = 0; m < 4; ++m) { float* rowp = C + (size_t)(row0 + ai * 128 + m * 16) * 256 + col0;
#pragma unroll
                for (int bj = 0; bj < 2; ++bj)
#pragma unroll
                    for (int n = 0; n < 2; ++n) *(f32x4*)(rowp + bj * 128 + n * 16) = acc[ai][bj][m][n]; }
    }
};
struct EpiResid { static constexpr int PID = 18;
    static constexpr bool PERM = false, AFTER_DRAIN = false;
    const float* baseF;
    bf16* XB; float* Xout;
    unsigned long long* ssq;
    DI void operator()(const f32x4 (&acc)[2][2][4][2], const pg8::Unit& u, int wr, int wc, int fr, int fq) const {
        const int row0 = u.pm * 256 + wr * 64 + fr, col0 = u.pn * 256 + wc * 32 + 4 * fq;
        if (baseF) {
#pragma unroll
            for (int ai = 0; ai < 2; ++ai)
#pragma unroll
                for (int m = 0; m < 4; ++m) { const int row = row0 + ai * 128 + m * 16; const size_t off = (size_t)row * DM + col0; float sq = 0.f;
#pragma unroll
                    for (int bj = 0; bj < 2; ++bj)
#pragma unroll
                        for (int n = 0; n < 2; ++n) { const size_t o2 = off + bj * 128 + n * 16; const f32x4 x = *(const f32x4*)(baseF + o2) + acc[ai][bj][m][n];
                            v2u o; o.x = pk2(x[0], x[1]); o.y = pk2(x[2], x[3]); *(v2u*)(XB + o2) = o; sq += (x[0] * x[0] + x[1] * x[1]) + (x[2] * x[2] + x[3] * x[3]); }
                    sq += __shfl_xor(sq, 16); sq += __shfl_xor(sq, 32); if (fq == 0) __hip_atomic_fetch_add(ssq + row, (unsigned long long)(sq * SSQ_SCALE + 0.5f), RLX_AGENT);
                    if (m & 1) asm volatile("" ::: "memory"); }
            return;
        }
        v2u bw[2][4][2][2];
#pragma unroll
        for (int ai = 0; ai < 2; ++ai)
#pragma unroll
            for (int m = 0; m < 4; ++m)
#pragma unroll
                for (int bj = 0; bj < 2; ++bj)
#pragma unroll
                    for (int n = 0; n < 2; ++n) bw[ai][m][bj][n] = *(const v2u*)(XB + (size_t)(row0 + ai * 128 + m * 16) * DM + col0 + bj * 128 + n * 16);
#pragma unroll
        for (int ai = 0; ai < 2; ++ai)
#pragma unroll
            for (int m = 0; m < 4; ++m) { const int row = row0 + ai * 128 + m * 16; const size_t off = (size_t)row * DM + col0; float sq = 0.f;
#pragma unroll
                for (int bj = 0; bj < 2; ++bj)
#pragma unroll
                    for (int n = 0; n < 2; ++n) { const size_t o2 = off + bj * 128 + n * 16; const v2u wv = bw[ai][m][bj][n];
                        const f32x4 x = (f32x4){bflo(wv.x), bfhi(wv.x), bflo(wv.y), bfhi(wv.y)} + acc[ai][bj][m][n];
                        if (Xout) *(f32x4*)(Xout + o2) = x;
                        else { v2u o; o.x = pk2(x[0], x[1]); o.y = pk2(x[2], x[3]); *(v2u*)(XB + o2) = o; sq += (x[0] * x[0] + x[1] * x[1]) + (x[2] * x[2] + x[3] * x[3]); } }
                if (!Xout) { sq += __shfl_xor(sq, 16); sq += __shfl_xor(sq, 32); if (fq == 0) __hip_atomic_fetch_add(ssq + row, (unsigned long long)(sq * SSQ_SCALE + 0.5f), RLX_AGENT); } }
    }
};
struct EpiLora { static constexpr int PID = 19;
    static constexpr bool PERM = false, AFTER_DRAIN = false;
    unsigned char* SC; float* G; const float *w0, *a0;
    DI void operator()(const f32x4 (&acc)[2][2][4][2], const pg8::Unit& u, int wr, int wc, int fr, int fq) const {
        const int row0 = u.pm * 256 + wr * 64 + fr, seg = u.pn >> 1, cb = (u.pn & 1) * 256 + wc * 32 + 4 * fq;
#pragma unroll
        for (int bj = 0; bj < 2; ++bj)
#pragma unroll
            for (int n = 0; n < 2; ++n) {
                const int colh = cb + bj * 128 + n * 16, h = colh >> 6, d = colh & 63;
                f32x4 c0 = (f32x4){0.f, 0.f, 0.f, 0.f};
                if (seg == 0) c0 = *(const f32x4*)(w0 + colh); else if (seg == 1) c0 = *(const f32x4*)(a0 + colh);
#pragma unroll
                for (int ai = 0; ai < 2; ++ai)
#pragma unroll
                    for (int m = 0; m < 4; ++m) { const int row = row0 + ai * 128 + m * 16; const f32x4 a = acc[ai][bj][m][n];
                        unsigned char* scb = SC + ((size_t)row * 8 + h) * SCR_BYTES;
                        if (seg == 0) { f32x4 o;
#pragma unroll
                            for (int i = 0; i < 4; ++i) { const float y = -(c0[i] + a[i]); const float sp = fmaxf(y, 0.f) + __logf(1.0f + __expf(-fabsf(y))); o[i] = __expf(-__expf(-sp - 0.5f)); }
                            *(f32x4*)(scb + d * 4) = o; }
                        else if (seg == 1) { f32x4 o;
#pragma unroll
                            for (int i = 0; i < 4; ++i) o[i] = sigmoidf_(c0[i] + a[i]);
                            v2u ob; ob.x = pk2(o[0], o[1]); ob.y = pk2(o[2], o[3]); *(v2u*)(scb + SCR_A + d * 2) = ob; }
                        else *(f32x4*)(G + (size_t)row * 512 + colh) = a;
                    }
            }
    }
};
template <int CTRL> DI f32x4 dpp4(const f32x4 v) { return (f32x4){dppf<CTRL>(v.x), dppf<CTRL>(v.y), dppf<CTRL>(v.z), dppf<CTRL>(v.w)}; }
template <int CTRL> DI float dppf_old(float old, float x) { return __builtin_bit_cast(float, __builtin_amdgcn_update_dpp(__builtin_bit_cast(int, old), __builtin_bit_cast(int, x), CTRL, 0xf, 0xf, false)); }
template <int CTRL> DI f32x4 dpp4_old(const f32x4 o, const f32x4 v) { return (f32x4){dppf_old<CTRL>(o.x, v.x), dppf_old<CTRL>(o.y, v.y), dppf_old<CTRL>(o.z, v.z), dppf_old<CTRL>(o.w, v.w)}; }
DI f32x4 silu4_mul(const f32x4 y, const f32x4 u) { return (f32x4){y.x * sigmoidf_(y.x) * u.x, y.y * sigmoidf_(y.y) * u.y, y.z * sigmoidf_(y.z) * u.z, y.w * sigmoidf_(y.w) * u.w}; }
struct EpiFfnAct { static constexpr int PID = 17;
    static constexpr bool PERM = false, AFTER_DRAIN = false;
    bf16* H; float* HALO; const float* cw  ; const unsigned long long* ssq; const float* state  ; float* outP; float* outS; int l;
    DI void operator()(const f32x4 (&acc)[2][2][4][2], const pg8::Unit& u, int wr, int wc, int fr, int fq) const {
        const bool samp = u.pm >= MP / 256;
        float rinv[2][4];
#pragma unroll
        for (int ai = 0; ai < 2; ++ai)
#pragma unroll
            for (int m = 0; m < 4; ++m) rinv[ai][m] = rinv_of(ssq, u.pm * 256 + ai * 128 + wr * 64 + m * 16 + fr);
#pragma unroll
        for (int n = 0; n < 2; ++n) {
            const int ch = u.pn * 128 + wc * 32 + 16 * n + 4 * fq;
            const f32x4 w0 = *(const f32x4*)(cw + ch), w1 = *(const f32x4*)(cw + DFF + ch), w2 = *(const f32x4*)(cw + 2 * DFF + ch);
#pragma unroll
            for (int ai = 0; ai < 2; ++ai) {
                f32x4 pa = (f32x4){0.f, 0.f, 0.f, 0.f};
#pragma unroll
                for (int m = 0; m < 4; ++m) {
                    const int row = u.pm * 256 + ai * 128 + wr * 64 + m * 16 + fr;
                    const float rin = rinv[ai][m];
                    const f32x4 a = acc[ai][0][m][n] * rin, uu = acc[ai][1][m][n] * rin;
                    const f32x4 r1 = dpp4<0x121>(pa), r2 = dpp4<0x122>(pa);
                    f32x4 a1 = dpp4_old<0x111>(r1, a), a2 = dpp4_old<0x112>(r2, a);
                    if (samp) { const int t = fr & 7, b = (row - MP) >> 3;
                        if (t < 2) { const float* st = state + (size_t)b * (4 * 2 * DFF) + ch; const f32x4 st0 = *(const f32x4*)st, st1 = *(const f32x4*)(st + DFF);
                            if (t == 0) { a1 = st1; a2 = st0; } else a2 = st1; }
                        if (t >= 6) *(f32x4*)(outS + ((size_t)(b * 4 + l) * 2 + (t - 6)) * DFF + ch) = a;
                    } else {
                        const int blk = row >> 6;
                        if (m == 3) { if (fr >= 14) { *(f32x4*)(HALO + ((size_t)blk * 6 + (fr - 14)) * DFF + ch) = a;
                            if ((row & (SEQ - 1)) >= SEQ - 2) *(f32x4*)(outP + ((size_t)((row >> 11) * 4 + l) * 2 + ((row & (SEQ - 1)) - (SEQ - 2))) * DFF + ch) = a; } }
                        if (m == 0) { if (fr < 2) { *(f32x4*)(HALO + ((size_t)blk * 6 + 2 + fr) * DFF + ch) = a; *(f32x4*)(HALO + ((size_t)blk * 6 + 4 + fr) * DFF + ch) = uu; } }
                    }
                    const f32x4 y = w0 * a2 + w1 * a1 + w2 * a;
                    const f32x4 hv = silu4_mul(y, uu);
                    v2u o; o.x = pk2(hv.x, hv.y); o.y = pk2(hv.z, hv.w);
                    *(v2u*)(H + (size_t)row * DFF + ch) = o;
                    pa = a;
                }
            }
        }
    }
};
DI void ffn_fix_panel(Frame& F, int l, int pm) {
    const float* HALO = WSP(float, WS_HALO); const float* cw = KIN(I_FCONV) + (size_t)l * 3 * DFF; bf16* H = WSP(bf16, WS_H);
    constexpr int NC4 = DFF / 4;
    for (int it = F.tid; it < 4 * 2 * NC4; it += NTHREADS) {
        const int ch = (it % NC4) * 4, bj = it / NC4, blk = pm * 4 + (bj >> 1), j = bj & 1; const bool s0 = (blk & 31) == 0;
        const f32x4 z = (f32x4){0.f, 0.f, 0.f, 0.f};
        const f32x4 a = *(const f32x4*)(HALO + ((size_t)blk * 6 + 2 + j) * DFF + ch), uu = *(const f32x4*)(HALO + ((size_t)blk * 6 + 4 + j) * DFF + ch);
        f32x4 a1, a2;
        if (j == 1) { a1 = *(const f32x4*)(HALO + ((size_t)blk * 6 + 2) * DFF + ch); a2 = s0 ? z : *(const f32x4*)(HALO + ((size_t)(blk - 1) * 6 + 1) * DFF + ch); }
        else { a1 = s0 ? z : *(const f32x4*)(HALO + ((size_t)(blk - 1) * 6 + 1) * DFF + ch); a2 = s0 ? z : *(const f32x4*)(HALO + ((size_t)(blk - 1) * 6 + 0) * DFF + ch); }
        const f32x4 w0 = *(const f32x4*)(cw + ch), w1 = *(const f32x4*)(cw + DFF + ch), w2 = *(const f32x4*)(cw + 2 * DFF + ch);
        const f32x4 hv = silu4_mul(w0 * a2 + w1 * a1 + w2 * a, uu);
        v2u o; o.x = pk2(hv.x, hv.y); o.y = pk2(hv.z, hv.w);
        *(v2u*)(H + (size_t)(blk * 64 + j) * DFF + ch) = o;
    }
    asm volatile("s_waitcnt vmcnt(0)" ::: "memory"); __syncthreads();
    if (F.tid == 0) { __builtin_amdgcn_fence(__ATOMIC_ACQUIRE, "agent"); asm volatile("s_waitcnt vmcnt(0)" ::: "memory"); }
    __syncthreads();
}
template <int K> DI void gemm64_sample_phase(Frame& F, const bf16* A  , const bf16* Bt  , const float* baseF  , bf16* XB, float* Xout  , unsigned long long* ssq) {
    static_assert(K % 128 == 0, "K split over 8 waves in 16-wide steps");
    constexpr int KW = K / 8, NS = KW / 16;
    const int w = F.wave, lane = F.lane, kl = lane & 31, h = lane >> 5;
    LAS float* part = (LAS float*)(F.lds + RING_OFF);
    for (int tile = F.bid; tile < 256; tile += F.G) {
        const int x = tile & 7, r = tile >> 3, tm = 4 * (x & 3) + (r & 3), tn = 8 * (x >> 2) + (r >> 2);
        const bf16* ap = A + (size_t)(tm * 64 + kl) * K + w * KW + 8 * h; const bf16* bp = Bt + (size_t)(tn * 64 + kl) * K + w * KW + 8 * h;
        f32x16 acc[2][2];
#pragma unroll
        for (int i = 0; i < 16; ++i) { acc[0][0][i] = 0.f; acc[0][1][i] = 0.f; acc[1][0][i] = 0.f; acc[1][1][i] = 0.f; }
#pragma unroll 8
        for (int s = 0; s < NS; ++s) {
            const bf16x8 a0 = *(const bf16x8*)(ap + 16 * s), a1 = *(const bf16x8*)(ap + (size_t)32 * K + 16 * s);
            const bf16x8 b0 = *(const bf16x8*)(bp + 16 * s), b1 = *(const bf16x8*)(bp + (size_t)32 * K + 16 * s);
            acc[0][0] = MFMA32(a0, b0, acc[0][0]); acc[0][1] = MFMA32(a0, b1, acc[0][1]); acc[1][0] = MFMA32(a1, b0, acc[1][0]); acc[1][1] = MFMA32(a1, b1, acc[1][1]);
        }
        __syncthreads();
#pragma unroll
        for (int rb = 0; rb < 2; ++rb)
#pragma unroll
            for (int cb = 0; cb < 2; ++cb)
#pragma unroll
                for (int i = 0; i < 16; ++i) part[w * 4096 + (rb * 32 + crow(i, h)) * 64 + cb * 32 + kl] = acc[rb][cb][i];
        __syncthreads();
        { const int r = F.tid >> 3, c0 = (F.tid & 7) * 8; float o[8];
#pragma unroll
          for (int j = 0; j < 8; ++j) o[j] = 0.f;
#pragma unroll
          for (int ww = 0; ww < 8; ++ww) { const f32x4 p0 = *(const LAS f32x4*)(part + ww * 4096 + r * 64 + c0), p1 = *(const LAS f32x4*)(part + ww * 4096 + r * 64 + c0 + 4);
              o[0] += p0.x; o[1] += p0.y; o[2] += p0.z; o[3] += p0.w; o[4] += p1.x; o[5] += p1.y; o[6] += p1.z; o[7] += p1.w; }
          const int row = tm * 64 + r; const size_t off = (size_t)row * DM + tn * 64 + c0;
          float bsv[8]; if (baseF) ld8f(baseF + off, bsv); else ld8bf(XB + off, bsv); float sq = 0.f;
#pragma unroll
          for (int j = 0; j < 8; ++j) { o[j] += bsv[j]; sq += o[j] * o[j]; }
          if (Xout) store8f(Xout + off, o);
          else { v4u pk; pk.x = pk2(o[0], o[1]); pk.y = pk2(o[2], o[3]); pk.z = pk2(o[4], o[5]); pk.w = pk2(o[6], o[7]); *(v4u*)(XB + off) = pk;
              sq = sum8(sq); if ((F.tid & 7) == 0) __hip_atomic_fetch_add(ssq + row, (unsigned long long)(sq * SSQ_SCALE + 0.5f), RLX_AGENT); }
        }
    }
    __syncthreads();
}
struct CmpOrder {
    int G, c;
    DI bool next(int i, pg8::Unit& u) const { const int L = i * G + c; if (L >= CS_ROWS / 256) return false; u.pm = L; u.pn = (L < 128) ? 0 : (L < 256 ? 1 : (L < 264 ? 0 : 1)); return true; }
    DI void a_ready(const pg8::Unit&) const {}
    DI void done(const pg8::Unit&) const {}
};

#ifndef REPSCAN
#define REPSCAN 1
#endif
#ifndef REPATP
#define REPATP 1
#endif
#ifndef REPATS
#define REPATS 1
#endif
DI void sub_barrier(Frame& F, int word, unsigned n, int mode  ) {
    asm volatile("s_waitcnt vmcnt(0)" ::: "memory");
    __syncthreads();
    if (F.tid == 0) {
        unsigned* w = (unsigned*)(F.ctl + word);
        if (mode != 1) { __builtin_amdgcn_fence(__ATOMIC_RELEASE, "agent"); asm volatile("s_waitcnt vmcnt(0)" ::: "memory"); __hip_atomic_fetch_add(w, 1u, RLX_AGENT); }
        unsigned sp = 0;
        while (mode != 2 && __hip_atomic_load(w, RLX_AGENT) < n) { __builtin_amdgcn_s_sleep(2); if (++sp > (1u << 22)) { __hip_atomic_store(F.ctl + CW_TMO, 0xDEAD0000u | (unsigned)word, RLX_AGENT); break; } }
        __builtin_amdgcn_fence(__ATOMIC_ACQUIRE, "agent");
        asm volatile("s_waitcnt vmcnt(0)" ::: "memory");
    }
    __syncthreads();
}
struct CmpOwnOrder {
    int r;
    DI bool next(int i, pg8::Unit& u) const { if (i == 0) { u.pm = r; u.pn = 0; return true; } if (i == 1) { u.pm = 128 + r; u.pn = 1; return true; }
        if (i == 2 && r < 16) { u.pm = 256 + r; u.pn = r >> 3; return true; } return false; }
    DI void a_ready(const pg8::Unit&) const {}
    DI void done(const pg8::Unit&) const {}
};
DI void mix_even_phase(Frame& F, int li, int rep) {
    const int qw = CW_QUEUE + 256 * li + 1024 * rep, sw = 2048 + 256 * (li * 2 + rep);
    const int NSC = 64;
    const int t0 = take_ticket(F, qw);
    if (t0 < NSC) { LAUNDER(F); PROBE_T0(1) scan_prompt_unit(F, t0 >> 3, t0 & 7, li); PROBE_T1(1)
        sub_barrier(F, sw + 128, (unsigned)NSC, 2); }
    else if (t0 < NSC + 128) {
        const int rank = t0 - NSC; LAUNDER(F);
        { pg8::Gemm g{WSP(bf16, WS_CSEG), WSP(bf16, WS_PHI1) + (size_t)li * 512 * 1024, CS_ROWS, 512, 1024};
          CmpOwnOrder S{rank}; EpiPart E{WSP(float, WS_PART)};
          pg8::gemm_phase<EpiPart, CmpOwnOrder, true, true>(F.lds + RING_OFF, g, S, E); }
        if (rank < 16) sub_barrier(F, sw, 16u, 2);
        asm volatile("s_waitcnt vmcnt(0)" ::: "memory"); __syncthreads();
        if (F.tid == 0) { __builtin_amdgcn_fence(__ATOMIC_ACQUIRE, "agent"); asm volatile("s_waitcnt vmcnt(0)" ::: "memory"); }
        __syncthreads(); LAUNDER(F);
        compress2_stage_w2(F, li);
        compress2_unit(F, 2 * rank, li); compress2_unit(F, 2 * rank + 1, li);
        if (rank < 16) { sub_barrier(F, sw, 16u, 1); LAUNDER(F); compress2_unit(F, 256 + rank, li); sub_barrier(F, sw + 64, 16u, 2); }
        asm volatile("s_waitcnt vmcnt(0)" ::: "memory"); __syncthreads();
        if (F.tid == 0) { __builtin_amdgcn_fence(__ATOMIC_ACQUIRE, "agent"); asm volatile("s_waitcnt vmcnt(0)" ::: "memory"); }
        __syncthreads();
        for (int g = 0; g < 2; ++g) { LAUNDER(F); PROBE_T0(4) attn_sample_unit(F, rank, g, li); PROBE_T1(4) }
    }
    else { LAUNDER(F); }
    for (int r2 = 0; r2 < REPSCAN; ++r2) for (;;) { const int u = take_ticket(F, qw + 64 + 2048 * r2); if (u >= DB) break; LAUNDER(F); PROBE_T0(9) scan_sample_unit(F, u, li); PROBE_T1(9) }
    sub_barrier(F, sw + 64, 16u, 1); LAUNDER(F);
    for (int r2 = 0; r2 < REPATP; ++r2) for (;;) { const int u = take_ticket(F, qw + 128 + 2048 * r2); if (u >= 512) break; LAUNDER(F);
        const int bg = u & 15, c = 31 - (u >> 4);
        PROBE_T0(3) attn_prompt_unit(F, bg >> 1, bg & 1, c, li); PROBE_T1(3) }
    sub_barrier(F, sw + 128, (unsigned)NSC, 1); LAUNDER(F);
    scan_post_phase(F, li);
}

#ifndef MK_PER_PHASE
#define MK_PER_PHASE 0
#endif
constexpr int PH_PER_LAYER = 12, N_PHASES = 1 + DEPTH * PH_PER_LAYER;
#ifndef REP0
#define REP0 1
#endif
#ifndef REP1
#define REP1 1
#endif
#ifndef REP3
#define REP3 1
#endif
#ifndef REP4
#define REP4 1
#endif
#ifndef REP6
#define REP6 1
#endif
#ifndef REP7
#define REP7 1
#endif
#ifndef REP8
#define REP8 1
#endif
__global__ void __launch_bounds__(NTHREADS, 2) mk_fwd(Args args) {
    Frame F;
    F.lds = (LAS unsigned char*)g_lds;
    F.MISC = (volatile LAS unsigned*)(F.lds + MISC_OFF);
    F.tid = threadIdx.x; F.lane = F.tid & 63; F.wave = __builtin_amdgcn_readfirstlane(F.tid >> 6);
    F.G = gridDim.x; F.bid = blockIdx.x;
    F.out = (GAS float*)args.out; F.ws = (GAS unsigned char*)args.ws; F.ctl = (gu32*)(args.ws + WS_CTL); F.ka = (unsigned long long)__builtin_amdgcn_kernarg_segment_ptr();
    for (int u = F.tid; u < (LDS_BYTES - LDSCTL_OFF) / 4; u += NTHREADS) ((LAS unsigned*)(F.lds + LDSCTL_OFF))[u] = 0u;
    __syncthreads();
    XcdBarrier bar; bar.bar = (unsigned*)(F.ctl + CW_BAR); bar.x = 0; bar.st = nullptr;
    if (!MK_PER_PHASE) bar = xcd_barrier_post((unsigned*)(F.ctl + CW_BAR), F.MISC + 8);
    const int lo = args.ph_lo, hi = args.ph_hi;
#define IN(k) (lo <= (k) && (k) < hi)
#define SEAM(k) do { if (IN((k) + 1)) { if (MK_PER_PHASE) { if (F.tid == 0) __hip_atomic_store(F.ctl + CW_TMO, 0xBADBA0u, RLX_AGENT); } else { asm volatile("" : "+s"(bar.bar)); asm volatile("" : "+s"(bar.x)); xcd_barrier(bar); } } } while (0)
    LAS unsigned char* ring = F.lds + RING_OFF;

    if (IN(0)) { LAUNDER(F); PROBE_T0(7) p0_prologue(F); SEAM(0); PROBE_T1(7) }

    for (int l = 0; l < DEPTH; ++l) {
        const int li = l >> 1; const bool even = (l & 1) == 0; const int pb = 1 + l * PH_PER_LAYER;
        if (IN(pb + 0)) for (int rep = 0; rep < REP0; ++rep) { LAUNDER(F); PROBE_T0(11)
            constexpr int NGEMM = 224, BG_QUOTA = 3;
            const int N = even ? NE : NO;
            if (F.G == 256 && l < 3 && F.bid >= NGEMM) { bg_units(F, l == 0 ? 0 : 1, BG_QUOTA); }
            else {
            const int gg = (F.G == 256 && l < 3) ? NGEMM : F.G;
            pg8::Gemm g{WSP(bf16, WS_XN), even ? WSP(bf16, WS_WIE) + (size_t)li * NE * DM : WSP(bf16, WS_WIO) + (size_t)li * NO * DM, MT, N, DM};
            pg8::StaticOrder S; S.init(MT, N, gg, F.bid);
            EpiStoreBf16 E{WSP(bf16, WS_ZB), N};
            pg8::gemm_phase<EpiStoreBf16, pg8::StaticOrder, true, true>(ring, g, S, E);
            }
            SEAM(pb + 0); PROBE_T1(11)
        }
        if (IN(pb + 1)) for (int rep = 0; rep < REP1; ++rep) { LAUNDER(F); PROBE_T0(5) PROBE_T0(10) if (even) { post_even_phase(F, li, l); SEAM(pb + 1); PROBE_T1(5) } else { odd_mix_phase(F, li, l); SEAM(pb + 1); PROBE_T1(10) } }
        if (even) {
            if (IN(pb + 2)) { LAUNDER(F); PROBE_T0(15)
                { int kdim = KLORA; asm volatile("" : "+s"(kdim));
                  pg8::Gemm g{WSP(bf16, WS_LA), WSP(bf16, WS_LORA) + (size_t)li * NLORA * KLORA, MT, NLORA, kdim};
                  pg8::StaticOrder S; S.init(MT, NLORA, F.G, F.bid);
                  EpiLora E{WSP(unsigned char, WS_SC), WSP(float, WS_G), KIN(I_W0) + li * 512, KIN(I_A0) + li * 512};
                  pg8::gemm_phase<EpiLora, pg8::StaticOrder, true, true>(ring, g, S, E); }
                SEAM(pb + 2); PROBE_T1(15)
            }
            if (IN(pb + 4)) for (int rep = 0; rep < REP4; ++rep) { LAUNDER(F); PROBE_T0(2) mix_even_phase(F, li, rep); SEAM(pb + 4); PROBE_T1(2) }
        }
        if (IN(pb + 6)) { LAUNDER(F); PROBE_T0(12)
            const bf16* Wt = even ? WSP(bf16, WS_WOE) + (size_t)li * DM * DM : WSP(bf16, WS_WOO) + (size_t)li * DM * DM;
            pg8::Gemm g{WSP(bf16, WS_MIX), Wt, MP, DM, DM};
            pg8::StaticOrder S; S.init(MP, DM, F.G, F.bid);
            EpiResid E{l == 0 ? KIN(I_XP) : nullptr, WSP(bf16, WS_XN), nullptr, SSQP(2 * l + 1)};
            pg8::gemm_phase<EpiResid, pg8::StaticOrder, true, true>(ring, g, S, E);
            __syncthreads(); LAUNDER(F);
            gemm64_sample_phase<DM>(F, WSP(bf16, WS_MIX) + (size_t)MP * DM, Wt, l == 0 ? KIN(I_XS) : nullptr, WSP(bf16, WS_XN) + (size_t)MP * DM, nullptr, SSQP(2 * l + 1) + MP);
            SEAM(pb + 6); PROBE_T1(12)
        }
        if (IN(pb + 8)) for (int rep = 0; rep < REP7; ++rep) { LAUNDER(F); PROBE_T0(13)
            pg8::Gemm g{WSP(bf16, WS_XN), WSP(bf16, WS_WUP) + (size_t)l * NUP * DM, MT, NUP, DM};
            pg8::StaticOrder S; S.init(MT, NUP, F.G, F.bid);
            EpiFfnAct E{WSP(bf16, WS_H), WSP(float, WS_HALO), KIN(I_FCONV) + (size_t)l * 3 * DFF, SSQP(2 * l + 1), KIN(I_SFFN) + (size_t)l * 2 * DFF, OUTF + O_FFP, OUTF + O_FFS, l};
            pg8::gemm_phase<EpiFfnAct, pg8::StaticOrder, true, true>(ring, g, S, E);
            SEAM(pb + 8); PROBE_T1(13)
        }
        if (IN(pb + 10)) { LAUNDER(F); PROBE_T0(14)
            pg8::Gemm g{WSP(bf16, WS_H), WSP(bf16, WS_WDN) + (size_t)l * DM * DFF, MP, DM, DFF};
            pg8::StaticOrder S; S.init(MP, DM, F.G, F.bid);
            for (int i = 0;; ++i) {
                const int nM = MP / 256, nN = DM / 256, nwg = nM * nN; const long L = (long)i * F.G + F.bid; if (L >= nwg) break;
                int wgid = (int)L; { const int q = nwg / 8, r = nwg % 8, xcd = wgid % 8, off = wgid / 8; wgid = (xcd < r ? xcd * (q + 1) : r * (q + 1) + (xcd - r) * q) + off; }
                const int nig = 8 * nN, gid = wgid / nig, fm = gid * 8, gsz = (nM - fm) < 8 ? (nM - fm) : 8;
                ffn_fix_panel(F, l, fm + ((wgid % nig) % gsz)); }
            LAUNDER(F);
            EpiResid E{nullptr, WSP(bf16, WS_XN), l + 1 < DEPTH ? nullptr : OUTF, SSQP(2 * l + 2 < 8 ? 2 * l + 2 : 0)};
            pg8::gemm_phase<EpiResid, pg8::StaticOrder, true, true>(ring, g, S, E);
            __syncthreads(); LAUNDER(F);
            gemm64_sample_phase<DFF>(F, WSP(bf16, WS_H) + (size_t)MP * DFF, WSP(bf16, WS_WDN) + (size_t)l * DM * DFF, nullptr, WSP(bf16, WS_XN) + (size_t)MP * DM, l + 1 < DEPTH ? nullptr : OUTF + (size_t)MP * DM, SSQP(2 * l + 2 < 8 ? 2 * l + 2 : 0) + MP);
            if (l + 1 < DEPTH) SEAM(pb + 10); PROBE_T1(14)
        }
    }
#undef IN
#undef SEAM
#ifdef PROBE_SUM
    if (PROBE_ID != 0) { __syncthreads(); if (F.tid == 0) __hip_atomic_fetch_add((unsigned*)(F.ctl + 40), (unsigned)F.MISC[20], RLX_AGENT);
        asm volatile("" : "+s"(bar.bar)); asm volatile("" : "+s"(bar.x)); xcd_barrier(bar);
        if (F.bid == 0 && F.tid == 0) { const unsigned long long t0 = __builtin_amdgcn_s_memrealtime(), dt = (unsigned long long)__hip_atomic_load((unsigned*)(F.ctl + 40), RLX_AGENT) * PROBE_MUL / 256;
            while (__builtin_amdgcn_s_memrealtime() - t0 < dt) __builtin_amdgcn_s_sleep(8); } }
#else
    if (PROBE_ID != 0) { __syncthreads(); if (F.tid == 0) { const unsigned long long t0 = __builtin_amdgcn_s_memrealtime(), dt = (unsigned long long)F.MISC[20] * PROBE_MUL;
        while (__builtin_amdgcn_s_memrealtime() - t0 < dt) __builtin_amdgcn_s_sleep(8); } }
#endif
}

extern "C" void kernel_launch(void* const* d_in, const int* in_sizes, int n_in, void* d_out, int out_size, void* d_ws, size_t ws_size, hipStream_t stream) {
    static int grid = 0;
    if (grid == 0) {
        if (n_in != N_IN || (size_t)out_size != O_END || ws_size < WS_END) { fprintf(stderr, "kernel_launch: unexpected shapes: n_in %d out %d ws %zu (need %zu)\n", n_in, out_size, ws_size, (size_t)WS_END); grid = -1; return; }
        int dev = 0, cus = 0, per_cu = 0;
        if (hipGetDevice(&dev) != hipSuccess || hipDeviceGetAttribute(&cus, hipDeviceAttributeMultiprocessorCount, dev) != hipSuccess) { grid = -1; return; }
        if (hipFuncSetAttribute((const void*)mk_fwd, hipFuncAttributeMaxDynamicSharedMemorySize, LDS_BYTES) != hipSuccess) { fprintf(stderr, "kernel_launch: hipFuncSetAttribute failed\n"); grid = -1; return; }
        if (hipOccupancyMaxActiveBlocksPerMultiprocessor(&per_cu, (const void*)mk_fwd, NTHREADS, LDS_BYTES) != hipSuccess || per_cu < 1) { fprintf(stderr, "kernel_launch: occupancy query says %d\n", per_cu); }
        (void)hipGetLastError();
        grid = cus;
        if (cus != 256) { fprintf(stderr, "kernel_launch: built for a 256-CU device (the mix phase splits the grid 128 + 128), found %d CUs\n", cus); if (cus > 256) grid = 256; }
    }
    if (grid < 0) return;
    if (hipMemsetAsync((char*)d_ws + WS_CTL, 0, CTL_RESERVED, stream) != hipSuccess) return;
    Args a{};
    for (int i = 0; i < N_IN; ++i) a.in[i] = (const float*)d_in[i];
    a.out = (float*)d_out; a.ws = (unsigned char*)d_ws;
#if MK_PER_PHASE
    for (int p = 0; p < N_PHASES; ++p) {
        if (p > 0) { const int l = (p - 1) / PH_PER_LAYER, q = (p - 1) % PH_PER_LAYER; if ((l & 1) && q >= 2 && q <= 5) continue; if (l == DEPTH - 1 && q == 11) continue; }
        a.ph_lo = p; a.ph_hi = p + 1;
        hipLaunchKernelGGL(mk_fwd, dim3(grid), dim3(NTHREADS), LDS_BYTES, stream, a);
    }
#else
    a.ph_lo = 0; a.ph_hi = N_PHASES;
    hipLaunchKernelGGL(mk_fwd, dim3(grid), dim3(NTHREADS), LDS_BYTES, stream, a);
#endif
    const hipError_t le = hipPeekAtLastError();
    if (le != hipSuccess) fprintf(stderr, "kernel_launch: launch failed: %s\n", hipGetErrorName(le));
}
```

```cpp
#include <hip/hip_runtime.h>
#include <cstdio>
#include <cstdint>

namespace pg8 {
#define PG8_LAS __attribute__((address_space(3)))
typedef unsigned short bf16_t;
typedef short bf16x8 __attribute__((ext_vector_type(8)));
typedef float f32x4 __attribute__((ext_vector_type(4)));
typedef unsigned u32x4 __attribute__((ext_vector_type(4)));
constexpr int BM = 256, BK = 64, HALF = 128, HTB = HALF * BK * 2  , STAGE_BYTES = 8 * HTB, NXCD = 8, WGM = 8;

__host__ __device__ __forceinline__ int lds_byte(int r, int c) { const int st = (r >> 4) * 2 + (c >> 5), rr = r & 15, cc = c & 31, ob = rr * 64 + cc * 2; return st * 1024 + (ob ^ (((ob >> 9) & 1) << 5)); }
__host__ __device__ __forceinline__ void stage_rc(int b, int& R, int& C) { const int st = b / 1024, sb = b % 1024, swz = sb ^ (((sb >> 9) & 1) << 5); R = (st >> 1) * 16 + swz / 64; C = (st & 1) * 32 + (swz % 64) / 2; }
__host__ __device__ __forceinline__ int perm32(int rho) { const int n = rho >> 4, i = rho & 15; return 8 * (i >> 2) + 4 * n + (i & 3); }

struct Unit { int pm, pn; };
struct Gemm { const bf16_t* A; const bf16_t* Bt; int M, N, K; };

struct StaticOrder {
    int nM, nN, nwg, G, c;
    __host__ __device__ void init(int M, int N, int G_, int c_) { nM = M / BM; nN = N / BM; nwg = nM * nN; G = G_; c = c_; }
    __host__ __device__ bool next(int i, Unit& u) const {
        const long L = (long)i * G + c; if (L >= nwg) return false;
        int wgid = (int)L; { const int q = nwg / NXCD, r = nwg % NXCD, xcd = wgid % NXCD, off = wgid / NXCD; wgid = (xcd < r ? xcd * (q + 1) : r * (q + 1) + (xcd - r) * q) + off; }
        const int nig = WGM * nN, gid = wgid / nig, fm = gid * WGM, gsz = (nM - fm) < WGM ? (nM - fm) : WGM;
        u.pm = fm + ((wgid % nig) % gsz); u.pn = (wgid % nig) / gsz; return true;
    }
    __device__ __forceinline__ void a_ready(const Unit&) const {}
    __device__ __forceinline__ void done(const Unit&) const {}
};

__device__ __forceinline__ unsigned cvt_pk_bf16(float lo, float hi) { unsigned r; asm volatile("v_cvt_pk_bf16_f32 %0, %1, %2" : "=v"(r) : "v"(lo), "v"(hi)); return r; }
template <class Epi, class Sched, bool ALIGN_EPI = false, bool SP2 = false>
__device__ __forceinline__ void gemm_phase(PG8_LAS unsigned char* lds, const Gemm g, const Sched& S, const Epi& E) {
    int tid_ = threadIdx.x; asm volatile("" : "+v"(tid_));
    const int tid = tid_, wid = __builtin_amdgcn_readfirstlane(tid >> 6), lane = tid & 63, wr = wid >> 2, wc = wid & 3, fr = lane & 15, fq = lane >> 4;
    const int K = g.K, nt = K / BK;
    unsigned voffA[2], voffB[2];
#pragma unroll
    for (int i = 0; i < 2; ++i) { int R, C; stage_rc(tid * 16 + i * 8192, R, C); const int Rb = Epi::PERM ? ((R & ~31) + perm32(R & 31)) : R;
        voffA[i] = (unsigned)(R * K + C) * 2u; voffB[i] = (unsigned)(Rb * K + C) * 2u; }
    const size_t kstep = (size_t)(BK * 2);
    const size_t hstep = (size_t)HALF * K * 2;
    const size_t tstep = 2 * hstep;
    const unsigned ldsw = (unsigned)wid * 1024u;
    const int aoff = lds_byte(wr * 64 + fr, fq * 8), boff = lds_byte(wc * 32 + fr, fq * 8);
#define PG8_SA(b, h) (((b) * 2 + (h)) * HTB)
#define PG8_SB(b, h) ((4 + (b) * 2 + (h)) * HTB)
#define PG8_STAGE(bufoff, gbase, voff) do { _Pragma("unroll") for (int _i = 0; _i < 2; ++_i) \
        __builtin_amdgcn_global_load_lds((const unsigned*)((const char*)(gbase) + (voff)[_i]), (PG8_LAS unsigned*)(lds + (bufoff) + ldsw + _i * 8192), 16, 0, 0); } while (0)
#define PG8_LDA(dst, b, h) do { _Pragma("unroll") for (int m = 0; m < 4; ++m) _Pragma("unroll") for (int k = 0; k < 2; ++k) dst[m][k] = *(const PG8_LAS bf16x8*)(lds + PG8_SA(b, h) + aoff + m * 2048 + k * 1024); } while (0)
#define PG8_LDB(dst, b, h) do { _Pragma("unroll") for (int n = 0; n < 2; ++n) _Pragma("unroll") for (int k = 0; k < 2; ++k) dst[n][k] = *(const PG8_LAS bf16x8*)(lds + PG8_SB(b, h) + boff + n * 2048 + k * 1024); } while (0)
#define PG8_MMA(ai, bj, At, Bt) do { __builtin_amdgcn_s_setprio(1); _Pragma("unroll") for (int m = 0; m < 4; ++m) _Pragma("unroll") for (int n = 0; n < 2; ++n) _Pragma("unroll") for (int k = 0; k < 2; ++k) \
        acc[ai][bj][m][n] = __builtin_amdgcn_mfma_f32_16x16x32_bf16(Bt[n][k], At[m][k], acc[ai][bj][m][n], 0, 0, 0); __builtin_amdgcn_s_setprio(0); } while (0)
#define PG8_WAIT_V(n) asm volatile("s_waitcnt vmcnt(" #n ")" ::: "memory")
#define PG8_WAIT_L(n) asm volatile("s_waitcnt lgkmcnt(" #n ")" ::: "memory")
#define PG8_BAR __builtin_amdgcn_s_barrier()
#define PG8_SCHED __builtin_amdgcn_sched_barrier(0)
    Unit cur, nxt; int ui = 0;
    if (!S.next(0, cur)) return;
    f32x4 acc[2][2][4][2];
#pragma unroll
    for (int a = 0; a < 2; ++a)
#pragma unroll
        for (int b = 0; b < 2; ++b)
#pragma unroll
            for (int m = 0; m < 4; ++m)
#pragma unroll
                for (int n = 0; n < 2; ++n) acc[a][b][m][n] = (f32x4){0.f, 0.f, 0.f, 0.f};
    bf16x8 At[4][2], B0[2][2], B1[2][2];
    const char* cA = (const char*)g.A + (size_t)cur.pm * tstep; const char* cB = (const char*)g.Bt + (size_t)cur.pn * tstep;
    S.a_ready(cur);
    if constexpr (SP2) {
        PG8_STAGE(PG8_SB(0, 0), cB, voffB); PG8_STAGE(PG8_SB(0, 1), cB + hstep, voffB); PG8_STAGE(PG8_SA(0, 0), cA, voffA); PG8_STAGE(PG8_SA(0, 1), cA + hstep, voffA);
        if (wr == 1) PG8_BAR;
        PG8_WAIT_V(2); PG8_BAR;
        PG8_STAGE(PG8_SB(1, 0), cB + kstep, voffB); PG8_STAGE(PG8_SA(1, 0), cA + kstep, voffA); PG8_STAGE(PG8_SB(1, 1), cB + hstep + kstep, voffB);
        PG8_WAIT_V(6); PG8_BAR;
    } else {
        PG8_STAGE(PG8_SB(0, 0), cB, voffB); PG8_STAGE(PG8_SA(0, 0), cA, voffA); PG8_STAGE(PG8_SB(0, 1), cB + hstep, voffB); PG8_STAGE(PG8_SA(0, 1), cA + hstep, voffA);
        if (wr == 1) PG8_BAR;
        PG8_WAIT_V(4); PG8_BAR;
        PG8_STAGE(PG8_SB(1, 0), cB + kstep, voffB); PG8_STAGE(PG8_SA(1, 0), cA + kstep, voffA); PG8_STAGE(PG8_SB(1, 1), cB + hstep + kstep, voffB);
        PG8_WAIT_V(6); PG8_BAR;
    }
    for (;;) {
        const bool has_next = S.next(ui + 1, nxt);
        const char* nA = has_next ? (const char*)g.A + (size_t)nxt.pm * tstep : cA; const char* nB = has_next ? (const char*)g.Bt + (size_t)nxt.pn * tstep : cB;
        for (int t = 0; t < nt; t += 2) {
            const bool last = (t == nt - 2);
            const char* a1 = cA + (size_t)(t + 1) * kstep;
            const char* a2 = last ? nA : cA + (size_t)(t + 2) * kstep; const char* b2 = last ? nB : cB + (size_t)(t + 2) * kstep;
            const char* a3 = a2 + kstep; const char* b3 = b2 + kstep;
            if (last && has_next) S.a_ready(nxt);
            if constexpr (SP2) {
            PG8_LDB(B0, 0, 0); PG8_LDB(B1, 0, 1); PG8_SCHED; PG8_LDA(At, 0, 0); PG8_STAGE(PG8_SA(1, 1), a1 + hstep, voffA);
            PG8_WAIT_V(8); PG8_WAIT_L(0); PG8_BAR; PG8_MMA(0, 0, At, B0); PG8_MMA(0, 1, At, B1); PG8_BAR; PG8_SCHED;
            PG8_LDA(At, 0, 1); PG8_STAGE(PG8_SB(0, 0), b2, voffB); PG8_STAGE(PG8_SB(0, 1), b2 + hstep, voffB); PG8_STAGE(PG8_SA(0, 0), a2, voffA);
            PG8_WAIT_V(8); PG8_WAIT_L(0); PG8_BAR; PG8_MMA(1, 0, At, B0); PG8_MMA(1, 1, At, B1); PG8_BAR; PG8_SCHED;
            PG8_LDB(B0, 1, 0); PG8_LDB(B1, 1, 1); PG8_SCHED; PG8_LDA(At, 1, 0); PG8_STAGE(PG8_SA(0, 1), a2 + hstep, voffA);
            PG8_WAIT_V(8); PG8_WAIT_L(0); PG8_BAR; PG8_MMA(0, 0, At, B0); PG8_MMA(0, 1, At, B1); PG8_BAR; PG8_SCHED;
            PG8_LDA(At, 1, 1); PG8_STAGE(PG8_SB(1, 0), b3, voffB); PG8_STAGE(PG8_SB(1, 1), b3 + hstep, voffB); PG8_STAGE(PG8_SA(1, 0), a3, voffA);
            PG8_WAIT_V(8); PG8_WAIT_L(0); PG8_BAR; PG8_MMA(1, 0, At, B0); PG8_MMA(1, 1, At, B1); PG8_BAR; PG8_SCHED;
            } else {
            PG8_LDB(B0, 0, 0); PG8_SCHED; PG8_LDA(At, 0, 0); PG8_STAGE(PG8_SA(1, 1), a1 + hstep, voffA);
            PG8_WAIT_L(8); PG8_BAR; PG8_WAIT_L(0); PG8_MMA(0, 0, At, B0); PG8_BAR; PG8_SCHED;
            PG8_LDB(B1, 0, 1); PG8_STAGE(PG8_SB(0, 0), b2, voffB);
            PG8_BAR; PG8_WAIT_L(0); PG8_MMA(0, 1, At, B1); PG8_BAR;
            PG8_LDA(At, 0, 1); PG8_STAGE(PG8_SA(0, 0), a2, voffA);
            PG8_BAR; PG8_WAIT_L(0); PG8_MMA(1, 0, At, B0); PG8_BAR; PG8_SCHED;
            PG8_STAGE(PG8_SB(0, 1), b2 + hstep, voffB);
            PG8_WAIT_V(6); PG8_BAR; PG8_MMA(1, 1, At, B1); PG8_BAR;
            PG8_LDB(B0, 1, 0); PG8_SCHED; PG8_LDA(At, 1, 0); PG8_STAGE(PG8_SA(0, 1), a2 + hstep, voffA);
            PG8_WAIT_L(8); PG8_BAR; PG8_WAIT_L(0); PG8_MMA(0, 0, At, B0); PG8_BAR; PG8_SCHED;
            PG8_LDB(B1, 1, 1); PG8_STAGE(PG8_SB(1, 0), b3, voffB);
            PG8_BAR; PG8_WAIT_L(0); PG8_MMA(0, 1, At, B1); PG8_BAR;
            PG8_LDA(At, 1, 1); PG8_STAGE(PG8_SA(1, 0), a3, voffA);
            PG8_BAR; PG8_WAIT_L(0); PG8_MMA(1, 0, At, B0); PG8_BAR; PG8_SCHED;
            PG8_STAGE(PG8_SB(1, 1), b3 + hstep, voffB);
            PG8_WAIT_V(6); PG8_BAR; PG8_MMA(1, 1, At, B1); PG8_BAR;
            }
        }
        if constexpr (ALIGN_EPI) { if (wr == 0) PG8_BAR; }
#if defined(PROBE_ID) && (PROBE_ID >= 16 && PROBE_ID <= 20)
        unsigned long long pt0_ = 0; if (PROBE_ID == Epi::PID) { __builtin_amdgcn_s_barrier(); pt0_ = __builtin_amdgcn_s_memrealtime(); }
#endif
        if constexpr (!Epi::AFTER_DRAIN) { E(acc, cur, wr, wc, fr, fq); S.done(cur); }
#if defined(PROBE_ID) && (PROBE_ID >= 16 && PROBE_ID <= 20)
        if (PROBE_ID == Epi::PID) { asm volatile("s_waitcnt vmcnt(0)" ::: "memory"); __builtin_amdgcn_s_barrier(); if (threadIdx.x == 0) ((volatile PG8_LAS unsigned*)(lds + 131072 + 320))[20] += (unsigned)(__builtin_amdgcn_s_memrealtime() - pt0_); }
#endif
        if (!has_next) break;
#pragma unroll
        for (int a = 0; a < 2; ++a)
#pragma unroll
            for (int b = 0; b < 2; ++b)
#pragma unroll
                for (int m = 0; m < 4; ++m)
#pragma unroll
                    for (int n = 0; n < 2; ++n) acc[a][b][m][n] = (f32x4){0.f, 0.f, 0.f, 0.f};
        cur = nxt; cA = nA; cB = nB; ++ui;
        if constexpr (ALIGN_EPI) { if (wr == 1) PG8_BAR; }
    }
    PG8_WAIT_V(0);
    if constexpr (!ALIGN_EPI) { if (wr == 0) PG8_BAR; }
    PG8_BAR;
    if constexpr (Epi::AFTER_DRAIN) { E.fused(acc, cur, wr, wc, fr, fq, lds, wid, lane); S.done(cur); }
#undef PG8_SA
#undef PG8_SB
#undef PG8_STAGE
#undef PG8_LDA
#undef PG8_LDB
#undef PG8_MMA
#undef PG8_WAIT_V
#undef PG8_WAIT_L
#undef PG8_BAR
#undef PG8_SCHED
}
}

constexpr int DM = 1024, NB = 8, SEQ = 2048, DEPTH = 4, DB = 128, DT = 8, PAST = 2048, PAGE = 128, NPAGE = 16, NPOOL = 2560;
constexpr int HD = 64, NCMP = 127, WIN = 512;
constexpr int MP = NB * SEQ, MS = DB * DT, MT = MP + MS;
constexpr int NE_ORIG = 3096, NE = 3328, RWP = 1792, NO = 3072, DFF = 2816, NUP = 2 * DFF;
constexpr int NLORA = 1536, KLORA = 256;
constexpr float RMS_EPS = 1e-6f, GN_EPS = 64e-5f, LOG2E = 1.4426950408889634f;
constexpr int NWAVES = 8, NTHREADS = 512;

enum { I_XP = 0, I_XS, I_CCMP, I_CSLC, I_CWIN, I_SWKV, I_SSHIFT, I_SCONV, I_SFFN, I_PT, I_NMIX, I_NFFN, I_RELB, I_WINE, I_WOUTE, I_QN, I_KN,
       I_PPE, I_PW1, I_PW2, I_MU, I_W0, I_W2, I_A0, I_A2, I_G2, I_KKW, I_KA, I_RK, I_LNW, I_LNB, I_WINO, I_CONVW, I_WOUTO, I_FUP, I_FCONV, I_FDOWN, N_IN };

constexpr size_t O_YP = 0, O_YS = O_YP + (size_t)MP * DM, O_CMPP = O_YS + (size_t)MS * DM, O_CMPS = O_CMPP + (size_t)NB * 2 * SEQ * 256,
    O_SLCP = O_CMPS + (size_t)DB * 2 * DT * 256, O_SLCS = O_SLCP + (size_t)NB * 2 * SEQ * 256, O_WINP = O_SLCS + (size_t)DB * 2 * DT * 256,
    O_WINS = O_WINP + (size_t)NB * 2 * WIN * 256, O_WKVP = O_WINS + (size_t)DB * 2 * WIN * 256, O_WKVS = O_WKVP + (size_t)NB * 2 * 8 * 4096,
    O_SHP = O_WKVS + (size_t)DB * 2 * 8 * 4096, O_SHS = O_SHP + (size_t)NB * 2 * RWP, O_CVP = O_SHS + (size_t)DB * 2 * RWP, O_CVS = O_CVP + (size_t)NB * 2 * 2 * DM,
    O_FFP = O_CVS + (size_t)DB * 2 * 2 * DM, O_FFS = O_FFP + (size_t)NB * 4 * 2 * DFF, O_END = O_FFS + (size_t)DB * 4 * 2 * DFF;

constexpr size_t al256(size_t x) { return (x + 255) & ~(size_t)255; }
constexpr size_t WS_CTL = 0, CTL_ZERO_BYTES = 1u << 20, CTL_RESERVED = 2u << 20;
constexpr size_t WS_WIE = CTL_RESERVED;
constexpr size_t WS_WOE = WS_WIE + (size_t)2 * NE * DM * 2;
constexpr size_t WS_WIO = WS_WOE + (size_t)2 * DM * DM * 2;
constexpr size_t WS_WOO = WS_WIO + (size_t)2 * NO * DM * 2;
constexpr size_t WS_WUP = WS_WOO + (size_t)2 * DM * DM * 2;
constexpr size_t WS_WDN = WS_WUP + (size_t)4 * NUP * DM * 2;
constexpr size_t WS_PHI1 = WS_WDN + (size_t)4 * DM * DFF * 2;
constexpr size_t WS_LORA = WS_PHI1 + (size_t)2 * 512 * 1024 * 2;
constexpr size_t WS_PEC = WS_LORA + (size_t)2 * NLORA * KLORA * 2;
constexpr size_t WS_XN = al256(WS_PEC + 4 * 128 * 4);
constexpr size_t WS_ZB = WS_XN + (size_t)MT * DM * 2;
constexpr size_t WS_QB = WS_ZB + (size_t)MT * NUP * 2;
constexpr size_t WS_CSEG = WS_QB + (size_t)MT * 512 * 2;
constexpr int CS_SK = 0, CS_SV = 32768, CS_PK = 65536, CS_PV = 67584, CS_ROWS = 69632;
constexpr size_t WS_PART = WS_CSEG + (size_t)CS_ROWS * 1024 * 2;
constexpr size_t WS_KC = WS_PART + (size_t)CS_ROWS * 256 * 4;
constexpr size_t WS_VCT = WS_KC + (size_t)272 * 128 * 64 * 2;
constexpr size_t WS_KS = WS_VCT + (size_t)272 * 128 * 64 * 2;
constexpr size_t WS_KW = WS_KS + (size_t)NB * 2 * SEQ * 64 * 2;
constexpr size_t WS_VST = WS_KW + (size_t)NB * 2 * SEQ * 64 * 2;
constexpr size_t WS_VWT = WS_VST + (size_t)NB * 2 * SEQ * 64 * 2;
constexpr size_t WS_GATE = WS_VWT + (size_t)NB * 2 * SEQ * 64 * 2;
constexpr size_t WS_SC = WS_GATE + (size_t)MT * 32 * 4;
constexpr int SCR_BYTES = 896, SCR_KK = 256, SCR_A = 384, SCR_K = 512, SCR_R = 640, SCR_V = 768;
#define SCREC(row, h) ((unsigned char*)(F.ws + WS_SC + ((size_t)(row) * 8 + (h)) * SCR_BYTES))
constexpr size_t WS_G = WS_SC + (size_t)MT * 8 * 6 * 64 * 4;
constexpr size_t WS_LA = WS_G + (size_t)MT * 512 * 4;
constexpr size_t WS_MIX = WS_LA + (size_t)MT * 256 * 2;
constexpr size_t WS_H = WS_MIX + (size_t)MT * DM * 2;
constexpr size_t WS_YRAW = WS_H + (size_t)MT * DFF * 2;
constexpr size_t WS_HALO = WS_YRAW + (size_t)MP * 512 * 4;
constexpr size_t WS_PECP = WS_HALO + (size_t)256 * 6 * DFF * 4;
constexpr size_t WS_END = WS_PECP + (size_t)32 * 512 * 4;

constexpr int CW_TMO = 0, CW_CODE = 1;
constexpr int CW_QUEUE = 64;
constexpr int CW_BAR = 4096;
constexpr size_t CTL_SSQ_BYTE = 65536; constexpr float SSQ_SCALE = 1048576.f;
static_assert(CTL_SSQ_BYTE + (size_t)8 * MT * 8 <= CTL_ZERO_BYTES * 2, "SSQ inside the memset region");
#define SSQP(k) ((unsigned long long*)(F.ws + WS_CTL + CTL_SSQ_BYTE) + (size_t)(k) * MT)


constexpr int RING_OFF = 0, RING_BYTES = 131072;
constexpr int LDSCTL_OFF = RING_BYTES, MISC_OFF = LDSCTL_OFF + 320;
constexpr int LDS_BYTES = 147456;

#define GAS __attribute__((address_space(1)))
#define LAS __attribute__((address_space(3)))
typedef unsigned short bf16;
typedef unsigned v4u __attribute__((ext_vector_type(4)));
typedef unsigned v2u __attribute__((ext_vector_type(2)));
typedef float f32x4 __attribute__((ext_vector_type(4)));
typedef float f32x2 __attribute__((ext_vector_type(2)));
typedef float f32x16 __attribute__((ext_vector_type(16)));
typedef short bf16x8 __attribute__((ext_vector_type(8)));
typedef GAS unsigned gu32;
#define RLX_AGENT __ATOMIC_RELAXED, __HIP_MEMORY_SCOPE_AGENT
#define LDS_WAIT() asm volatile("s_waitcnt lgkmcnt(0)" ::: "memory")
#define VM_WAIT() asm volatile("s_waitcnt vmcnt(0)" ::: "memory")
#define DI __device__ __forceinline__
#define MFMA32(a, b, c) __builtin_amdgcn_mfma_f32_32x32x16_bf16((a), (b), (c), 0, 0, 0)

DI float bf2f(unsigned b) { return __builtin_bit_cast(float, b << 16); }
DI float bflo(unsigned w) { return __builtin_bit_cast(float, w << 16); }
DI float bfhi(unsigned w) { return __builtin_bit_cast(float, w & 0xffff0000u); }
DI unsigned pk2(float lo, float hi) {
    typedef __bf16 bf2v __attribute__((ext_vector_type(2)));
    f32x2 v = {lo, hi}; bf2v r = __builtin_convertvector(v, bf2v); return __builtin_bit_cast(unsigned, r);
}
DI float rbf(float x) { return bflo(pk2(x, 0.f) & 0xffffu); }
DI float fexp2(float x) { return __builtin_amdgcn_exp2f(x); }
DI float fexp(float x) { return __builtin_amdgcn_exp2f(x * LOG2E); }
DI float frcp(float x) { return __builtin_amdgcn_rcpf(x); }
DI float sigmoidf_(float x) { return __builtin_amdgcn_rcpf(1.0f + __expf(-x)); }
DI float tanhf_(float x) { const float e = __expf(2.0f * x); return 1.0f - 2.0f * __builtin_amdgcn_rcpf(e + 1.0f); }
template <int CTRL> DI float dppf(float x) { return __builtin_bit_cast(float, __builtin_amdgcn_mov_dpp(__builtin_bit_cast(int, x), CTRL, 0xf, 0xf, true)); }
template <int CTRL> DI unsigned dppu(unsigned x) { return (unsigned)__builtin_amdgcn_mov_dpp((int)x, CTRL, 0xf, 0xf, true); }
constexpr int XOR1 = 0xB1, XOR2 = 0x4E, HMIR = 0x141, ROR8 = 0x128;
DI float sum4(float v) { v += dppf<XOR1>(v); v += dppf<XOR2>(v); return v; }
DI float sum8(float v) { v = sum4(v); v += dppf<HMIR>(v); return v; }
DI float sum16(float v) { v = sum8(v); v += dppf<ROR8>(v); return v; }
DI float wave_sum(float v) {
#pragma unroll
    for (int o = 1; o < 64; o <<= 1) v += __shfl_xor(v, o);
    return v;
}
DI float rinv_of(const unsigned long long* ssq, int row) { return __builtin_amdgcn_rsqf((float)ssq[row] * (1.f / (SSQ_SCALE * DM)) + RMS_EPS); }
DI int crow(int i, int h) { return (i & 3) + 8 * (i >> 2) + 4 * h; }

#define XB_TMO      128
#define XB_XCNT(j)  (256  + 64 * (j))
#define XB_XSUB(j)  (1280 + 64 * (j))
#define XB_XGEN(j)  (2304 + 64 * (j))
#define XB_TOP      3328
#define XB_TOPGEN   3392
#define XCD_BAR_WORDS 3456
#define XB_SPIN_CAP (1u << 18)

__device__ __forceinline__ unsigned xb_ld(unsigned* p)              { return __hip_atomic_load(p, __ATOMIC_RELAXED, __HIP_MEMORY_SCOPE_AGENT); }
__device__ __forceinline__ unsigned xb_add(unsigned* p, unsigned v) { return __hip_atomic_fetch_add(p, v, __ATOMIC_RELAXED, __HIP_MEMORY_SCOPE_AGENT); }
__device__ __forceinline__ unsigned xb_xcc_id() { return (unsigned)__builtin_amdgcn_s_getreg((3 << 11) | 20) & 0xFu; }
#define XB_SPIN(cond, bar) do { unsigned _sp = 0; while (cond) { __builtin_amdgcn_s_sleep(1); \
    if ((++_sp & 255u) == 0u) { if (xb_ld(&(bar)[XB_TMO])) break; if (_sp > XB_SPIN_CAP) { atomicAdd(&(bar)[XB_TMO], 1u); break; } } } } while (0)

struct XcdBarrier { unsigned* bar; unsigned x; volatile LAS unsigned* st; };

__device__ __forceinline__ XcdBarrier xcd_barrier_post(unsigned* bar, volatile LAS unsigned* st) {
    XcdBarrier b; b.bar = bar; b.x = xb_xcc_id(); b.st = st;
    if (threadIdx.x == 0) (void)xb_add(&bar[XB_XCNT(b.x)], 1u);
    return b;
}
__device__ __forceinline__ void xcd_barrier_complete(unsigned* bar, unsigned x, unsigned& nloc, unsigned& nx) {
    const unsigned G = gridDim.x * gridDim.y * gridDim.z;
    unsigned sum, cnt, mine, sp = 0u;
    for (;;) {
        sum = 0u; cnt = 0u; mine = 0u;
#pragma unroll
        for (unsigned j = 0; j < 16; ++j) { const unsigned c = xb_ld(&bar[XB_XCNT(j)]); sum += c; cnt += (c > 0u) ? 1u : 0u; mine = (j == x) ? c : mine; }
        if (sum == G) break;
        __builtin_amdgcn_s_sleep(1);
        if ((++sp & 255u) == 0u) { if (xb_ld(&bar[XB_TMO])) break; if (sp > XB_SPIN_CAP) { atomicAdd(&bar[XB_TMO], 1u); break; } }
    }
    nloc = mine > 0u ? mine : 1u; nx = cnt > 0u ? cnt : 1u;
}
__device__ __forceinline__ void xcd_barrier(const XcdBarrier& b) {
    asm volatile("s_waitcnt vmcnt(0)" ::: "memory");
    __syncthreads();
    if (threadIdx.x == 0) {
        unsigned* bar = b.bar;
        __builtin_amdgcn_s_waitcnt(0);
        unsigned nloc = b.st[0], nx = b.st[1];
        if (nloc == 0u) { xcd_barrier_complete(bar, b.x, nloc, nx); b.st[0] = nloc; b.st[1] = nx; }
        const unsigned old = xb_add(&bar[XB_XSUB(b.x)], 1u);
        const unsigned gen = old / nloc;
        if (old + 1u == (gen + 1u) * nloc) {
            __builtin_amdgcn_fence(__ATOMIC_RELEASE, "agent");
            asm volatile("s_waitcnt vmcnt(0)" ::: "memory");
            const unsigned og = xb_add(&bar[XB_TOP], 1u);
            const unsigned tg = og / nx;
            if (og + 1u == (tg + 1u) * nx) xb_add(&bar[XB_TOPGEN], 1u);
            else XB_SPIN(xb_ld(&bar[XB_TOPGEN]) == tg, bar);
            __builtin_amdgcn_fence(__ATOMIC_ACQUIRE, "agent");
            xb_add(&bar[XB_XGEN(b.x)], 1u);
            asm volatile("s_waitcnt vmcnt(0)" ::: "memory");
        } else {
            XB_SPIN(xb_ld(&bar[XB_XGEN(b.x)]) == gen, bar);
            __builtin_amdgcn_fence(__ATOMIC_ACQUIRE, "agent");
            asm volatile("s_waitcnt vmcnt(0)" ::: "memory");
        }
    }
    __syncthreads();
}

struct Frame {
    LAS unsigned char* lds;
    volatile LAS unsigned* MISC;
    gu32* ctl;
    int tid, lane, wave, G, bid;
    GAS float* out;
    GAS unsigned char* ws;
    unsigned long long ka;
};
#define LAUNDER(F) do { asm volatile("" : "+s"((F).ws)); asm volatile("" : "+s"((F).out)); asm volatile("" : "+s"((F).ka)); asm volatile("" : "+s"((F).bid)); asm volatile("" : "+s"((F).G)); asm volatile("" : "+v"((F).tid)); (F).lane = (F).tid & 63; (F).wave = __builtin_amdgcn_readfirstlane((F).tid >> 6); } while (0)
#define WSP(T, off) ((T*)(F.ws + (off)))
#define OUTF ((float*)F.out)
struct Args { const float* in[N_IN]; float* out; unsigned char* ws; int ph_lo, ph_hi; };
struct KArgs { const GAS float* in[N_IN]; GAS float* out; GAS unsigned char* ws; int ph_lo, ph_hi; };
#define KIN(i) ((const float*)(((const __attribute__((address_space(4))) KArgs*)(F.ka))->in[i]))

#ifndef PROBE_ID
#define PROBE_ID 0
#endif
#ifndef PROBE_MUL
#define PROBE_MUL 8
#endif
#define PROBE_T0(id) unsigned long long _pt0_##id = 0; if (PROBE_ID == (id)) { __syncthreads(); _pt0_##id = __builtin_amdgcn_s_memrealtime(); }
#define PROBE_T1(id) if (PROBE_ID == (id)) { __syncthreads(); if (F.tid == 0) F.MISC[20] += (unsigned)(__builtin_amdgcn_s_memrealtime() - _pt0_##id); }
template <class SRC> DI void tr_load(const SRC& src, int N, int item, int lane, float (&tv)[32]) {
    const int nblk = N / 32, kb = item / nblk, nb = item % nblk, k0 = 64 * kb, n0 = 32 * nb;
#pragma unroll
    for (int i = 0; i < 32; ++i) tv[i] = src(k0 + 2 * i + (lane >> 5), n0 + (lane & 31));
}
DI void tr_store(const float (&tv)[32], int K, int N, bf16* WT, LAS float* scr, int item, int lane) {
    const int nblk = N / 32, kb = item / nblk, nb = item % nblk, k0 = 64 * kb, n0 = 32 * nb;
#pragma unroll
    for (int i = 0; i < 32; ++i) scr[(2 * i + (lane >> 5)) * 33 + (lane & 31)] = tv[i];
    LDS_WAIT(); asm volatile("" ::: "memory");
    const int c = lane & 7;
#pragma unroll
    for (int j = 0; j < 4; ++j) { const int n = (lane >> 3) + 8 * j; const LAS float* s = scr + (8 * c) * 33 + n;
        v4u o; o.x = pk2(s[0 * 33], s[1 * 33]); o.y = pk2(s[2 * 33], s[3 * 33]); o.z = pk2(s[4 * 33], s[5 * 33]); o.w = pk2(s[6 * 33], s[7 * 33]);
        *(v4u*)(WT + (size_t)(n0 + n) * K + k0 + 8 * c) = o; }
    LDS_WAIT(); asm volatile("" ::: "memory");
}
template <class SRC> DI void tr_item(const SRC& src, int K, int N, bf16* WT, LAS float* scr, int item, int lane) { float tv[32]; tr_load(src, N, item, lane, tv); tr_store(tv, K, N, WT, scr, item, lane); }
template <class SRC> DI void tr_matrix(const SRC& src, int K, int N, bf16* WT, LAS float* scr, int first, int stride, int count, int lane) {
    if (first >= count) return;
    float cur[32], nxt[32]; tr_load(src, N, first, lane, cur);
    for (int it = first; it < count; it += stride) {
        const bool more = it + stride < count;
        if (more) tr_load(src, N, it + stride, lane, nxt);
        tr_store(cur, K, N, WT, scr, it, lane);
        if (more) {
#pragma unroll
            for (int i = 0; i < 32; ++i) cur[i] = nxt[i]; }
    }
}
struct SrcPlain { const float* W; int N; DI float operator()(int k, int n) const { return W[(size_t)k * N + n]; } };
struct SrcGain { const float* W; int N; const float* g; DI float operator()(int k, int n) const { return W[(size_t)k * N + n] * g[k]; } };
struct SrcWie { const float* W; const float* g; DI float operator()(int k, int n) const {
    int c; if (n < 1280) c = n; else if (n < 3072) c = n + 24; else if (n < 3096) c = n - 3072 + 1280; else c = -1;
    return c < 0 ? 0.f : W[(size_t)k * NE_ORIG + c] * g[k]; } };
struct SrcUp { const float* W; const float* g; DI float operator()(int k, int n) const {
    const int c = ((n >> 7) & 1) * DFF + (n >> 8) * 128 + (n & 127); return W[(size_t)k * NUP + c] * g[k]; } };
struct SrcPhi { const float* W; DI float operator()(int k, int n) const {
    const int kv = n >> 8, r = (n >> 7) & 1, e = n & 127; return W[(size_t)kv * 262144 + (size_t)r * 131072 + (size_t)k * 128 + e]; } };
struct SrcLora { const float *w2, *a2, *g2; DI float operator()(int k, int n) const {
    const int seg = n >> 9, c = n & 511;
    if (seg == 0) return k < 64 ? w2[k * 512 + c] : 0.f;
    if (seg == 1) return (k >= 64 && k < 128) ? a2[(k - 64) * 512 + c] : 0.f;
    return k >= 128 ? g2[(k - 128) * 512 + c] : 0.f; } };

DI void row_to_bf16_ssq(const float* xrow, bf16* orow, unsigned long long* ssq, int lane) {
    const f32x4* xr = (const f32x4*)xrow + lane;
    f32x4 v[4]; float s = 0.f;
#pragma unroll
    for (int j = 0; j < 4; ++j) { v[j] = xr[64 * j]; s += (v[j].x * v[j].x + v[j].y * v[j].y) + (v[j].z * v[j].z + v[j].w * v[j].w); }
    s = wave_sum(s);
    v2u* o8 = (v2u*)orow + lane;
#pragma unroll
    for (int j = 0; j < 4; ++j) { v2u o; o.x = pk2(v[j].x, v[j].y); o.y = pk2(v[j].z, v[j].w); o8[64 * j] = o; }
    if (lane == 0) *ssq = (unsigned long long)(s * SSQ_SCALE + 0.5f);
}
DI const float* xin_row(Frame& F, int row) { return row < MP ? KIN(I_XP) + (size_t)row * DM : KIN(I_XS) + (size_t)(row - MP) * DM; }

DI void p0_prologue(Frame& F) {
    LAS float* scr = (LAS float*)(F.lds + RING_OFF + F.wave * 16384);
    const int gw = F.bid * NWAVES + F.wave, NGW = F.G * NWAVES, lane = F.lane;
    constexpr int I_WIE = 16 * (NE / 32), I_SQ = 16 * 32, I_WIO = 16 * (NO / 32), I_UP = 16 * (NUP / 32), I_DN = (DFF / 64) * 32, I_PHI = 16 * 16, I_LORA = 4 * (NLORA / 32);
    int rot = 0;
#define TR_MAT(srcexpr, K_, N_, dst, cnt) do { auto s_ = srcexpr; const int f_ = (gw + NGW - (rot % NGW)) % NGW; tr_matrix(s_, K_, N_, dst, scr, f_, NGW, cnt, lane); rot += (cnt); } while (0)
    for (int li = 0; li < 2; ++li) TR_MAT((SrcWie{KIN(I_WINE) + (size_t)li * DM * NE_ORIG, KIN(I_NMIX) + (2 * li) * DM}), DM, NE, WSP(bf16, WS_WIE) + (size_t)li * NE * DM, I_WIE);
    for (int li = 0; li < 2; ++li) TR_MAT((SrcPlain{KIN(I_WOUTE) + (size_t)li * DM * DM, DM}), DM, DM, WSP(bf16, WS_WOE) + (size_t)li * DM * DM, I_SQ);
    for (int li = 0; li < 2; ++li) TR_MAT((SrcGain{KIN(I_WINO) + (size_t)li * DM * NO, NO, KIN(I_NMIX) + (2 * li + 1) * DM}), DM, NO, WSP(bf16, WS_WIO) + (size_t)li * NO * DM, I_WIO);
    for (int li = 0; li < 2; ++li) TR_MAT((SrcPlain{KIN(I_WOUTO) + (size_t)li * DM * DM, DM}), DM, DM, WSP(bf16, WS_WOO) + (size_t)li * DM * DM, I_SQ);
    for (int l = 0; l < 4; ++l) TR_MAT((SrcUp{KIN(I_FUP) + (size_t)l * DM * NUP, KIN(I_NFFN) + l * DM}), DM, NUP, WSP(bf16, WS_WUP) + (size_t)l * NUP * DM, I_UP);
    for (int l = 0; l < 4; ++l) TR_MAT((SrcPlain{KIN(I_FDOWN) + (size_t)l * DFF * DM, DM}), DFF, DM, WSP(bf16, WS_WDN) + (size_t)l * DM * DFF, I_DN);
    for (int li = 0; li < 2; ++li) TR_MAT((SrcPhi{KIN(I_PW1) + (size_t)li * 2 * 262144}), 1024, 512, WSP(bf16, WS_PHI1) + (size_t)li * 512 * 1024, I_PHI);
    for (int li = 0; li < 2; ++li) TR_MAT((SrcLora{KIN(I_W2) + (size_t)li * 64 * 512, KIN(I_A2) + (size_t)li * 64 * 512, KIN(I_G2) + (size_t)li * 128 * 512}), KLORA, NLORA, WSP(bf16, WS_LORA) + (size_t)li * NLORA * KLORA, I_LORA);
#undef TR_MAT
    if (F.wave == NWAVES - 1 && F.bid < 256) { const int q = F.bid, jc = q >> 3, lk = (q >> 1) & 3, e = (q & 1) * 64 + lane; const float* pe = KIN(I_PPE) + (size_t)lk * 2048 + jc * 64; const float* w1 = KIN(I_PW1) + (size_t)lk * 262144 + (size_t)jc * 64 * 128;
        float a = 0.f;
#pragma unroll 16
        for (int jd = 0; jd < 64; ++jd) a += pe[jd] * w1[(size_t)jd * 128 + e];
        WSP(float, WS_PECP)[(jc * 4 + lk) * 128 + e] = a; }
    for (int m = gw; m < MT; m += NGW) row_to_bf16_ssq(xin_row(F, m), WSP(bf16, WS_XN) + (size_t)m * DM, SSQP(0) + m, lane);
}

DI void store8f(float* p, const float (&v)[8]) { *(f32x4*)p = (f32x4){v[0], v[1], v[2], v[3]}; *(f32x4*)(p + 4) = (f32x4){v[4], v[5], v[6], v[7]}; }
DI void ld8bf(const bf16* p, float (&v)[8]) { const v4u w = *(const v4u*)p; v[0] = bflo(w.x); v[1] = bfhi(w.x); v[2] = bflo(w.y); v[3] = bfhi(w.y); v[4] = bflo(w.z); v[5] = bfhi(w.z); v[6] = bflo(w.w); v[7] = bfhi(w.w); }
DI void ld8f(const float* p, float (&v)[8]) { const f32x4 a = *(const f32x4*)p, b = *(const f32x4*)(p + 4); v[0] = a.x; v[1] = a.y; v[2] = a.z; v[3] = a.w; v[4] = b.x; v[5] = b.y; v[6] = b.z; v[7] = b.w; }

struct RowRawA { v4u q; v2u kv[3]; unsigned gate; unsigned long long sq; };
struct RowRawB { v4u z[4]; unsigned long long sq; };
DI RowRawA load_row_a(const bf16* zr, const unsigned long long* sq, int lane) { RowRawA r; r.sq = *sq; r.q = *(const v4u*)(zr + lane * 8);
#pragma unroll
    for (int c = 0; c < 3; ++c) r.kv[c] = *(const v2u*)(zr + 512 + c * 256 + lane * 4);
    r.gate = zr[3072 + lane]; return r; }
DI RowRawB load_row_b(const bf16* zr, const unsigned long long* sq, int lane) { RowRawB r; r.sq = *sq;
#pragma unroll
    for (int p = 0; p < 4; ++p) r.z[p] = *(const v4u*)(zr + 1280 + p * 512 + lane * 8);
    return r; }
DI void unpk8(const v4u w, float (&v)[8]) { v[0] = bflo(w.x); v[1] = bfhi(w.x); v[2] = bflo(w.y); v[3] = bfhi(w.y); v[4] = bflo(w.z); v[5] = bfhi(w.z); v[6] = bflo(w.w); v[7] = bfhi(w.w); }
DI void post_even_run(Frame& F, int li, int l, bool samp, int b, int tbase, int row0, int ntok) {
    const int lane = F.lane;
    LAS bf16* vts = (LAS bf16*)(F.lds + RING_OFF);
    LAS bf16* vtw = vts + 2 * 64 * 66;
    const bf16* ZB = WSP(bf16, WS_ZB);
    float kn1[4], kn2[4];
    { const f32x4 a = *(const f32x4*)(KIN(I_KN) + (li * 3 + 1) * 64 + (lane & 15) * 4), c = *(const f32x4*)(KIN(I_KN) + (li * 3 + 2) * 64 + (lane & 15) * 4);
      kn1[0] = a.x; kn1[1] = a.y; kn1[2] = a.z; kn1[3] = a.w; kn2[0] = c.x; kn2[1] = c.y; kn2[2] = c.z; kn2[3] = c.w; }
    const unsigned long long* ssq = SSQP(2 * l);
    float qg[8]; ld8f(KIN(I_QN) + li * 64 + (lane & 7) * 8, qg);
    RowRawA nx = load_row_a(ZB + (size_t)row0 * NE, ssq + row0, lane);
    for (int i8 = 0; i8 < ntok; ++i8) {
        const int t = tbase + i8, row = row0 + i8;
        const RowRawA cu = nx;
        if (i8 < ntok - 1) nx = load_row_a(ZB + (size_t)(row + 1) * NE, ssq + row + 1, lane);
        const float rin = __builtin_amdgcn_rsqf((float)cu.sq * (1.f / (SSQ_SCALE * DM)) + RMS_EPS);
        { float x[8]; unpk8(cu.q, x); float ss = 0.f;
#pragma unroll
          for (int i = 0; i < 8; ++i) x[i] *= rin;
#pragma unroll
          for (int i = 0; i < 8; ++i) ss += x[i] * x[i];
          ss = sum8(ss); const float rinv = 1.0f / sqrtf(ss * (1.f / 64.f) + RMS_EPS);
          v4u o; o.x = pk2(x[0] * rinv * qg[0], x[1] * rinv * qg[1]); o.y = pk2(x[2] * rinv * qg[2], x[3] * rinv * qg[3]); o.z = pk2(x[4] * rinv * qg[4], x[5] * rinv * qg[5]); o.w = pk2(x[6] * rinv * qg[6], x[7] * rinv * qg[7]);
          *(v4u*)(WSP(bf16, WS_QB) + (size_t)row * 512 + lane * 8) = o; }
#pragma unroll
        for (int c = 0; c < 3; ++c) {
            const v2u wv = cu.kv[c];
            float x[4] = {bflo(wv.x) * rin, bfhi(wv.x) * rin, bflo(wv.y) * rin, bfhi(wv.y) * rin};
            const int g = (lane >> 4) & 1, dd = (lane & 15) * 4; const bool isv = lane >= 32;
            if (c > 0) { float ss = (x[0] * x[0] + x[1] * x[1]) + (x[2] * x[2] + x[3] * x[3]); ss = sum16(ss);
                if (!isv) { const float rinv = 1.0f / sqrtf(ss * (1.f / 64.f) + RMS_EPS);
#pragma unroll
                    for (int i = 0; i < 4; ++i) x[i] = x[i] * rinv * (c == 1 ? kn1[i] : kn2[i]); } }
            float* op = nullptr;
            if (c == 0) op = OUTF + (samp ? O_CMPS + ((size_t)(b * 2 + li) * DT + t) * 256 : O_CMPP + ((size_t)(b * 2 + li) * SEQ + t) * 256);
            else if (c == 1) op = OUTF + (samp ? O_SLCS + ((size_t)(b * 2 + li) * DT + t) * 256 : O_SLCP + ((size_t)(b * 2 + li) * SEQ + t) * 256);
            else { if (samp) op = OUTF + O_WINS + ((size_t)(b * 2 + li) * WIN + (WIN - DT) + t) * 256; else if (t >= SEQ - WIN) op = OUTF + O_WINP + ((size_t)(b * 2 + li) * WIN + (t - (SEQ - WIN))) * 256; }
            if (op) *(f32x4*)(op + lane * 4) = (f32x4){x[0], x[1], x[2], x[3]};
            if (!samp) {
                v2u pk; pk.x = pk2(x[0], x[1]); pk.y = pk2(x[2], x[3]);
                if (c == 0) { const int rw = (isv ? CS_PV : CS_PK) + (b * 2 + g) * 128 + (t >> 4);
                    *(v2u*)(WSP(bf16, WS_CSEG) + (size_t)rw * 1024 + (t & 15) * 64 + dd) = pk; }
                else if (!isv) { *(v2u*)(WSP(bf16, c == 1 ? WS_KS : WS_KW) + ((size_t)(b * 2 + g) * SEQ + t) * 64 + dd) = pk; }
                else { LAS bf16* vt = (c == 1 ? vts : vtw) + (g * 64 + dd) * 66 + (t & 63);
                    vt[0] = (bf16)(pk.x & 0xffffu); vt[66] = (bf16)(pk.x >> 16); vt[132] = (bf16)(pk.y & 0xffffu); vt[198] = (bf16)(pk.y >> 16); }
            }
        }
        if (lane < 24) WSP(float, WS_GATE)[(size_t)row * 32 + lane] = sigmoidf_(bf2f(cu.gate) * rin);
    }
    float zp[4][8];
#pragma unroll
    for (int p = 0; p < 4; ++p) {
        const bool act = (p < 3 || lane < 32);
        if (!act) { for (int i = 0; i < 8; ++i) zp[p][i] = 0.f; }
        else if (tbase == 0) { if (samp) ld8f(KIN(I_SSHIFT) + (size_t)(b * 2 + li) * RWP + p * 512 + lane * 8, zp[p]); else { for (int i = 0; i < 8; ++i) zp[p][i] = 0.f; } }
        else { ld8bf(ZB + (size_t)(row0 - 1) * NE + 1280 + p * 512 + lane * 8, zp[p]); const float rp = rinv_of(ssq, row0 - 1);
#pragma unroll
            for (int i = 0; i < 8; ++i) zp[p][i] *= rp; }
    }
    float mu[4][8], kkw[8]; ld8f(KIN(I_KKW) + li * 512 + lane * 8, kkw);
#pragma unroll
    for (int p = 0; p < 4; ++p) { if (p < 3 || lane < 32) ld8f(KIN(I_MU) + li * RWP + p * 512 + lane * 8, mu[p]); else { for (int i = 0; i < 8; ++i) mu[p][i] = 0.f; } }
    RowRawB nb = load_row_b(ZB + (size_t)row0 * NE, ssq + row0, lane);
    for (int i8 = 0; i8 < ntok; ++i8) {
        const int t = tbase + i8, row = row0 + i8;
        const RowRawB cu = nb;
        if (i8 < ntok - 1) nb = load_row_b(ZB + (size_t)(row + 1) * NE, ssq + row + 1, lane);
        const float rin = __builtin_amdgcn_rsqf((float)cu.sq * (1.f / (SSQ_SCALE * DM)) + RMS_EPS);
        const bool lastt = samp ? (t == DT - 1) : (t == SEQ - 1);
#pragma unroll
        for (int p = 0; p < 4; ++p) {
            if (p < 3 || lane < 32) {
                float z[8], zz[8]; unpk8(cu.z[p], z);
#pragma unroll
                for (int i = 0; i < 8; ++i) z[i] *= rin;

#pragma unroll
                for (int i = 0; i < 8; ++i) { zz[i] = z[i] + (zp[p][i] - z[i]) * mu[p][i]; zp[p][i] = z[i]; }
                if (lastt) store8f(OUTF + (samp ? O_SHS : O_SHP) + (size_t)(b * 2 + li) * RWP + p * 512 + lane * 8, z);
                const int h = lane >> 3, d = (lane & 7) * 8;
                unsigned char* scb = (unsigned char*)SCREC(row, h) + d * 2;
                v4u zb; zb.x = pk2(zz[0], zz[1]); zb.y = pk2(zz[2], zz[3]); zb.z = pk2(zz[4], zz[5]); zb.w = pk2(zz[6], zz[7]);
                if (p == 0) *(v4u*)(scb + SCR_R) = zb;
                else if (p == 2) *(v4u*)(scb + SCR_V) = zb;
                else if (p == 1) { *(v4u*)(scb + SCR_K) = zb; float kk[8]; float ss = 0.f;
#pragma unroll
                    for (int i = 0; i < 8; ++i) { kk[i] = zz[i] * kkw[i]; ss += kk[i] * kk[i]; }
                    ss = sum8(ss); const float rinv = 1.0f / sqrtf(fmaxf(ss, 1e-24f));
#pragma unroll
                    for (int i = 0; i < 8; ++i) kk[i] *= rinv;
                    v4u kb; kb.x = pk2(kk[0], kk[1]); kb.y = pk2(kk[2], kk[3]); kb.z = pk2(kk[4], kk[5]); kb.w = pk2(kk[6], kk[7]); *(v4u*)(scb + SCR_KK) = kb; }
                else { float o[8];
#pragma unroll
                    for (int i = 0; i < 8; ++i) o[i] = lane < 8 ? tanhf_(zz[i]) : (lane < 16 ? zz[i] : sigmoidf_(zz[i]));
                    v4u pk; pk.x = pk2(o[0], o[1]); pk.y = pk2(o[2], o[3]); pk.z = pk2(o[4], o[5]); pk.w = pk2(o[6], o[7]);
                    *(v4u*)(WSP(bf16, WS_LA) + (size_t)row * 256 + lane * 8) = pk; }
            }
        }
    }
}
DI void post_even_tile(Frame& F, int tt, int li, int l) {
    const int w = F.wave, b = tt >> 5, blk = tt & 31;
    post_even_run(F, li, l, false, b, blk * 64 + 8 * w, b * SEQ + blk * 64 + 8 * w, 8);
    if (w < 4) { const int st = tt * 4 + w; post_even_run(F, li, l, true, st >> 3, st & 7, MP + st, 1); }
    LAS bf16* vts = (LAS bf16*)(F.lds + RING_OFF); LAS bf16* vtw = vts + 2 * 64 * 66;
    {
        __syncthreads();
#pragma unroll
        for (int a = 0; a < 2; ++a) { const LAS bf16* vt = a ? vtw : vts; const int ri = F.tid >> 2, q4 = F.tid & 3;
            const LAS unsigned* s = (const LAS unsigned*)(vt + ri * 66 + q4 * 16);
            v4u o0, o1; o0.x = s[0]; o0.y = s[1]; o0.z = s[2]; o0.w = s[3]; o1.x = s[4]; o1.y = s[5]; o1.z = s[6]; o1.w = s[7];
            bf16* dst = WSP(bf16, a ? WS_VWT : WS_VST) + (((size_t)(b * 2 + (ri >> 6)) * 32 + blk) * 64 + (ri & 63)) * 64 + q4 * 16;
            *(v4u*)dst = o0; *(v4u*)(dst + 8) = o1; }
        __syncthreads();
    }
}
DI void cseg_page_load(Frame& F, int u, int li, f32x4 (&v)[8][2]) {
    const int b = u >> 4, p = u & 15; const int pg = ((const int*)KIN(I_PT))[b * NPAGE + p];
    const float* src = KIN(I_CCMP) + ((size_t)pg * 2 + li) * (PAGE * 256);
#pragma unroll
    for (int k = 0; k < 8; ++k) { const int q = k * NTHREADS + F.tid; const f32x4* sp = (const f32x4*)(src + (size_t)(q >> 5) * 256 + (q & 31) * 8);
        v[k][0] = sp[0]; v[k][1] = sp[1]; }
}
DI void cseg_page_store(Frame& F, int u, const f32x4 (&v)[8][2]) {
    const int b = u >> 4, p = u & 15; bf16* CS = WSP(bf16, WS_CSEG);
#pragma unroll
    for (int k = 0; k < 8; ++k) { const int q = k * NTHREADS + F.tid; const int r = q >> 5, c = q & 31;
        const int kv = c >> 4, g = (c >> 3) & 1, d0 = (c & 7) * 8;
        v4u o; o.x = pk2(v[k][0].x, v[k][0].y); o.y = pk2(v[k][0].z, v[k][0].w); o.z = pk2(v[k][1].x, v[k][1].y); o.w = pk2(v[k][1].z, v[k][1].w);
        *(v4u*)(CS + ((size_t)((kv ? CS_SV : CS_SK) + (b * 2 + g) * 128 + p * 8 + (r >> 4))) * 1024 + (r & 15) * 64 + d0) = o; }
}
DI void cseg_page_unit(Frame& F, int u, int li) { f32x4 v[8][2]; cseg_page_load(F, u, li, v); cseg_page_store(F, u, v); }
DI void win_copy_unit(Frame& F, int u, int li) {
    const int b = u / 9, q = u % 9;
    const f32x4* src = (const f32x4*)(KIN(I_CWIN) + ((size_t)(b * 2 + li) * WIN + DT + q * 56) * 256) + F.tid;
    f32x4* dst = (f32x4*)(OUTF + O_WINS + ((size_t)(b * 2 + li) * WIN + q * 56) * 256) + F.tid;
    f32x4 v[7];
#pragma unroll
    for (int k = 0; k < 7; ++k) v[k] = src[k * NTHREADS];
#pragma unroll
    for (int k = 0; k < 7; ++k) dst[k * NTHREADS] = v[k];
}
constexpr int BG_NTK = (DB * NPAGE + DB * 9) / 4, BG_KTOP = 156;
static_assert((BG_NTK - BG_KTOP) * 4 >= DB * NPAGE, "the top tickets are window copies only");
DI void bg_units(Frame& F, int li, int max_tickets, bool top = false) {
    volatile LAS unsigned* tk = F.MISC + 17;
    for (int n = 0; n < max_tickets; ++n) {
        __syncthreads();
        if (F.tid == 0) tk[0] = __hip_atomic_fetch_add((unsigned*)(F.ctl + CW_QUEUE + 16 + (top ? 1 : 0) + 32 * li), 1u, RLX_AGENT);
        __syncthreads();
        const int k4 = __builtin_amdgcn_readfirstlane((int)tk[0]);
        if (k4 >= (top ? BG_KTOP : BG_NTK - BG_KTOP)) break;
        const int t4 = top ? BG_NTK - 1 - k4 : k4;
#pragma unroll 1
        for (int k = 0; k < 4; ++k) { LAUNDER(F); const int u = t4 * 4 + k; if (u < DB * NPAGE) cseg_page_unit(F, u, li); else win_copy_unit(F, u - DB * NPAGE, li); }
    }
}
DI void post_even_phase(Frame& F, int li, int l) {
    for (int u = F.bid; u < 256; u += F.G) post_even_tile(F, u, li, l);
    bg_units(F, li, 1 << 30); bg_units(F, li, 1 << 30, true);
}

DI float gelu_tanh(float x) { const float u = 0.7978845608028654f * (x + 0.044715f * x * x * x); return 0.5f * x * (1.0f + tanhf_(u)); }
DI void compress2_stage_w2(Frame& F, int li) {
    LAS bf16* w2t = (LAS bf16*)(F.lds + RING_OFF);
    const float* w2 = KIN(I_PW2) + (size_t)li * 2 * 128 * 64;
    for (int i = F.tid; i < 2 * 128 * 64; i += NTHREADS) { const int kv = i >> 13, e = (i >> 6) & 127, d = i & 63; w2t[(kv * 64 + d) * 136 + e] = (bf16)(pk2(w2[i], 0.f) & 0xffffu); }
    if (F.tid < 256) { float a = 0.f; const float* pp = WSP(float, WS_PECP) + li * 256 + F.tid;
#pragma unroll 8
        for (int jc = 0; jc < 32; ++jc) a += pp[jc * 512];
        ((LAS float*)(F.lds + RING_OFF + 36864))[F.tid] = a; }
    __syncthreads();
}
DI void compress2_unit(Frame& F, int cu, int li) {
    const int w = F.wave, lane = F.lane, kl = lane & 31, h = lane >> 5, kv = w >> 2, n = (w & 3) * 32 + kl;
    const LAS bf16* w2t = (const LAS bf16*)(F.lds + RING_OFF) + kv * 64 * 136;
    const bool prm = cu >= 256; const int bg = prm ? cu - 256 : cu;
    const size_t rb = (size_t)(prm ? (kv ? CS_PV : CS_PK) : (kv ? CS_SV : CS_SK)) + (size_t)bg * 128;
    const float* p0 = WSP(float, WS_PART) + (rb + n) * 256 + 8 * h; const float* p1 = p0 + 256 + 128; const LAS float* pec = (const LAS float*)(F.lds + RING_OFF + 36864) + kv * 128 + 8 * h;
    f32x16 C[2];
#pragma unroll
    for (int i = 0; i < 16; ++i) { C[0][i] = 0.f; C[1][i] = 0.f; }
#pragma unroll
    for (int ks = 0; ks < 8; ++ks) {
        float x0[8], x1[8], pc[8]; ld8f(p0 + 16 * ks, x0); ld8f(p1 + 16 * ks, x1);
#pragma unroll
        for (int j = 0; j < 8; ++j) pc[j] = pec[16 * ks + j];
        v4u bv; bv.x = pk2(gelu_tanh(pc[0] + x0[0] + x1[0]), gelu_tanh(pc[1] + x0[1] + x1[1])); bv.y = pk2(gelu_tanh(pc[2] + x0[2] + x1[2]), gelu_tanh(pc[3] + x0[3] + x1[3]));
        bv.z = pk2(gelu_tanh(pc[4] + x0[4] + x1[4]), gelu_tanh(pc[5] + x0[5] + x1[5])); bv.w = pk2(gelu_tanh(pc[6] + x0[6] + x1[6]), gelu_tanh(pc[7] + x0[7] + x1[7]));
        const bf16x8 bf = __builtin_bit_cast(bf16x8, bv);
#pragma unroll
        for (int dt = 0; dt < 2; ++dt) { const bf16x8 a = *(const LAS bf16x8*)(w2t + (dt * 32 + kl) * 136 + 16 * ks + 8 * h); C[dt] = MFMA32(a, bf, C[dt]); }
    }
    const bool valid = n < NCMP;
    if (kv == 0) {
        float ss = 0.f;
#pragma unroll
        for (int dt = 0; dt < 2; ++dt)
#pragma unroll
            for (int i = 0; i < 16; ++i) ss += C[dt][i] * C[dt][i];
        ss += __shfl_xor(ss, 32);
        const float rinv = valid ? 1.0f / sqrtf(ss * (1.f / 64.f) + RMS_EPS) : 0.f;
        bf16* KC = WSP(bf16, WS_KC) + (size_t)cu * 8192 + n * 64; const float* kn = KIN(I_KN) + (li * 3 + 0) * 64;
#pragma unroll
        for (int dt = 0; dt < 2; ++dt)
#pragma unroll
            for (int a = 0; a < 4; ++a) { const int d0 = dt * 32 + 8 * a + 4 * h; const f32x4 g = *(const f32x4*)(kn + d0);
                v2u o; o.x = pk2(C[dt][4 * a] * rinv * g.x, C[dt][4 * a + 1] * rinv * g.y); o.y = pk2(C[dt][4 * a + 2] * rinv * g.z, C[dt][4 * a + 3] * rinv * g.w); if (!valid) { o.x = 0u; o.y = 0u; } *(v2u*)(KC + d0) = o; }
    } else {
        bf16* VCT = WSP(bf16, WS_VCT) + (size_t)cu * 8192 + n;
#pragma unroll
        for (int dt = 0; dt < 2; ++dt)
#pragma unroll
            for (int i = 0; i < 16; ++i) VCT[(dt * 32 + crow(i, h)) * 128] = (bf16)(pk2(valid ? C[dt][i] : 0.f, 0.f) & 0xffffu);
    }
}
DI void compress2_phase(Frame& F, int li) { compress2_stage_w2(F, li); for (int u = F.bid; u < 272; u += F.G) compress2_unit(F, u, li); __syncthreads(); }

DI void odd_mix_phase(Frame& F, int li, int l) {
    const unsigned long long* ssq = SSQP(2 * l);
    const bf16* ZB = WSP(bf16, WS_ZB); bf16* MIX = WSP(bf16, WS_MIX);
    const float* cw = KIN(I_CONVW) + (size_t)li * 3 * DM;
    constexpr int NCG = DM / 8, NRUN = MT / 8;
    for (int it = F.bid * NTHREADS + F.tid; it < NRUN * NCG; it += F.G * NTHREADS) {
        const int run = it / NCG, ch = (it % NCG) * 8;
        const bool samp = run >= MP / 8; const int b = samp ? run - MP / 8 : run >> 8, t0 = samp ? 0 : (run & 255) * 8, row0 = run * 8;
        v4u rb[8], rc[10], rx[10]; unsigned long long sq[10];
        const bool halo = t0 != 0;
#pragma unroll
        for (int j = 0; j < 10; ++j) { const int rr = halo ? row0 - 2 + j : (j < 2 ? row0 : row0 - 2 + j); const bf16* zr = ZB + (size_t)rr * NO;
            rc[j] = *(const v4u*)(zr + DM + ch); rx[j] = *(const v4u*)(zr + 2 * DM + ch); sq[j] = ssq[rr]; if (j >= 2) rb[j - 2] = *(const v4u*)(zr + ch); }
        float w0[8], w1[8], w2[8], p2[8], p1[8];
        ld8f(cw + ch, w0); ld8f(cw + DM + ch, w1); ld8f(cw + 2 * DM + ch, w2);
        if (!halo) { if (samp) { ld8f(KIN(I_SCONV) + ((size_t)(b * 2 + li) * 2 + 0) * DM + ch, p2); ld8f(KIN(I_SCONV) + ((size_t)(b * 2 + li) * 2 + 1) * DM + ch, p1); }
                     else { for (int i = 0; i < 8; ++i) { p2[i] = 0.f; p1[i] = 0.f; } } }
        else { float a[8], c[8]; float rr = __builtin_amdgcn_rsqf((float)sq[0] * (1.f / (SSQ_SCALE * DM)) + RMS_EPS); rr *= rr; unpk8(rc[0], a); unpk8(rx[0], c); for (int i = 0; i < 8; ++i) p2[i] = a[i] * c[i] * rr;
               rr = __builtin_amdgcn_rsqf((float)sq[1] * (1.f / (SSQ_SCALE * DM)) + RMS_EPS); rr *= rr; unpk8(rc[1], a); unpk8(rx[1], c); for (int i = 0; i < 8; ++i) p1[i] = a[i] * c[i] * rr; }
#pragma unroll
        for (int j = 0; j < 8; ++j) {
            float bgv[8], cg[8], xi[8], p[8], o[8]; unpk8(rb[j], bgv); unpk8(rc[j + 2], cg); unpk8(rx[j + 2], xi);
            const float rin = __builtin_amdgcn_rsqf((float)sq[j + 2] * (1.f / (SSQ_SCALE * DM)) + RMS_EPS), rin2 = rin * rin;
#pragma unroll
            for (int i = 0; i < 8; ++i) { p[i] = cg[i] * xi[i] * rin2; o[i] = bgv[i] * rin * (w0[i] * p2[i] + w1[i] * p1[i] + w2[i] * p[i]); p2[i] = p1[i]; p1[i] = p[i]; }
            v4u pk; pk.x = pk2(o[0], o[1]); pk.y = pk2(o[2], o[3]); pk.z = pk2(o[4], o[5]); pk.w = pk2(o[6], o[7]);
            *(v4u*)(MIX + (size_t)(row0 + j) * DM + ch) = pk;
            const int t = t0 + j; const int tl = samp ? DT : SEQ;
            if (t >= tl - 2) store8f(OUTF + (samp ? O_CVS : O_CVP) + ((size_t)(b * 2 + li) * 2 + (t - (tl - 2))) * DM + ch, p);
        }
    }
}
DI void ffn_act_phase(Frame& F, int l) {
    const unsigned long long* ssq = SSQP(2 * l + 1);
    const bf16* AU = WSP(bf16, WS_ZB); bf16* H = WSP(bf16, WS_H);
    const float* cw = KIN(I_FCONV) + (size_t)l * 3 * DFF;
    constexpr int NCG = DFF / 8, NRUN = MT / 8;
    for (int it = F.bid * NTHREADS + F.tid; it < NRUN * NCG; it += F.G * NTHREADS) {
        const int run = it / NCG, ch = (it % NCG) * 8;
        const bool samp = run >= MP / 8; const int b = samp ? run - MP / 8 : run >> 8, t0 = samp ? 0 : (run & 255) * 8, row0 = run * 8;
        float w0[8], w1[8], w2[8], a2[8], a1[8];
        ld8f(cw + ch, w0); ld8f(cw + DFF + ch, w1); ld8f(cw + 2 * DFF + ch, w2);
        if (t0 == 0) { if (samp) { ld8f(KIN(I_SFFN) + ((size_t)(b * 4 + l) * 2 + 0) * DFF + ch, a2); ld8f(KIN(I_SFFN) + ((size_t)(b * 4 + l) * 2 + 1) * DFF + ch, a1); }
                       else { for (int i = 0; i < 8; ++i) { a2[i] = 0.f; a1[i] = 0.f; } } }
        else { ld8bf(AU + (size_t)(row0 - 2) * NUP + ch, a2); ld8bf(AU + (size_t)(row0 - 1) * NUP + ch, a1); const float r2 = rinv_of(ssq, row0 - 2), r1 = rinv_of(ssq, row0 - 1); for (int i = 0; i < 8; ++i) { a2[i] *= r2; a1[i] *= r1; } }
#pragma unroll
        for (int j = 0; j < 8; ++j) {
            const bf16* zr = AU + (size_t)(row0 + j) * NUP; float a[8], uu[8], o[8];
            ld8bf(zr + ch, a); ld8bf(zr + DFF + ch, uu);
            const float rin = rinv_of(ssq, row0 + j);
#pragma unroll
            for (int i = 0; i < 8; ++i) { a[i] *= rin; const float y = w0[i] * a2[i] + w1[i] * a1[i] + w2[i] * a[i]; o[i] = y * sigmoidf_(y) * uu[i] * rin; a2[i] = a1[i]; a1[i] = a[i]; }
            v4u pk; pk.x = pk2(o[0], o[1]); pk.y = pk2(o[2], o[3]); pk.z = pk2(o[4], o[5]); pk.w = pk2(o[6], o[7]);
            *(v4u*)(H + (size_t)(row0 + j) * DFF + ch) = pk;
            const int t = t0 + j; const int tl = samp ? DT : SEQ;
            if (t >= tl - 2) store8f(OUTF + (samp ? O_FFS : O_FFP) + ((size_t)(b * 4 + l) * 2 + (t - (tl - 2))) * DFF + ch, a);
        }
    }
}

DI int rel_bucket(int d) {
    if (d < 16) return d;
    int bkt = 16;
    bkt += (d >= 19) + (d >= 21) + (d >= 24) + (d >= 27) + (d >= 31) + (d >= 35) + (d >= 40) + (d >= 46) + (d >= 52) + (d >= 59) + (d >= 67) + (d >= 77) + (d >= 87) + (d >= 99) + (d >= 113);
    return bkt;
}
DI void fill_bias_table(Frame& F, LAS float* biasT, int g) {
    const int hq = F.tid >> 7, d = F.tid & 127;
    biasT[F.tid] = KIN(I_RELB)[rel_bucket(d) * 8 + g * 4 + hq] * LOG2E;
}
DI bf16x8 pack_p(const f32x16& p, int s) {
    v4u r; r.x = pk2(p[8 * s + 0], p[8 * s + 1]); r.y = pk2(p[8 * s + 2], p[8 * s + 3]); r.z = pk2(p[8 * s + 4], p[8 * s + 5]); r.w = pk2(p[8 * s + 6], p[8 * s + 7]);
    return __builtin_bit_cast(bf16x8, r);
}
DI float xhalf_max(float x) { return fmaxf(x, __shfl_xor(x, 32)); }
DI float xhalf_sum(float x) { return x + __shfl_xor(x, 32); }
constexpr float SC2 = 0.125f * LOG2E;
constexpr float NEG_BIG = -1e30f;

constexpr float SREF = 8.0f;
DI void softmax_pv(f32x16& s, float& l, f32x16 (&O)[2], const bf16x8 (&vf)[2][2]) {
    float ps0 = 0.f, ps1 = 0.f;
#pragma unroll
    for (int i = 0; i < 16; i += 2) { s[i] = fexp2(s[i]); s[i + 1] = fexp2(s[i + 1]); ps0 += s[i]; ps1 += s[i + 1]; }
    l += ps0 + ps1;
    const bf16x8 p0 = pack_p(s, 0), p1 = pack_p(s, 1);
#pragma unroll
    for (int dt = 0; dt < 2; ++dt) { O[dt] = MFMA32(vf[dt][0], p0, O[dt]); O[dt] = MFMA32(vf[dt][1], p1, O[dt]); }
}

DI void cmp_branch(const bf16x8 (&qf)[4], const bf16* kc, const bf16* vct, int t, int ccur, const LAS float* biasT, int lane, LAS float* scr, f32x16 (&Oc)[2], unsigned& selmask) {
    const int kl = lane & 31, h = lane >> 5, hq = kl & 3, tl = kl >> 2;
    f32x16 S[4];
#pragma unroll
    for (int kt = 0; kt < 4; ++kt) {
#pragma unroll
        for (int i = 0; i < 16; ++i) S[kt][i] = 0.f;
#pragma unroll
        for (int ks = 0; ks < 4; ++ks) { const bf16x8 a = *(const bf16x8*)(kc + (32 * kt + kl) * 64 + 16 * ks + 8 * h); S[kt] = MFMA32(a, qf[ks], S[kt]); }
    }
    const int nmax = (t - 31) >> 4;
    float mx = NEG_BIG;
#pragma unroll
    for (int kt = 0; kt < 4; ++kt) {
        float bv[16];
#pragma unroll
        for (int i = 0; i < 16; ++i) { const int n = 32 * kt + crow(i, h); const int dist = t - (16 * n + 31); const int idx = dist < 0 ? 0 : (dist > 127 ? 127 : dist); bv[i] = biasT[hq * 128 + idx]; }
#pragma unroll
        for (int i = 0; i < 16; ++i) { const int n = 32 * kt + crow(i, h); float v = S[kt][i] * SC2 + bv[i]; v = (n <= nmax) ? v : -INFINITY; S[kt][i] = v; mx = fmaxf(mx, v); }
    }
    mx = xhalf_max(mx);
    float sum = 0.f;
#pragma unroll
    for (int kt = 0; kt < 4; ++kt)
#pragma unroll
        for (int i = 0; i < 16; ++i) { const float e = fexp2(S[kt][i] - mx); S[kt][i] = e; sum += e; }
    sum = xhalf_sum(sum);
    const float inv = sum > 0.f ? 1.0f / sum : 0.f;
#pragma unroll
    for (int kt = 0; kt < 4; ++kt) S[kt] = S[kt] * inv;
    f32x16 I;
#pragma unroll
    for (int i = 0; i < 16; ++i) { Oc[0][i] = 0.f; Oc[1][i] = 0.f; I[i] = 0.f; }
#pragma unroll
    for (int kt = 0; kt < 4; ++kt)
#pragma unroll
        for (int st = 0; st < 2; ++st) {
            const bf16x8 ph = pack_p(S[kt], st);
            f32x16 lo = S[kt];
#pragma unroll
            for (int j = 0; j < 8; ++j) { const unsigned short hb = (unsigned short)ph[j]; lo[8 * st + j] = S[kt][8 * st + j] - bf2f(hb); }
            const bf16x8 pl = pack_p(lo, st);
#pragma unroll
            for (int dt = 0; dt < 2; ++dt) { const bf16* vr = vct + (dt * 32 + kl) * 128 + 32 * kt + 16 * st + 4 * h;
                const v2u a0 = *(const v2u*)vr, a1 = *(const v2u*)(vr + 8); v4u av; av.x = a0.x; av.y = a0.y; av.z = a1.x; av.w = a1.y;
                Oc[dt] = MFMA32(__builtin_bit_cast(bf16x8, av), ph, Oc[dt]); }
            bf16x8 ov;
#pragma unroll
            for (int j = 0; j < 8; ++j) { const int n = 32 * kt + 16 * st + 8 * (j >> 2) + 4 * h + (j & 3); ov[j] = (n >= 4 * kl - 1 && n <= 4 * kl + 3) ? (short)0x3F80 : (short)0; }
            I = MFMA32(ov, ph, I); I = MFMA32(ov, pl, I);
        }
#pragma unroll
    for (int i = 0; i < 16; ++i) I[i] = sum4(I[i]);
    if (hq == 0) {
#pragma unroll
        for (int i = 0; i < 16; ++i) { const int sb = crow(i, h); scr[tl * 33 + sb] = (sb >= 1 && sb <= ccur - 2) ? I[i] : -INFINITY; }
    }
    LDS_WAIT(); asm volatile("" ::: "memory");
    float v[32];
#pragma unroll
    for (int s = 0; s < 32; ++s) v[s] = scr[tl * 33 + s];
    const int sub = hq + 4 * h;
    unsigned bits = 0u;
#pragma unroll
    for (int k = 0; k < 4; ++k) { const int sk = 4 * sub + k; const float x = scr[tl * 33 + sk]; int cnt = 0;
#pragma unroll
        for (int s = 0; s < 32; ++s) cnt += (v[s] > x || (v[s] == x && s < sk)) ? 1 : 0;
        if (sk >= 1 && sk <= ccur - 2 && cnt < 13) bits |= 1u << sk; }
    LDS_WAIT(); asm volatile("" ::: "memory");
    bits |= dppu<XOR1>(bits); bits |= dppu<XOR2>(bits); bits |= (unsigned)__shfl_xor((int)bits, 32);
    unsigned forced = 1u;
    if (ccur < 32) forced |= 1u << ccur;
    if (ccur >= 1) forced |= 1u << (ccur - 1);
    selmask = bits | forced;
}

constexpr int KV_PITCH = 72;
constexpr int AT_KBUF = 0, AT_VBUF = 2 * 64 * KV_PITCH * 2, AT_BIAS = 2 * AT_VBUF, AT_SCR = AT_BIAS + 2048, AT_OUT = AT_SCR + 8 * 8 * 33 * 4, AT_END = AT_OUT + 8 * 64 * 32 * 4;
template <int MODE>
DI void prompt_branch(Frame& F, const bf16* Kg, const bf16* Vg, int s_lo, int s_hi, int c, int t, unsigned sel, const bf16x8 (&qf)[4], const LAS float* biasT, float gate, LAS float* outw) {
    const int lane = F.lane, kl = lane & 31, h = lane >> 5, hq = kl & 3;
    LAS bf16* Kb = (LAS bf16*)(F.lds + RING_OFF + AT_KBUF); LAS bf16* Vb = (LAS bf16*)(F.lds + RING_OFF + AT_VBUF);
    const int srow = F.tid >> 3, spc = F.tid & 7;
    f32x16 O[2]; float l = 0.f;
#pragma unroll
    for (int i = 0; i < 16; ++i) { O[0][i] = 0.f; O[1][i] = 0.f; }
    const float bfar = biasT[hq * 128 + 127] - SREF;
    v4u kr = *(const v4u*)(Kg + ((size_t)s_lo * 64 + srow) * 64 + spc * 8), vr = *(const v4u*)(Vg + ((size_t)s_lo * 64 + srow) * 64 + spc * 8);
    *(LAS v4u*)(Kb + srow * KV_PITCH + spc * 8) = kr; *(LAS v4u*)(Vb + srow * KV_PITCH + spc * 8) = vr;
    __syncthreads();
    int buf = 0;
    for (int s = s_lo; s <= s_hi; ++s) {
        if (s < s_hi) { kr = *(const v4u*)(Kg + ((size_t)(s + 1) * 64 + srow) * 64 + spc * 8); vr = *(const v4u*)(Vg + ((size_t)(s + 1) * 64 + srow) * 64 + spc * 8); }
        const bool act = (MODE == 1) ? true : (((sel >> s) & 1u) != 0u);
        if (__any(act)) {
            const LAS bf16* kb = Kb + buf * 64 * KV_PITCH; const LAS bf16* vb = Vb + buf * 64 * KV_PITCH;
            const bool near = s >= c - 2;
#pragma unroll
            for (int kt = 0; kt < 2; ++kt) {
                f32x16 S;
#pragma unroll
                for (int i = 0; i < 16; ++i) S[i] = 0.f;
#pragma unroll
                for (int ks = 0; ks < 4; ++ks) { const bf16x8 a = *(const LAS bf16x8*)(kb + (32 * kt + kl) * KV_PITCH + 16 * ks + 8 * h); S = MFMA32(a, qf[ks], S); }
                bf16x8 vf[2][2];
#pragma unroll
                for (int dt = 0; dt < 2; ++dt)
#pragma unroll
                    for (int st = 0; st < 2; ++st) { const LAS bf16* vp = vb + (dt * 32 + kl) * KV_PITCH + 32 * kt + 16 * st + 4 * h;
                        const v2u a0 = *(const LAS v2u*)vp, a1 = *(const LAS v2u*)(vp + 8); v4u av; av.x = a0.x; av.y = a0.y; av.z = a1.x; av.w = a1.y; vf[dt][st] = __builtin_bit_cast(bf16x8, av); }
                const int key0 = 64 * s + 32 * kt;
                if (near) {
                    float bv[16];
#pragma unroll
                    for (int i = 0; i < 16; ++i) { const int dist = t - (key0 + crow(i, h)); const int idx = dist < 0 ? 0 : (dist > 127 ? 127 : dist); bv[i] = biasT[hq * 128 + idx]; }
#pragma unroll
                    for (int i = 0; i < 16; ++i) { const int dist = t - (key0 + crow(i, h)); const bool ok = act && dist >= 0 && (MODE == 0 || dist < WIN); const float v = S[i] * SC2 + (bv[i] - SREF); S[i] = ok ? v : -INFINITY; }
                } else if (MODE == 1 && s == c - 8) {
#pragma unroll
                    for (int i = 0; i < 16; ++i) { const int dist = t - (key0 + crow(i, h)); const float v = S[i] * SC2 + bfar; S[i] = dist < WIN ? v : -INFINITY; }
                } else {
                    const float addc = act ? bfar : -INFINITY;
#pragma unroll
                    for (int i = 0; i < 16; ++i) S[i] = S[i] * SC2 + addc;
                }
                softmax_pv(S, l, O, vf);
            }
        }
        if (s < s_hi) { *(LAS v4u*)(Kb + (buf ^ 1) * 64 * KV_PITCH + srow * KV_PITCH + spc * 8) = kr; *(LAS v4u*)(Vb + (buf ^ 1) * 64 * KV_PITCH + srow * KV_PITCH + spc * 8) = vr; }
        __syncthreads();
        buf ^= 1;
    }
    l = xhalf_sum(l);
    const float sc = l > 0.f ? gate / l : 0.f;
#pragma unroll
    for (int dt = 0; dt < 2; ++dt)
#pragma unroll
        for (int i = 0; i < 16; ++i) outw[(dt * 32 + crow(i, h)) * 32 + kl] += O[dt][i] * sc;
}
DI void attn_prompt_unit(Frame& F, int b, int g, int c, int li) {
    const int w = F.wave, lane = F.lane, kl = lane & 31, h = lane >> 5, hq = kl & 3, tl = kl >> 2, hd = g * 4 + hq;
    LAS float* biasT = (LAS float*)(F.lds + RING_OFF + AT_BIAS); LAS float* scr = (LAS float*)(F.lds + RING_OFF + AT_SCR) + w * 8 * 33;
    fill_bias_table(F, biasT, g);
    const int t = 64 * c + 8 * w + tl, row = b * SEQ + t;
    bf16x8 qf[4];
#pragma unroll
    for (int ks = 0; ks < 4; ++ks) qf[ks] = *(const bf16x8*)(WSP(bf16, WS_QB) + (size_t)row * 512 + hd * 64 + 16 * ks + 8 * h);
    const float* gp = WSP(float, WS_GATE) + (size_t)row * 32 + hd * 3; const float g0 = gp[0], g1 = gp[1], g2 = gp[2];
    __syncthreads();
    unsigned sel;
    LAS float* outw = (LAS float*)(F.lds + RING_OFF + AT_OUT) + w * 2048;
    { f32x16 Oc[2];
      const int cu = 256 + b * 2 + g;
      cmp_branch(qf, WSP(bf16, WS_KC) + (size_t)cu * 8192, WSP(bf16, WS_VCT) + (size_t)cu * 8192, t, c, biasT, lane, scr, Oc, sel);
#pragma unroll
      for (int dt = 0; dt < 2; ++dt)
#pragma unroll
          for (int i = 0; i < 16; ++i) outw[(dt * 32 + crow(i, h)) * 32 + kl] = Oc[dt][i] * g0; }
    const size_t kvo = (size_t)(b * 2 + g) * SEQ * 64;
    prompt_branch<0>(F, WSP(bf16, WS_KS) + kvo, WSP(bf16, WS_VST) + kvo, 0, c, c, t, sel, qf, biasT, g1, outw);
    prompt_branch<1>(F, WSP(bf16, WS_KW) + kvo, WSP(bf16, WS_VWT) + kvo, c > 8 ? c - 8 : 0, c, c, t, sel, qf, biasT, g2, outw);
    bf16* mix = WSP(bf16, WS_MIX) + (size_t)row * DM + hd * 64;
#pragma unroll
    for (int dt = 0; dt < 2; ++dt)
#pragma unroll
        for (int a = 0; a < 4; ++a) { const LAS float* o4 = outw + (dt * 32 + 8 * a + 4 * h) * 32 + kl;
            v2u o; o.x = pk2(o4[0], o4[32]); o.y = pk2(o4[64], o4[96]); *(v2u*)(mix + dt * 32 + 8 * a + 4 * h) = o; }
}

constexpr int SA_BIAS = 0, SA_SCR = 2048, SA_ML = SA_SCR + 8 * 8 * 33 * 4, SA_OUT = SA_ML + 8 * 2 * 32 * 4, SA_RED = SA_OUT + 32 * 64 * 4, SA_END = SA_RED + 8 * 64 * 32 * 4;
struct SampTile { float v[2][2][8]; };
template <int MODE> DI const float* samp_tile_base(Frame& F, const int* pt, int b, int g, int li, int j, int ntile) {
    const bool fresh = (j == ntile - 1);
    if (MODE == 0) return fresh ? OUTF + O_SLCS + ((size_t)(b * 2 + li) * DT) * 256 + g * 64 : KIN(I_CSLC) + (((size_t)pt[j >> 2] * 2 + li) * PAGE + (j & 3) * 32) * 256 + g * 64;
    return fresh ? OUTF + O_WINS + ((size_t)(b * 2 + li) * WIN + (WIN - DT)) * 256 + g * 64 : KIN(I_CWIN) + ((size_t)(b * 2 + li) * WIN + 32 * j) * 256 + g * 64;
}
DI void samp_tile_load(SampTile& T, const float* base, int rmask, int kl, int h) {
#pragma unroll
    for (int st = 0; st < 2; ++st)
#pragma unroll
        for (int jj = 0; jj < 8; ++jj) { const int kr = (16 * st + 8 * (jj >> 2) + 4 * h + (jj & 3)) & rmask; const float* vp = base + (size_t)kr * 256 + 128 + kl; T.v[st][0][jj] = vp[0]; T.v[st][1][jj] = vp[32]; }
}
template <int MODE>
DI void sample_branch(Frame& F, int b, int g, int li, int t, unsigned sel, const bf16x8 (&qf)[4], const LAS float* biasT) {
    const int w = F.wave, lane = F.lane, kl = lane & 31, h = lane >> 5, hq = kl & 3;
    const int ntile = (MODE == 0) ? 65 : 17;
    f32x16 O[2]; float l = 0.f;
#pragma unroll
    for (int i = 0; i < 16; ++i) { O[0][i] = 0.f; O[1][i] = 0.f; }
    const int* pt = (const int*)KIN(I_PT) + b * NPAGE;
    SampTile T;
    samp_tile_load(T, samp_tile_base<MODE>(F, pt, b, g, li, w, ntile), (w == ntile - 1) ? 7 : 31, kl, h);
    for (int j = w; j < ntile; j += NWAVES) {
        const bool fresh = (j == ntile - 1);
        const int pos0 = fresh ? PAST : (MODE == 0 ? 32 * j : PAST - WIN + 32 * j);
        bf16x8 kf[4], vf[2][2];
        { const float* kp = samp_tile_base<MODE>(F, pt, b, g, li, j, ntile) + (size_t)(kl & (fresh ? 7 : 31)) * 256 + 8 * h;
#pragma unroll
          for (int ks = 0; ks < 4; ++ks) { const f32x4 x0 = *(const f32x4*)(kp + 16 * ks), x1 = *(const f32x4*)(kp + 16 * ks + 4); v4u av; av.x = pk2(x0.x, x0.y); av.y = pk2(x0.z, x0.w); av.z = pk2(x1.x, x1.y); av.w = pk2(x1.z, x1.w); kf[ks] = __builtin_bit_cast(bf16x8, av); } }
#pragma unroll
        for (int st = 0; st < 2; ++st)
#pragma unroll
            for (int dt = 0; dt < 2; ++dt) { v4u av; av.x = pk2(T.v[st][dt][0], T.v[st][dt][1]); av.y = pk2(T.v[st][dt][2], T.v[st][dt][3]); av.z = pk2(T.v[st][dt][4], T.v[st][dt][5]); av.w = pk2(T.v[st][dt][6], T.v[st][dt][7]); vf[dt][st] = __builtin_bit_cast(bf16x8, av); }
        if (j + NWAVES < ntile) samp_tile_load(T, samp_tile_base<MODE>(F, pt, b, g, li, j + NWAVES, ntile), (j + NWAVES == ntile - 1) ? 7 : 31, kl, h);
        f32x16 S;
#pragma unroll
        for (int i = 0; i < 16; ++i) S[i] = 0.f;
#pragma unroll
        for (int ks = 0; ks < 4; ++ks) S = MFMA32(kf[ks], qf[ks], S);
        { float bv[16];
#pragma unroll
          for (int i = 0; i < 16; ++i) { const int dist = t - (pos0 + crow(i, h)); const int idx = dist < 0 ? 0 : (dist > 127 ? 127 : dist); bv[i] = biasT[hq * 128 + idx]; }
          const bool blk_ok = (MODE == 1) || fresh || (((sel >> ((j >> 1) & 31)) & 1u) != 0u);
#pragma unroll
          for (int i = 0; i < 16; ++i) { const int ko = crow(i, h); const int dist = t - (pos0 + ko);
            const bool ok = blk_ok && dist >= 0 && (!fresh || ko < DT) && (MODE == 0 || dist < WIN);
            const float v = S[i] * SC2 + (bv[i] - SREF); S[i] = ok ? v : -INFINITY; } }
        softmax_pv(S, l, O, vf);
    }
    l += __shfl_xor(l, 32);
    LAS float* ml = (LAS float*)(F.lds + RING_OFF + SA_ML); LAS float* red = (LAS float*)(F.lds + RING_OFF + SA_RED) + w * 2048;
    if (h == 0) { ml[(w * 2 + 0) * 32 + kl] = 0.f; ml[(w * 2 + 1) * 32 + kl] = l; }
#pragma unroll
    for (int dt = 0; dt < 2; ++dt)
#pragma unroll
        for (int i = 0; i < 16; ++i) red[(dt * 32 + crow(i, h)) * 32 + kl] = O[dt][i];
}
DI void sample_combine(Frame& F, int b, int g, int gi) {
    const LAS float* ml = (const LAS float*)(F.lds + RING_OFF + SA_ML); const LAS float* red = (const LAS float*)(F.lds + RING_OFF + SA_RED);
    LAS float* outF = (LAS float*)(F.lds + RING_OFF + SA_OUT);
    const int q = F.tid & 31, d0 = (F.tid >> 5) * 4;
    float M = NEG_BIG;
#pragma unroll
    for (int w = 0; w < 8; ++w) M = fmaxf(M, ml[(w * 2) * 32 + q]);
    float L = 0.f, o[4] = {0.f, 0.f, 0.f, 0.f};
#pragma unroll
    for (int w = 0; w < 8; ++w) { const float f = fexp2(ml[(w * 2) * 32 + q] - M); L += ml[(w * 2 + 1) * 32 + q] * f;
#pragma unroll
        for (int k = 0; k < 4; ++k) o[k] += red[w * 2048 + (d0 + k) * 32 + q] * f; }
    const int row = MP + b * DT + (q >> 2), hd = g * 4 + (q & 3);
    const float gate = WSP(float, WS_GATE)[(size_t)row * 32 + hd * 3 + gi];
    const float sc = L > 0.f ? gate / L : 0.f;
#pragma unroll
    for (int k = 0; k < 4; ++k) outF[q * 64 + d0 + k] += o[k] * sc;
}
DI void attn_sample_unit(Frame& F, int b, int g, int li) {
    const int w = F.wave, lane = F.lane, kl = lane & 31, h = lane >> 5, hq = kl & 3, tl = kl >> 2, hd = g * 4 + hq;
    LAS float* biasT = (LAS float*)(F.lds + RING_OFF + SA_BIAS); LAS float* scr = (LAS float*)(F.lds + RING_OFF + SA_SCR) + w * 8 * 33;
    LAS float* outF = (LAS float*)(F.lds + RING_OFF + SA_OUT);
    fill_bias_table(F, biasT, g);
    const int t = PAST + tl, row = MP + b * DT + tl;
    bf16x8 qf[4];
#pragma unroll
    for (int ks = 0; ks < 4; ++ks) qf[ks] = *(const bf16x8*)(WSP(bf16, WS_QB) + (size_t)row * 512 + hd * 64 + 16 * ks + 8 * h);
    __syncthreads();
    f32x16 Oc[2]; unsigned sel;
    const int cu = b * 2 + g;
    cmp_branch(qf, WSP(bf16, WS_KC) + (size_t)cu * 8192, WSP(bf16, WS_VCT) + (size_t)cu * 8192, t, 32, biasT, lane, scr, Oc, sel);
    if (w == 0) { const float g0 = WSP(float, WS_GATE)[(size_t)row * 32 + hd * 3];
#pragma unroll
        for (int dt = 0; dt < 2; ++dt)
#pragma unroll
            for (int i = 0; i < 16; ++i) outF[kl * 64 + dt * 32 + crow(i, h)] = Oc[dt][i] * g0; }
    sample_branch<0>(F, b, g, li, t, sel, qf, biasT);
    __syncthreads();
    sample_combine(F, b, g, 1);
    __syncthreads();
    sample_branch<1>(F, b, g, li, t, sel, qf, biasT);
    __syncthreads();
    sample_combine(F, b, g, 2);
    __syncthreads();
    { const int q = F.tid >> 4, d4 = (F.tid & 15) * 4; const LAS float* s = outF + q * 64 + d4;
      v2u o; o.x = pk2(s[0], s[1]); o.y = pk2(s[2], s[3]);
      *(v2u*)(WSP(bf16, WS_MIX) + (size_t)(MP + b * DT + (q >> 2)) * DM + (g * 4 + (q & 3)) * 64 + d4) = o; }
    __syncthreads();
}

constexpr int SCN_STEPS = 32, SCN_CH = SCN_STEPS * 384 * 4  , SCN_Y = 2 * SCN_CH, SCN_END = SCN_Y + 2 * SCN_STEPS * 32 * 4;
struct ScanOps { f32x4 w0, w1, k0, k1, b0, b1, m0, m1, r0, r1; float v; };
DI ScanOps scan_ld(const LAS float* ch, int st, int cj, int irow) { const LAS float* c = ch + st * 384 + cj * 8; ScanOps o;
    o.w0 = *(const LAS f32x4*)(c); o.w1 = *(const LAS f32x4*)(c + 4); o.k0 = *(const LAS f32x4*)(c + 64); o.k1 = *(const LAS f32x4*)(c + 68); o.b0 = *(const LAS f32x4*)(c + 128); o.b1 = *(const LAS f32x4*)(c + 132);
    o.m0 = *(const LAS f32x4*)(c + 192); o.m1 = *(const LAS f32x4*)(c + 196); o.r0 = *(const LAS f32x4*)(c + 256); o.r1 = *(const LAS f32x4*)(c + 260); o.v = ch[st * 384 + 320 + irow]; return o; }
DI float dot8(const f32x4 a0, const f32x4 a1, const f32x4 b0, const f32x4 b1) { const f32x4 p = a0 * b0 + a1 * b1; return (p.x + p.y) + (p.z + p.w); }
DI float scan_step(f32x4& s0, f32x4& s1, const ScanOps& o) {
    float sa = dot8(s0, s1, o.k0, o.k1);
    const f32x4 t0 = s0 * o.w0 + o.m0 * o.v, t1 = s1 * o.w1 + o.m1 * o.v;
    sa = sum8(sa);
    s0 = t0 - o.b0 * sa; s1 = t1 - o.b1 * sa;
    return sum8(dot8(s0, s1, o.r0, o.r1));
}
struct ScanRaw { f32x4 w; v2u b[5]; };
DI void scan_stage_load(const unsigned char* rec, int c4, ScanRaw& pre) { pre.w = *(const f32x4*)(rec + 16 * c4);
#pragma unroll
    for (int k = 0; k < 5; ++k) pre.b[k] = *(const v2u*)(rec + SCR_KK + 128 * k + 8 * c4); }
DI f32x4 unpk4(const v2u w) { return (f32x4){bflo(w.x), bfhi(w.x), bflo(w.y), bfhi(w.y)}; }
DI void scan_stage_store(LAS float* rec, int c4, const ScanRaw& pre, const f32x4 ka) { LAS float* p = rec + 4 * c4;
    const f32x4 kk = unpk4(pre.b[0]), a = unpk4(pre.b[1]), k = unpk4(pre.b[2]);
    *(LAS f32x4*)(p) = pre.w; *(LAS f32x4*)(p + 64) = kk; *(LAS f32x4*)(p + 128) = kk * a; *(LAS f32x4*)(p + 192) = k * ((a - 1.0f) * ka + 1.0f); *(LAS f32x4*)(p + 256) = unpk4(pre.b[3]); *(LAS f32x4*)(p + 320) = unpk4(pre.b[4]); }
typedef short bf16x4 __attribute__((ext_vector_type(4)));
#define MFMA16(a, b, c) __builtin_amdgcn_mfma_f32_16x16x16bf16_1k((a), (b), (c), 0, 0, 0)
DI bf16x4 pack4(const f32x4 v) { v2u r; r.x = pk2(v.x, v.y); r.y = pk2(v.z, v.w); return __builtin_bit_cast(bf16x4, r); }
constexpr int CK_L = 16, CK_NB = 4, CK_PA = 68  , CK_PS = 20  ;
constexpr int CKO_AL = 0, CKO_RH = CKO_AL + 16 * CK_PA * 2, CKO_BR = CKO_RH + 16 * CK_PA * 2, CKO_MR = CKO_BR + 16 * CK_PA * 2, CKO_NBC = CKO_MR + 16 * CK_PA * 2, CKO_MUC = CKO_NBC + 64 * CK_PS * 2,
              CKO_VTB = CKO_MUC + 64 * CK_PS * 2, CKO_QT = CKO_VTB + 64 * CK_PS * 2, CKO_NT = CKO_QT + 16 * CK_PS * 2, CKO_NT1 = CKO_NT + 16 * CK_PS * 2, CKO_T2T = CKO_NT1 + 16 * CK_PS * 2, CKO_GL = CKO_T2T + 16 * CK_PS * 2,
              CK_BUF = CKO_GL + 64 * 4, CK_PRIV = CK_NB * CK_BUF  , CK_PRIVB = 8 * SCR_BYTES, CK_YB = CK_PRIV + 4 * CK_PRIVB  , CK_END = CK_YB + 2 * 4096;
static_assert(CK_BUF % 16 == 0 && CK_PRIVB % 16 == 0 && CK_END <= RING_BYTES, "chunked scan LDS map");
#define CK_BAR() asm volatile("s_waitcnt lgkmcnt(0)\n\ts_barrier" ::: "memory")
template <int TB> DI void ck_h1_half(const LAS unsigned char* raw, LAS unsigned char* cb, int lane, float kaj, float& gm) {
    float hw_w[8]; unsigned hw_kk[8], hw_a[8], hw_k[8], hw_r[8], hw_v[8];
#pragma unroll
    for (int t = 0; t < 8; ++t) { const LAS unsigned char* rr = raw + t * SCR_BYTES;
        hw_w[t] = *(const LAS float*)(rr + 4 * lane); hw_kk[t] = *(const LAS bf16*)(rr + SCR_KK + 2 * lane); hw_a[t] = *(const LAS bf16*)(rr + SCR_A + 2 * lane);
        hw_k[t] = *(const LAS bf16*)(rr + SCR_K + 2 * lane); hw_r[t] = *(const LAS bf16*)(rr + SCR_R + 2 * lane); hw_v[t] = *(const LAS bf16*)(rr + SCR_V + 2 * lane); }
    asm volatile("s_waitcnt lgkmcnt(0)" ::: "memory");
    unsigned nb[4], mc[4], vc[4];
#pragma unroll
    for (int t = 0; t < 8; ++t) {
        const float kap = bf2f(hw_kk[t]), av = bf2f(hw_a[t]);
        const float al = kap * gm; gm *= hw_w[t]; const float ig = __builtin_amdgcn_rcpf(gm);
        const float be = kap * av * ig, mu = bf2f(hw_k[t]) * ((av - 1.0f) * kaj + 1.0f) * ig, rh = bf2f(hw_r[t]) * gm;
        const unsigned bm = pk2(be, mu), ar = pk2(al, rh);
        *(LAS bf16*)(cb + CKO_AL + ((TB + t) * CK_PA + lane) * 2) = (bf16)(ar & 0xffffu); *(LAS bf16*)(cb + CKO_RH + ((TB + t) * CK_PA + lane) * 2) = (bf16)(ar >> 16);
        *(LAS bf16*)(cb + CKO_BR + ((TB + t) * CK_PA + lane) * 2) = (bf16)(bm & 0xffffu); *(LAS bf16*)(cb + CKO_MR + ((TB + t) * CK_PA + lane) * 2) = (bf16)(bm >> 16);
        if (t & 1) { nb[t >> 1] |= ((bm & 0xffffu) ^ 0x8000u) << 16; mc[t >> 1] |= bm & 0xffff0000u; vc[t >> 1] |= hw_v[t] << 16; }
        else { nb[t >> 1] = (bm & 0xffffu) ^ 0x8000u; mc[t >> 1] = bm >> 16; vc[t >> 1] = hw_v[t]; } }
#pragma unroll
    for (int q = 0; q < 2; ++q) { v2u x; x.x = nb[2 * q]; x.y = nb[2 * q + 1]; *(LAS v2u*)(cb + CKO_NBC + (lane * CK_PS + TB + 4 * q) * 2) = x;
        x.x = mc[2 * q]; x.y = mc[2 * q + 1]; *(LAS v2u*)(cb + CKO_MUC + (lane * CK_PS + TB + 4 * q) * 2) = x; x.x = vc[2 * q]; x.y = vc[2 * q + 1]; *(LAS v2u*)(cb + CKO_VTB + (lane * CK_PS + TB + 4 * q) * 2) = x; }
}
DI void ck_gram_inverse(LAS unsigned char* cb, int l15, int g4) {
    f32x4 gp = (f32x4){0.f, 0.f, 0.f, 0.f}, gq = gp, g1 = gp, g2 = gp, gt = gp;
#pragma unroll
    for (int ks = 0; ks < 4; ++ks) { const int o = (l15 * CK_PA + 16 * ks + g4) * 2;
        const bf16x4 fb = *(const LAS bf16x4*)(cb + CKO_BR + o), fm = *(const LAS bf16x4*)(cb + CKO_MR + o), fa = *(const LAS bf16x4*)(cb + CKO_AL + o), fr = *(const LAS bf16x4*)(cb + CKO_RH + o);
        gp = MFMA16(fb, fa, gp); gq = MFMA16(fm, fa, gq); g1 = MFMA16(fb, fr, g1); g2 = MFMA16(fm, fr, g2); gt = MFMA16(fa, fb, gt); }
    f32x4 q4, n1, t2, p4, pt4, id;
#pragma unroll
    for (int e = 0; e < 4; ++e) { const int tau = g4 + e; q4[e] = tau < l15 ? gq[e] : 0.f; n1[e] = tau <= l15 ? -g1[e] : 0.f; t2[e] = tau <= l15 ? g2[e] : 0.f;
        p4[e] = tau < l15 ? gp[e] : 0.f; pt4[e] = l15 < tau ? gt[e] : 0.f; id[e] = tau == l15 ? 1.0f : 0.f; }
    *(LAS bf16x4*)(cb + CKO_QT + (l15 * CK_PS + g4) * 2) = pack4(q4); *(LAS bf16x4*)(cb + CKO_NT1 + (l15 * CK_PS + g4) * 2) = pack4(n1); *(LAS bf16x4*)(cb + CKO_T2T + (l15 * CK_PS + g4) * 2) = pack4(t2);
    const f32x4 z4 = (f32x4){0.f, 0.f, 0.f, 0.f};
    const bf16x4 Pb = pack4(p4), PTb = pack4(pt4);
    const f32x4 P2 = MFMA16(PTb, Pb, z4), P2T = MFMA16(Pb, PTb, z4);
    const bf16x4 P2b = pack4(P2), P2Tb = pack4(P2T);
    const f32x4 P4 = MFMA16(P2Tb, P2b, z4), P4T = MFMA16(P2b, P2Tb, z4);
    const f32x4 P8 = MFMA16(pack4(P4T), pack4(P4), z4);
    const bf16x4 M1Tb = pack4(id - pt4), M2b = pack4(id + P2), M4b = pack4(id + P4);
    const f32x4 R1T = MFMA16(M2b, M1Tb, z4);
    const f32x4 R2T = MFMA16(M4b, pack4(R1T), z4);
    const f32x4 N = MFMA16(pack4(R2T), pack4(id + P8), z4);
    *(LAS bf16x4*)(cb + CKO_NT + (l15 * CK_PS + g4) * 2) = pack4(N);
}
struct CkPostIn { v2u r[4], k[4], a[4], v[4]; f32x4 g[4]; };
struct CkPostC { f32x4 ka, rk, lw, lb; };
DI void ck_post_load(Frame& F, CkPostIn& p, int row0, int h, int lane) { const int i0 = (lane & 15) * 4;
#pragma unroll
    for (int q = 0; q < 4; ++q) { const int row = row0 + 4 * q + (lane >> 4); const unsigned char* c = SCREC(row, h) + i0 * 2;
        p.r[q] = *(const v2u*)(c + SCR_R); p.k[q] = *(const v2u*)(c + SCR_K); p.a[q] = *(const v2u*)(c + SCR_A); p.v[q] = *(const v2u*)(c + SCR_V);
        p.g[q] = *(const f32x4*)(WSP(float, WS_G) + (size_t)row * 512 + h * 64 + i0); } }
DI void ck_post(Frame& F, const CkPostIn& p, const CkPostC& k, const LAS float* yb, int row0, int h, int lane) { const int i0 = (lane & 15) * 4;
#pragma unroll
    for (int q = 0; q < 4; ++q) { const int t = 4 * q + (lane >> 4), row = row0 + t;
        const f32x4 y = *(const LAS f32x4*)(yb + t * 64 + i0);
        const float mu = sum16((y.x + y.y) + (y.z + y.w)) * (1.f / 64.f);
        const f32x4 dv = y - mu;
        const float var = sum16((dv.x * dv.x + dv.y * dv.y) + (dv.z * dv.z + dv.w * dv.w)) * (1.f / 64.f);
        const float rs = __builtin_amdgcn_rsqf(var + GN_EPS);
        const f32x4 r = unpk4(p.r[q]), km = unpk4(p.k[q]) * ((unpk4(p.a[q]) - 1.0f) * k.ka + 1.0f);
        const float bon = sum16((r.x * km.x * k.rk.x + r.y * km.y * k.rk.y) + (r.z * km.z * k.rk.z + r.w * km.w * k.rk.w));
        const f32x4 o = (dv * rs * k.lw + k.lb + unpk4(p.v[q]) * bon) * p.g[q];
        v2u pk; pk.x = pk2(o.x, o.y); pk.y = pk2(o.z, o.w);
        *(v2u*)(WSP(bf16, WS_MIX) + (size_t)row * DM + 512 + h * 64 + i0) = pk; } }
DI void scan_prompt_unit(Frame& F, int b, int h, int li) {
    const int w = F.wave, lane = F.lane, l15 = lane & 15, g4 = (lane >> 4) * 4;
    LAS unsigned char* lds = F.lds + RING_OFF;
    constexpr int NCH = SEQ / CK_L;
    if (w < 4) {
        f32x4 T[4];
#pragma unroll
        for (int c = 0; c < 4; ++c) T[c] = (f32x4){0.f, 0.f, 0.f, 0.f};
        CK_BAR(); CK_BAR(); CK_BAR();
        for (int c0 = 0; c0 < NCH; ++c0) {
            const LAS unsigned char* cb = lds + (c0 % CK_NB) * CK_BUF;
            bf16x4 tb[4];
#pragma unroll
            for (int c = 0; c < 4; ++c) tb[c] = pack4(T[c]);
            f32x4 a1 = (f32x4){0.f, 0.f, 0.f, 0.f}, a2 = a1;
#pragma unroll
            for (int c = 0; c < 4; ++c) { const bf16x4 fa = *(const LAS bf16x4*)(cb + CKO_AL + (l15 * CK_PA + 16 * c + g4) * 2), fr = *(const LAS bf16x4*)(cb + CKO_RH + (l15 * CK_PA + 16 * c + g4) * 2);
                a1 = MFMA16(fa, tb[c], a1); a2 = MFMA16(fr, tb[c], a2); }
            const bf16x4 vt = *(const LAS bf16x4*)(cb + CKO_VTB + ((16 * w + l15) * CK_PS + g4) * 2);
            a1 = MFMA16(*(const LAS bf16x4*)(cb + CKO_QT + (l15 * CK_PS + g4) * 2), vt, a1);
            const f32x4 z4 = (f32x4){0.f, 0.f, 0.f, 0.f};
            const f32x4 U = MFMA16(*(const LAS bf16x4*)(cb + CKO_NT + (l15 * CK_PS + g4) * 2), pack4(a1), z4);
            const bf16x4 ub = pack4(U);
            a2 = MFMA16(*(const LAS bf16x4*)(cb + CKO_NT1 + (l15 * CK_PS + g4) * 2), ub, a2);
            a2 = MFMA16(*(const LAS bf16x4*)(cb + CKO_T2T + (l15 * CK_PS + g4) * 2), vt, a2);
            { LAS float* yp = (LAS float*)(lds + CK_YB + (c0 & 1) * 4096) + g4 * 64 + 16 * w + l15; yp[0] = a2.x; yp[64] = a2.y; yp[128] = a2.z; yp[192] = a2.w; }
#pragma unroll
            for (int c = 0; c < 4; ++c) { T[c] = MFMA16(*(const LAS bf16x4*)(cb + CKO_NBC + ((16 * c + l15) * CK_PS + g4) * 2), ub, T[c]);
                T[c] = MFMA16(*(const LAS bf16x4*)(cb + CKO_MUC + ((16 * c + l15) * CK_PS + g4) * 2), vt, T[c]);
                T[c] = T[c] * *(const LAS f32x4*)(cb + CKO_GL + (16 * c + g4) * 4); }
            CK_BAR();
        }
        float* so = OUTF + O_WKVP + ((size_t)((b * 2 + li) * 8 + h) * 64 + 16 * w + l15) * 64;
#pragma unroll
        for (int c = 0; c < 4; ++c) *(f32x4*)(so + 16 * c + g4) = T[c];
    } else {
        const int hw = w - 4;
        const float kaj = KIN(I_KA)[li * 512 + h * 64 + lane];
        LAS unsigned char* raw = lds + CK_PRIV + hw * CK_PRIVB;
        const int i0 = (lane & 15) * 4;
        CkPostC pc; pc.ka = *(const f32x4*)(KIN(I_KA) + (size_t)li * 512 + h * 64 + i0); pc.rk = *(const f32x4*)(KIN(I_RK) + (size_t)(li * 8 + h) * 64 + i0);
        pc.lw = *(const f32x4*)(KIN(I_LNW) + (size_t)li * 512 + h * 64 + i0); pc.lb = *(const f32x4*)(KIN(I_LNB) + (size_t)li * 512 + h * 64 + i0);
        f32x4 hr[16];
#pragma unroll
        for (int t = 0; t < 16; ++t) hr[t] = *(const f32x4*)(SCREC(b * SEQ + hw * CK_L + t, h) + 16 * (lane < 56 ? lane : 55));
        for (int i = 0; i < hw; ++i) CK_BAR();
        for (int c1 = hw; c1 < NCH; c1 += 4) {
            LAS unsigned char* cb = lds + (c1 % CK_NB) * CK_BUF;
#pragma unroll
            for (int t = 0; t < 8; ++t) if (lane < 56) *(LAS f32x4*)(raw + t * SCR_BYTES + 16 * lane) = hr[t];
            float gm = 1.0f; ck_h1_half<0>(raw, cb, lane, kaj, gm); CK_BAR();
#pragma unroll
            for (int t = 0; t < 8; ++t) if (lane < 56) *(LAS f32x4*)(raw + t * SCR_BYTES + 16 * lane) = hr[8 + t];
            ck_h1_half<8>(raw, cb, lane, kaj, gm); *(LAS float*)(cb + CKO_GL + lane * 4) = gm; CK_BAR();
            { const int rown = b * SEQ + (c1 + 4 < NCH ? c1 + 4 : c1) * CK_L;
#pragma unroll
              for (int t = 0; t < 16; ++t) hr[t] = *(const f32x4*)(SCREC(rown + t, h) + 16 * (lane < 56 ? lane : 55)); }
            const int cp = c1 > 0 ? c1 - 1 : 0;
            CkPostIn pin; ck_post_load(F, pin, b * SEQ + cp * CK_L, h, lane);
            ck_gram_inverse(cb, l15, g4); CK_BAR();
            if (c1 > 0) ck_post(F, pin, pc, (const LAS float*)(lds + CK_YB + (cp & 1) * 4096), b * SEQ + cp * CK_L, h, lane);
            CK_BAR();
        }
        for (int i = 0; i < 3 - hw; ++i) CK_BAR();
        if (hw == 0) { CkPostIn pin; ck_post_load(F, pin, b * SEQ + (NCH - 1) * CK_L, h, lane);
            ck_post(F, pin, pc, (const LAS float*)(lds + CK_YB + ((NCH - 1) & 1) * 4096), b * SEQ + (NCH - 1) * CK_L, h, lane); }
    }
}
DI void scan_post_phase(Frame& F, int li) {
    const float* YR = WSP(float, WS_YRAW);
    const int i0 = (F.tid & 15) * 4;
    for (int it0 = F.bid * (NTHREADS / 16) + (F.tid >> 4); it0 < MP * 8; it0 += 2 * F.G * (NTHREADS / 16)) {
        f32x4 y[2], r[2], kraw[2], av[2], v[2], gg[2];
#pragma unroll
        for (int q = 0; q < 2; ++q) { const int it = it0 + q * F.G * (NTHREADS / 16), row = it >> 3, h = it & 7; const unsigned char* c = SCREC(row, h) + i0 * 2;
            y[q] = *(const f32x4*)(YR + (size_t)row * 512 + h * 64 + i0); r[q] = unpk4(*(const v2u*)(c + SCR_R)); kraw[q] = unpk4(*(const v2u*)(c + SCR_K)); av[q] = unpk4(*(const v2u*)(c + SCR_A)); v[q] = unpk4(*(const v2u*)(c + SCR_V));
            gg[q] = *(const f32x4*)(WSP(float, WS_G) + (size_t)row * 512 + h * 64 + i0); }
#pragma unroll
        for (int q = 0; q < 2; ++q) { const int it = it0 + q * F.G * (NTHREADS / 16), row = it >> 3, h = it & 7;
            const float mu = sum16((y[q].x + y[q].y) + (y[q].z + y[q].w)) * (1.f / 64.f);
            const f32x4 dv = y[q] - mu;
            const float var = sum16((dv.x * dv.x + dv.y * dv.y) + (dv.z * dv.z + dv.w * dv.w)) * (1.f / 64.f);
            const float rs = __builtin_amdgcn_rsqf(var + GN_EPS);
            const f32x4 km = kraw[q] * ((av[q] - 1.0f) * *(const f32x4*)(KIN(I_KA) + (size_t)li * 512 + h * 64 + i0) + 1.0f);
            const f32x4 rk = *(const f32x4*)(KIN(I_RK) + (size_t)(li * 8 + h) * 64 + i0);
            const float bon = sum16((r[q].x * km.x * rk.x + r[q].y * km.y * rk.y) + (r[q].z * km.z * rk.z + r[q].w * km.w * rk.w));
            const f32x4 lw = *(const f32x4*)(KIN(I_LNW) + (size_t)li * 512 + h * 64 + i0), lb = *(const f32x4*)(KIN(I_LNB) + (size_t)li * 512 + h * 64 + i0);
            const f32x4 o = (dv * rs * lw + lb + v[q] * bon) * gg[q];
            v2u pk; pk.x = pk2(o.x, o.y); pk.y = pk2(o.z, o.w);
            *(v2u*)(WSP(bf16, WS_MIX) + (size_t)row * DM + 512 + h * 64 + i0) = pk; }
    }
}
DI void scan_sample_unit(Frame& F, int b, int li) {
    const int h = F.wave, lane = F.lane;
    LAS float* ch = (LAS float*)(F.lds + RING_OFF) + h * (DT * 384);
    LAS float* yb = (LAS float*)(F.lds + RING_OFF + 8 * DT * 384 * 4) + h * (DT * 64);
#pragma unroll
    for (int k = 0; k < 2; ++k) { const int it = lane + 64 * k, tk = it >> 4, c4 = it & 15; ScanRaw pre;
        scan_stage_load(SCREC(MP + b * DT + tk, h), c4, pre);
        scan_stage_store(ch + tk * 384, c4, pre, *(const f32x4*)(KIN(I_KA) + (size_t)li * 512 + h * 64 + 4 * c4)); }
    float s[64];
    const float* s0 = KIN(I_SWKV) + ((size_t)((b * 2 + li) * 8 + h) * 64 + lane) * 64;
#pragma unroll
    for (int j = 0; j < 16; ++j) { const f32x4 x = ((const f32x4*)s0)[j]; s[4 * j] = x.x; s[4 * j + 1] = x.y; s[4 * j + 2] = x.z; s[4 * j + 3] = x.w; }
    LDS_WAIT(); asm volatile("" ::: "memory");
    for (int st = 0; st < DT; ++st) {
        const LAS float* c = ch + st * 384;
        float sa = 0.f;
#pragma unroll
        for (int j = 0; j < 64; ++j) sa += s[j] * c[64 + j];
        sa = -sa;
        const float v = c[320 + lane];
        float y = 0.f;
#pragma unroll
        for (int j = 0; j < 64; ++j) { s[j] = s[j] * c[j] + sa * c[128 + j] + v * c[192 + j]; y += s[j] * c[256 + j]; }
        yb[st * 64 + lane] = y;
    }
    float* so = OUTF + O_WKVS + ((size_t)((b * 2 + li) * 8 + h) * 64 + lane) * 64;
#pragma unroll
    for (int j = 0; j < 16; ++j) ((f32x4*)so)[j] = (f32x4){s[4 * j], s[4 * j + 1], s[4 * j + 2], s[4 * j + 3]};
    LDS_WAIT(); asm volatile("" ::: "memory");
#pragma unroll
    for (int ps = 0; ps < 2; ++ps) {
        const int tok = ps * 4 + (lane >> 4), i0 = (lane & 15) * 4;
        const LAS float* c = ch + tok * 384;
        const f32x4 y = *(const LAS f32x4*)(yb + tok * 64 + i0);
        const float mu = sum16((y.x + y.y) + (y.z + y.w)) * (1.f / 64.f);
        const f32x4 dv = y - mu;
        const float var = sum16((dv.x * dv.x + dv.y * dv.y) + (dv.z * dv.z + dv.w * dv.w)) * (1.f / 64.f);
        const float rs = 1.0f / sqrtf(var + GN_EPS);
        const f32x4 r = *(const LAS f32x4*)(c + 4 * 64 + i0), km = *(const LAS f32x4*)(c + 3 * 64 + i0), v = *(const LAS f32x4*)(c + 5 * 64 + i0);
        const f32x4 rk = *(const f32x4*)(KIN(I_RK) + (size_t)(li * 8 + h) * 64 + i0);
        const float bon = sum16((r.x * km.x * rk.x + r.y * km.y * rk.y) + (r.z * km.z * rk.z + r.w * km.w * rk.w));
        const f32x4 lw = *(const f32x4*)(KIN(I_LNW) + (size_t)li * 512 + h * 64 + i0), lb = *(const f32x4*)(KIN(I_LNB) + (size_t)li * 512 + h * 64 + i0);
        const int row = MP + b * DT + tok;
        const f32x4 gg = *(const f32x4*)(WSP(float, WS_G) + (size_t)row * 512 + h * 64 + i0);
        const f32x4 o = (dv * rs * lw + lb + v * bon) * gg;
        v2u pk; pk.x = pk2(o.x, o.y); pk.y = pk2(o.z, o.w);
        *(v2u*)(WSP(bf16, WS_MIX) + (size_t)row * DM + 512 + h * 64 + i0) = pk;
    }
    __syncthreads();
}

extern __shared__ __attribute__((aligned(16))) unsigned char g_lds[];
DI int take_ticket(Frame& F, int word) {
    volatile LAS unsigned* tk = F.MISC + 16;
    __syncthreads();
    if (F.tid == 0) tk[0] = __hip_atomic_fetch_add((unsigned*)(F.ctl + word), 1u, RLX_AGENT);
    __syncthreads();
    return __builtin_amdgcn_readfirstlane((int)tk[0]);
}

struct EpiStoreBf16 { static constexpr int PID = 16;
    static constexpr bool PERM = true, AFTER_DRAIN = false;
    bf16* O; int ldc;
    DI void operator()(const f32x4 (&acc)[2][2][4][2], const pg8::Unit& u, int wr, int wc, int fr, int fq) const {
        const int row0 = u.pm * 256 + wr * 64 + fr, col0 = u.pn * 256 + wc * 32 + 8 * fq;
#pragma unroll
        for (int ai = 0; ai < 2; ++ai)
#pragma unroll
            for (int m = 0; m < 4; ++m) { bf16* rowp = O + (size_t)(row0 + ai * 128 + m * 16) * ldc + col0;
#pragma unroll
                for (int bj = 0; bj < 2; ++bj) { const f32x4 v0 = acc[ai][bj][m][0], v1 = acc[ai][bj][m][1];
                    v4u w; w.x = pk2(v0[0], v0[1]); w.y = pk2(v0[2], v0[3]); w.z = pk2(v1[0], v1[1]); w.w = pk2(v1[2], v1[3]);
                    *(v4u*)(rowp + bj * 128) = w; } }
    }
};
struct EpiPart { static constexpr int PID = 20;
    static constexpr bool PERM = false, AFTER_DRAIN = false;
    float* C;
    DI void operator()(const f32x4 (&acc)[2][2][4][2], const pg8::Unit& u, int wr, int wc, int fr, int fq) const {
        const int row0 = u.pm * 256 + wr * 64 + fr, col0 = wc * 32 + 4 * fq;
#pragma unroll
        for (int ai = 0; ai < 2; ++ai)
#pragma unroll
            for (int m = 0; m < 4; ++m) { float* rowp = C + (size_t)(row0 + ai * 128 + m * 16) * 256 + col0;
#pragma unroll
                for (int bj = 0; bj < 2; ++bj)
#pragma unroll
                    for (int n = 0; n < 2; ++n) *(f32x4*)(rowp + bj * 128 + n * 16) = acc[ai][bj][m][n]; }
    }
};
struct EpiResid { static constexpr int PID = 18;
    static constexpr bool PERM = false, AFTER_DRAIN = false;
    const float* baseF;
    bf16* XB; float* Xout;
    unsigned long long* ssq;
    DI void operator()(const f32x4 (&acc)[2][2][4][2], const pg8::Unit& u, int wr, int wc, int fr, int fq) const {
        const int row0 = u.pm * 256 + wr * 64 + fr, col0 = u.pn * 256 + wc * 32 + 4 * fq;
        if (baseF) {
#pragma unroll
            for (int ai = 0; ai < 2; ++ai)
#pragma unroll
                for (int m = 0; m < 4; ++m) { const int row = row0 + ai * 128 + m * 16; const size_t off = (size_t)row * DM + col0; float sq = 0.f;
#pragma unroll
                    for (int bj = 0; bj < 2; ++bj)
#pragma unroll
                        for (int n = 0; n < 2; ++n) { const size_t o2 = off + bj * 128 + n * 16; const f32x4 x = *(const f32x4*)(baseF + o2) + acc[ai][bj][m][n];
                            v2u o; o.x = pk2(x[0], x[1]); o.y = pk2(x[2], x[3]); *(v2u*)(XB + o2) = o; sq += (x[0] * x[0] + x[1] * x[1]) + (x[2] * x[2] + x[3] * x[3]); }
                    sq += __shfl_xor(sq, 16); sq += __shfl_xor(sq, 32); if (fq == 0) __hip_atomic_fetch_add(ssq + row, (unsigned long long)(sq * SSQ_SCALE + 0.5f), RLX_AGENT);
                    if (m & 1) asm volatile("" ::: "memory"); }
            return;
        }
        v2u bw[2][4][2][2];
#pragma unroll
        for (int ai = 0; ai < 2; ++ai)
#pragma unroll
            for (int m = 0; m < 4; ++m)
#pragma unroll
                for (int bj = 0; bj < 2; ++bj)
#pragma unroll
                    for (int n = 0; n < 2; ++n) bw[ai][m][bj][n] = *(const v2u*)(XB + (size_t)(row0 + ai * 128 + m * 16) * DM + col0 + bj * 128 + n * 16);
#pragma unroll
        for (int ai = 0; ai < 2; ++ai)
#pragma unroll
            for (int m = 0; m < 4; ++m) { const int row = row0 + ai * 128 + m * 16; const size_t off = (size_t)row * DM + col0; float sq = 0.f;
#pragma unroll
                for (int bj = 0; bj < 2; ++bj)
#pragma unroll
                    for (int n = 0; n < 2; ++n) { const size_t o2 = off + bj * 128 + n * 16; const v2u wv = bw[ai][m][bj][n];
                        const f32x4 x = (f32x4){bflo(wv.x), bfhi(wv.x), bflo(wv.y), bfhi(wv.y)} + acc[ai][bj][m][n];
                        if (Xout) *(f32x4*)(Xout + o2) = x;
                        else { v2u o; o.x = pk2(x[0], x[1]); o.y = pk2(x[2], x[3]); *(v2u*)(XB + o2) = o; sq += (x[0] * x[0] + x[1] * x[1]) + (x[2] * x[2] + x[3] * x[3]); } }
                if (!Xout) { sq += __shfl_xor(sq, 16); sq += __shfl_xor(sq, 32); if (fq == 0) __hip_atomic_fetch_add(ssq + row, (unsigned long long)(sq * SSQ_SCALE + 0.5f), RLX_AGENT); } }
    }
};
struct EpiLora { static constexpr int PID = 19;
    static constexpr bool PERM = false, AFTER_DRAIN = false;
    unsigned char* SC; float* G; const float *w0, *a0;
    DI void operator()(const f32x4 (&acc)[2][2][4][2], const pg8::Unit& u, int wr, int wc, int fr, int fq) const {
        const int row0 = u.pm * 256 + wr * 64 + fr, seg = u.pn >> 1, cb = (u.pn & 1) * 256 + wc * 32 + 4 * fq;
#pragma unroll
        for (int bj = 0; bj < 2; ++bj)
#pragma unroll
            for (int n = 0; n < 2; ++n) {
                const int colh = cb + bj * 128 + n * 16, h = colh >> 6, d = colh & 63;
                f32x4 c0 = (f32x4){0.f, 0.f, 0.f, 0.f};
                if (seg == 0) c0 = *(const f32x4*)(w0 + colh); else if (seg == 1) c0 = *(const f32x4*)(a0 + colh);
#pragma unroll
                for (int ai = 0; ai < 2; ++ai)
#pragma unroll
                    for (int m = 0; m < 4; ++m) { const int row = row0 + ai * 128 + m * 16; const f32x4 a = acc[ai][bj][m][n];
                        unsigned char* scb = SC + ((size_t)row * 8 + h) * SCR_BYTES;
                        if (seg == 0) { f32x4 o;
#pragma unroll
                            for (int i = 0; i < 4; ++i) { const float y = -(c0[i] + a[i]); const float sp = fmaxf(y, 0.f) + __logf(1.0f + __expf(-fabsf(y))); o[i] = __expf(-__expf(-sp - 0.5f)); }
                            *(f32x4*)(scb + d * 4) = o; }
                        else if (seg == 1) { f32x4 o;
#pragma unroll
                            for (int i = 0; i < 4; ++i) o[i] = sigmoidf_(c0[i] + a[i]);
                            v2u ob; ob.x = pk2(o[0], o[1]); ob.y = pk2(o[2], o[3]); *(v2u*)(scb + SCR_A + d * 2) = ob; }
                        else *(f32x4*)(G + (size_t)row * 512 + colh) = a;
                    }
            }
    }
};
template <int CTRL> DI f32x4 dpp4(const f32x4 v) { return (f32x4){dppf<CTRL>(v.x), dppf<CTRL>(v.y), dppf<CTRL>(v.z), dppf<CTRL>(v.w)}; }
template <int CTRL> DI float dppf_old(float old, float x) { return __builtin_bit_cast(float, __builtin_amdgcn_update_dpp(__builtin_bit_cast(int, old), __builtin_bit_cast(int, x), CTRL, 0xf, 0xf, false)); }
template <int CTRL> DI f32x4 dpp4_old(const f32x4 o, const f32x4 v) { return (f32x4){dppf_old<CTRL>(o.x, v.x), dppf_old<CTRL>(o.y, v.y), dppf_old<CTRL>(o.z, v.z), dppf_old<CTRL>(o.w, v.w)}; }
DI f32x4 silu4_mul(const f32x4 y, const f32x4 u) { return (f32x4){y.x * sigmoidf_(y.x) * u.x, y.y * sigmoidf_(y.y) * u.y, y.z * sigmoidf_(y.z) * u.z, y.w * sigmoidf_(y.w) * u.w}; }
struct EpiFfnAct { static constexpr int PID = 17;
    static constexpr bool PERM = false, AFTER_DRAIN = false;
    bf16* H; float* HALO; const float* cw  ; const unsigned long long* ssq; const float* state  ; float* outP; float* outS; int l;
    DI void operator()(const f32x4 (&acc)[2][2][4][2], const pg8::Unit& u, int wr, int wc, int fr, int fq) const {
        const bool samp = u.pm >= MP / 256;
        float rinv[2][4];
#pragma unroll
        for (int ai = 0; ai < 2; ++ai)
#pragma unroll
            for (int m = 0; m < 4; ++m) rinv[ai][m] = rinv_of(ssq, u.pm * 256 + ai * 128 + wr * 64 + m * 16 + fr);
#pragma unroll
        for (int n = 0; n < 2; ++n) {
            const int ch = u.pn * 128 + wc * 32 + 16 * n + 4 * fq;
            const f32x4 w0 = *(const f32x4*)(cw + ch), w1 = *(const f32x4*)(cw + DFF + ch), w2 = *(const f32x4*)(cw + 2 * DFF + ch);
#pragma unroll
            for (int ai = 0; ai < 2; ++ai) {
                f32x4 pa = (f32x4){0.f, 0.f, 0.f, 0.f};
#pragma unroll
                for (int m = 0; m < 4; ++m) {
                    const int row = u.pm * 256 + ai * 128 + wr * 64 + m * 16 + fr;
                    const float rin = rinv[ai][m];
                    const f32x4 a = acc[ai][0][m][n] * rin, uu = acc[ai][1][m][n] * rin;
                    const f32x4 r1 = dpp4<0x121>(pa), r2 = dpp4<0x122>(pa);
                    f32x4 a1 = dpp4_old<0x111>(r1, a), a2 = dpp4_old<0x112>(r2, a);
                    if (samp) { const int t = fr & 7, b = (row - MP) >> 3;
                        if (t < 2) { const float* st = state + (size_t)b * (4 * 2 * DFF) + ch; const f32x4 st0 = *(const f32x4*)st, st1 = *(const f32x4*)(st + DFF);
                            if (t == 0) { a1 = st1; a2 = st0; } else a2 = st1; }
                        if (t >= 6) *(f32x4*)(outS + ((size_t)(b * 4 + l) * 2 + (t - 6)) * DFF + ch) = a;
                    } else {
                        const int blk = row >> 6;
                        if (m == 3) { if (fr >= 14) { *(f32x4*)(HALO + ((size_t)blk * 6 + (fr - 14)) * DFF + ch) = a;
                            if ((row & (SEQ - 1)) >= SEQ - 2) *(f32x4*)(outP + ((size_t)((row >> 11) * 4 + l) * 2 + ((row & (SEQ - 1)) - (SEQ - 2))) * DFF + ch) = a; } }
                        if (m == 0) { if (fr < 2) { *(f32x4*)(HALO + ((size_t)blk * 6 + 2 + fr) * DFF + ch) = a; *(f32x4*)(HALO + ((size_t)blk * 6 + 4 + fr) * DFF + ch) = uu; } }
                    }
                    const f32x4 y = w0 * a2 + w1 * a1 + w2 * a;
                    const f32x4 hv = silu4_mul(y, uu);
                    v2u o; o.x = pk2(hv.x, hv.y); o.y = pk2(hv.z, hv.w);
                    *(v2u*)(H + (size_t)row * DFF + ch) = o;
                    pa = a;
                }
            }
        }
    }
};
DI void ffn_fix_panel(Frame& F, int l, int pm) {
    const float* HALO = WSP(float, WS_HALO); const float* cw = KIN(I_FCONV) + (size_t)l * 3 * DFF; bf16* H = WSP(bf16, WS_H);
    constexpr int NC4 = DFF / 4;
    for (int it = F.tid; it < 4 * 2 * NC4; it += NTHREADS) {
        const int ch = (it % NC4) * 4, bj = it / NC4, blk = pm * 4 + (bj >> 1), j = bj & 1; const bool s0 = (blk & 31) == 0;
        const f32x4 z = (f32x4){0.f, 0.f, 0.f, 0.f};
        const f32x4 a = *(const f32x4*)(HALO + ((size_t)blk * 6 + 2 + j) * DFF + ch), uu = *(const f32x4*)(HALO + ((size_t)blk * 6 + 4 + j) * DFF + ch);
        f32x4 a1, a2;
        if (j == 1) { a1 = *(const f32x4*)(HALO + ((size_t)blk * 6 + 2) * DFF + ch); a2 = s0 ? z : *(const f32x4*)(HALO + ((size_t)(blk - 1) * 6 + 1) * DFF + ch); }
        else { a1 = s0 ? z : *(const f32x4*)(HALO + ((size_t)(blk - 1) * 6 + 1) * DFF + ch); a2 = s0 ? z : *(const f32x4*)(HALO + ((size_t)(blk - 1) * 6 + 0) * DFF + ch); }
        const f32x4 w0 = *(const f32x4*)(cw + ch), w1 = *(const f32x4*)(cw + DFF + ch), w2 = *(const f32x4*)(cw + 2 * DFF + ch);
        const f32x4 hv = silu4_mul(w0 * a2 + w1 * a1 + w2 * a, uu);
        v2u o; o.x = pk2(hv.x, hv.y); o.y = pk2(hv.z, hv.w);
        *(v2u*)(H + (size_t)(blk * 64 + j) * DFF + ch) = o;
    }
    asm volatile("s_waitcnt vmcnt(0)" ::: "memory"); __syncthreads();
    if (F.tid == 0) { __builtin_amdgcn_fence(__ATOMIC_ACQUIRE, "agent"); asm volatile("s_waitcnt vmcnt(0)" ::: "memory"); }
    __syncthreads();
}
template <int K> DI void gemm64_sample_phase(Frame& F, const bf16* A  , const bf16* Bt  , const float* baseF  , bf16* XB, float* Xout  , unsigned long long* ssq) {
    static_assert(K % 128 == 0, "K split over 8 waves in 16-wide steps");
    constexpr int KW = K / 8, NS = KW / 16;
    const int w = F.wave, lane = F.lane, kl = lane & 31, h = lane >> 5;
    LAS float* part = (LAS float*)(F.lds + RING_OFF);
    for (int tile = F.bid; tile < 256; tile += F.G) {
        const int x = tile & 7, r = tile >> 3, tm = 4 * (x & 3) + (r & 3), tn = 8 * (x >> 2) + (r >> 2);
        const bf16* ap = A + (size_t)(tm * 64 + kl) * K + w * KW + 8 * h; const bf16* bp = Bt + (size_t)(tn * 64 + kl) * K + w * KW + 8 * h;
        f32x16 acc[2][2];
#pragma unroll
        for (int i = 0; i < 16; ++i) { acc[0][0][i] = 0.f; acc[0][1][i] = 0.f; acc[1][0][i] = 0.f; acc[1][1][i] = 0.f; }
#pragma unroll 8
        for (int s = 0; s < NS; ++s) {
            const bf16x8 a0 = *(const bf16x8*)(ap + 16 * s), a1 = *(const bf16x8*)(ap + (size_t)32 * K + 16 * s);
            const bf16x8 b0 = *(const bf16x8*)(bp + 16 * s), b1 = *(const bf16x8*)(bp + (size_t)32 * K + 16 * s);
            acc[0][0] = MFMA32(a0, b0, acc[0][0]); acc[0][1] = MFMA32(a0, b1, acc[0][1]); acc[1][0] = MFMA32(a1, b0, acc[1][0]); acc[1][1] = MFMA32(a1, b1, acc[1][1]);
        }
        __syncthreads();
#pragma unroll
        for (int rb = 0; rb < 2; ++rb)
#pragma unroll
            for (int cb = 0; cb < 2; ++cb)
#pragma unroll
                for (int i = 0; i < 16; ++i) part[w * 4096 + (rb * 32 + crow(i, h)) * 64 + cb * 32 + kl] = acc[rb][cb][i];
        __syncthreads();
        { const int r = F.tid >> 3, c0 = (F.tid & 7) * 8; float o[8];
#pragma unroll
          for (int j = 0; j < 8; ++j) o[j] = 0.f;
#pragma unroll
          for (int ww = 0; ww < 8; ++ww) { const f32x4 p0 = *(const LAS f32x4*)(part + ww * 4096 + r * 64 + c0), p1 = *(const LAS f32x4*)(part + ww * 4096 + r * 64 + c0 + 4);
              o[0] += p0.x; o[1] += p0.y; o[2] += p0.z; o[3] += p0.w; o[4] += p1.x; o[5] += p1.y; o[6] += p1.z; o[7] += p1.w; }
          const int row = tm * 64 + r; const size_t off = (size_t)row * DM + tn * 64 + c0;
          float bsv[8]; if (baseF) ld8f(baseF + off, bsv); else ld8bf(XB + off, bsv); float sq = 0.f;
#pragma unroll
          for (int j = 0; j < 8; ++j) { o[j] += bsv[j]; sq += o[j] * o[j]; }
          if (Xout) store8f(Xout + off, o);
          else { v4u pk; pk.x = pk2(o[0], o[1]); pk.y = pk2(o[2], o[3]); pk.z = pk2(o[4], o[5]); pk.w = pk2(o[6], o[7]); *(v4u*)(XB + off) = pk;
              sq = sum8(sq); if ((F.tid & 7) == 0) __hip_atomic_fetch_add(ssq + row, (unsigned long long)(sq * SSQ_SCALE + 0.5f), RLX_AGENT); }
        }
    }
    __syncthreads();
}
struct CmpOrder {
    int G, c;
    DI bool next(int i, pg8::Unit& u) const { const int L = i * G + c; if (L >= CS_ROWS / 256) return false; u.pm = L; u.pn = (L < 128) ? 0 : (L < 256 ? 1 : (L < 264 ? 0 : 1)); return true; }
    DI void a_ready(const pg8::Unit&) const {}
    DI void done(const pg8::Unit&) const {}
};

#ifndef REPSCAN
#define REPSCAN 1
#endif
#ifndef REPATP
#define REPATP 1
#endif
#ifndef REPATS
#define REPATS 1
#endif
DI void sub_barrier(Frame& F, int word, unsigned n, int mode  ) {
    asm volatile("s_waitcnt vmcnt(0)" ::: "memory");
    __syncthreads();
    if (F.tid == 0) {
        unsigned* w = (unsigned*)(F.ctl + word);
        if (mode != 1) { __builtin_amdgcn_fence(__ATOMIC_RELEASE, "agent"); asm volatile("s_waitcnt vmcnt(0)" ::: "memory"); __hip_atomic_fetch_add(w, 1u, RLX_AGENT); }
        unsigned sp = 0;
        while (mode != 2 && __hip_atomic_load(w, RLX_AGENT) < n) { __builtin_amdgcn_s_sleep(2); if (++sp > (1u << 22)) { __hip_atomic_store(F.ctl + CW_TMO, 0xDEAD0000u | (unsigned)word, RLX_AGENT); break; } }
        __builtin_amdgcn_fence(__ATOMIC_ACQUIRE, "agent");
        asm volatile("s_waitcnt vmcnt(0)" ::: "memory");
    }
    __syncthreads();
}
struct CmpOwnOrder {
    int r, pr;
    DI bool next(int i, pg8::Unit& u) const { if (i == 0) { u.pm = pr ? 256 + r : r; u.pn = pr ? r >> 3 : 0; return true; } if (i == 1 && !pr) { u.pm = 128 + r; u.pn = 1; return true; } return false; }
    DI void a_ready(const pg8::Unit&) const {}
    DI void done(const pg8::Unit&) const {}
};
DI void mix_even_phase(Frame& F, int li, int rep) {
    const int qw = CW_QUEUE + 256 * li + 1024 * rep, sw = 2048 + 256 * (li * 2 + rep);
    const int NSC = 64;
    const int t0 = take_ticket(F, qw);
    if (t0 < NSC) { LAUNDER(F); PROBE_T0(1) scan_prompt_unit(F, t0 >> 3, t0 & 7, li); PROBE_T1(1) }
    else if (t0 < NSC + 144) {
        const int pr = t0 >= NSC + 128 ? 1 : 0, rank = t0 - NSC - 128 * pr; LAUNDER(F);
        { pg8::Gemm g{WSP(bf16, WS_CSEG), WSP(bf16, WS_PHI1) + (size_t)li * 512 * 1024, CS_ROWS, 512, 1024};
          CmpOwnOrder S{rank, pr}; EpiPart E{WSP(float, WS_PART)};
          pg8::gemm_phase<EpiPart, CmpOwnOrder, true, true>(F.lds + RING_OFF, g, S, E); }
        if (pr) sub_barrier(F, sw, 16u, 2);
        asm volatile("s_waitcnt vmcnt(0)" ::: "memory"); __syncthreads();
        if (F.tid == 0) { __builtin_amdgcn_fence(__ATOMIC_ACQUIRE, "agent"); asm volatile("s_waitcnt vmcnt(0)" ::: "memory"); }
        __syncthreads(); LAUNDER(F);
        compress2_stage_w2(F, li);
        if (pr) { sub_barrier(F, sw, 16u, 1); LAUNDER(F); compress2_unit(F, 256 + rank, li); sub_barrier(F, sw + 64, 16u, 2); LAUNDER(F); }
        else {
            compress2_unit(F, 2 * rank, li); compress2_unit(F, 2 * rank + 1, li);
            asm volatile("s_waitcnt vmcnt(0)" ::: "memory"); __syncthreads();
            if (F.tid == 0) { __builtin_amdgcn_fence(__ATOMIC_ACQUIRE, "agent"); asm volatile("s_waitcnt vmcnt(0)" ::: "memory"); }
            __syncthreads();
            for (int g = 0; g < 2; ++g) { LAUNDER(F); PROBE_T0(4) attn_sample_unit(F, rank, g, li); PROBE_T1(4) }
        }
    }
    else { LAUNDER(F); }
    for (int r2 = 0; r2 < REPSCAN; ++r2) for (;;) { const int u = take_ticket(F, qw + 64 + 2048 * r2); if (u >= DB) break; LAUNDER(F); PROBE_T0(9) scan_sample_unit(F, u, li); PROBE_T1(9) }
    sub_barrier(F, sw + 64, 16u, 1); LAUNDER(F);
    for (int r2 = 0; r2 < REPATP; ++r2) for (;;) { const int u = take_ticket(F, qw + 128 + 2048 * r2); if (u >= 512) break; LAUNDER(F);
        const int bg = u & 15, c = 31 - (u >> 4);
        PROBE_T0(3) attn_prompt_unit(F, bg >> 1, bg & 1, c, li); PROBE_T1(3) }
}

#ifndef MK_PER_PHASE
#define MK_PER_PHASE 0
#endif
constexpr int PH_PER_LAYER = 12, N_PHASES = 1 + DEPTH * PH_PER_LAYER;
#ifndef REP0
#define REP0 1
#endif
#ifndef REP1
#define REP1 1
#endif
#ifndef REP3
#define REP3 1
#endif
#ifndef REP4
#define REP4 1
#endif
#ifndef REP6
#define REP6 1
#endif
#ifndef REP7
#define REP7 1
#endif
#ifndef REP8
#define REP8 1
#endif
__global__ void __launch_bounds__(NTHREADS, 2) mk_fwd(Args args) {
    Frame F;
    F.lds = (LAS unsigned char*)g_lds;
    F.MISC = (volatile LAS unsigned*)(F.lds + MISC_OFF);
    F.tid = threadIdx.x; F.lane = F.tid & 63; F.wave = __builtin_amdgcn_readfirstlane(F.tid >> 6);
    F.G = gridDim.x; F.bid = blockIdx.x;
    F.out = (GAS float*)args.out; F.ws = (GAS unsigned char*)args.ws; F.ctl = (gu32*)(args.ws + WS_CTL); F.ka = (unsigned long long)__builtin_amdgcn_kernarg_segment_ptr();
    for (int u = F.tid; u < (LDS_BYTES - LDSCTL_OFF) / 4; u += NTHREADS) ((LAS unsigned*)(F.lds + LDSCTL_OFF))[u] = 0u;
    __syncthreads();
    XcdBarrier bar; bar.bar = (unsigned*)(F.ctl + CW_BAR); bar.x = 0; bar.st = nullptr;
    if (!MK_PER_PHASE) bar = xcd_barrier_post((unsigned*)(F.ctl + CW_BAR), F.MISC + 8);
    const int lo = args.ph_lo, hi = args.ph_hi;
#define IN(k) (lo <= (k) && (k) < hi)
#define SEAM(k) do { if (IN((k) + 1)) { if (MK_PER_PHASE) { if (F.tid == 0) __hip_atomic_store(F.ctl + CW_TMO, 0xBADBA0u, RLX_AGENT); } else { asm volatile("" : "+s"(bar.bar)); asm volatile("" : "+s"(bar.x)); xcd_barrier(bar); } } } while (0)
    LAS unsigned char* ring = F.lds + RING_OFF;

    if (IN(0)) { LAUNDER(F); PROBE_T0(7) p0_prologue(F); SEAM(0); PROBE_T1(7) }

    for (int l = 0; l < DEPTH; ++l) {
        const int li = l >> 1; const bool even = (l & 1) == 0; const int pb = 1 + l * PH_PER_LAYER;
        if (IN(pb + 0)) for (int rep = 0; rep < REP0; ++rep) { LAUNDER(F); PROBE_T0(11)
            constexpr int BG_QUOTA = 4; const int NGEMM = even ? 221 : 204;
            const int N = even ? NE : NO;
            if (F.G == 256 && l < 3 && F.bid >= NGEMM) { bg_units(F, l == 0 ? 0 : 1, BG_QUOTA); }
            else {
            const int gg = (F.G == 256 && l < 3) ? NGEMM : F.G;
            pg8::Gemm g{WSP(bf16, WS_XN), even ? WSP(bf16, WS_WIE) + (size_t)li * NE * DM : WSP(bf16, WS_WIO) + (size_t)li * NO * DM, MT, N, DM};
            pg8::StaticOrder S; S.init(MT, N, gg, F.bid);
            EpiStoreBf16 E{WSP(bf16, WS_ZB), N};
            pg8::gemm_phase<EpiStoreBf16, pg8::StaticOrder, true, true>(ring, g, S, E);
            }
            SEAM(pb + 0); PROBE_T1(11)
        }
        if (IN(pb + 1)) for (int rep = 0; rep < REP1; ++rep) { LAUNDER(F); PROBE_T0(5) PROBE_T0(10) if (even) { post_even_phase(F, li, l); SEAM(pb + 1); PROBE_T1(5) } else { odd_mix_phase(F, li, l); SEAM(pb + 1); PROBE_T1(10) } }
        if (even) {
            if (IN(pb + 2)) { LAUNDER(F); PROBE_T0(15)
                { int kdim = KLORA; asm volatile("" : "+s"(kdim));
                  pg8::Gemm g{WSP(bf16, WS_LA), WSP(bf16, WS_LORA) + (size_t)li * NLORA * KLORA, MT, NLORA, kdim};
                  constexpr int NLG = 204;
                  if (F.G == 256 && l == 0 && F.bid >= NLG) { bg_units(F, 1, 3, true); }
                  else {
                  pg8::StaticOrder S; S.init(MT, NLORA, (F.G == 256 && l == 0) ? NLG : F.G, F.bid);
                  EpiLora E{WSP(unsigned char, WS_SC), WSP(float, WS_G), KIN(I_W0) + li * 512, KIN(I_A0) + li * 512};
                  pg8::gemm_phase<EpiLora, pg8::StaticOrder, true, true>(ring, g, S, E); } }
                SEAM(pb + 2); PROBE_T1(15)
            }
            if (IN(pb + 4)) for (int rep = 0; rep < REP4; ++rep) { LAUNDER(F); PROBE_T0(2) mix_even_phase(F, li, rep); SEAM(pb + 4); PROBE_T1(2) }
        }
        if (IN(pb + 6)) { LAUNDER(F); PROBE_T0(12)
            const bf16* Wt = even ? WSP(bf16, WS_WOE) + (size_t)li * DM * DM : WSP(bf16, WS_WOO) + (size_t)li * DM * DM;
            pg8::Gemm g{WSP(bf16, WS_MIX), Wt, MP, DM, DM};
            pg8::StaticOrder S; S.init(MP, DM, F.G, F.bid);
            EpiResid E{l == 0 ? KIN(I_XP) : nullptr, WSP(bf16, WS_XN), nullptr, SSQP(2 * l + 1)};
            pg8::gemm_phase<EpiResid, pg8::StaticOrder, true, true>(ring, g, S, E);
            __syncthreads(); LAUNDER(F);
            gemm64_sample_phase<DM>(F, WSP(bf16, WS_MIX) + (size_t)MP * DM, Wt, l == 0 ? KIN(I_XS) : nullptr, WSP(bf16, WS_XN) + (size_t)MP * DM, nullptr, SSQP(2 * l + 1) + MP);
            SEAM(pb + 6); PROBE_T1(12)
        }
        if (IN(pb + 8)) for (int rep = 0; rep < REP7; ++rep) { LAUNDER(F); PROBE_T0(13)
            constexpr int NUPG = 250, UP_BG_QUOTA = 7;
            if (F.G == 256 && l < 2 && F.bid >= NUPG) { bg_units(F, 1, UP_BG_QUOTA); }
            else {
            pg8::Gemm g{WSP(bf16, WS_XN), WSP(bf16, WS_WUP) + (size_t)l * NUP * DM, MT, NUP, DM};
            pg8::StaticOrder S; S.init(MT, NUP, (F.G == 256 && l < 2) ? NUPG : F.G, F.bid);
            EpiFfnAct E{WSP(bf16, WS_H), WSP(float, WS_HALO), KIN(I_FCONV) + (size_t)l * 3 * DFF, SSQP(2 * l + 1), KIN(I_SFFN) + (size_t)l * 2 * DFF, OUTF + O_FFP, OUTF + O_FFS, l};
            pg8::gemm_phase<EpiFfnAct, pg8::StaticOrder, true, true>(ring, g, S, E);
            }
            SEAM(pb + 8); PROBE_T1(13)
        }
        if (IN(pb + 10)) { LAUNDER(F); PROBE_T0(14)
            pg8::Gemm g{WSP(bf16, WS_H), WSP(bf16, WS_WDN) + (size_t)l * DM * DFF, MP, DM, DFF};
            pg8::StaticOrder S; S.init(MP, DM, F.G, F.bid);
            for (int i = 0;; ++i) {
                const int nM = MP / 256, nN = DM / 256, nwg = nM * nN; const long L = (long)i * F.G + F.bid; if (L >= nwg) break;
                int wgid = (int)L; { const int q = nwg / 8, r = nwg % 8, xcd = wgid % 8, off = wgid / 8; wgid = (xcd < r ? xcd * (q + 1) : r * (q + 1) + (xcd - r) * q) + off; }
                const int nig = 8 * nN, gid = wgid / nig, fm = gid * 8, gsz = (nM - fm) < 8 ? (nM - fm) : 8;
                ffn_fix_panel(F, l, fm + ((wgid % nig) % gsz)); }
            LAUNDER(F);
            EpiResid E{nullptr, WSP(bf16, WS_XN), l + 1 < DEPTH ? nullptr : OUTF, SSQP(2 * l + 2 < 8 ? 2 * l + 2 : 0)};
            pg8::gemm_phase<EpiResid, pg8::StaticOrder, true, true>(ring, g, S, E);
            __syncthreads(); LAUNDER(F);
            gemm64_sample_phase<DFF>(F, WSP(bf16, WS_H) + (size_t)MP * DFF, WSP(bf16, WS_WDN) + (size_t)l * DM * DFF, nullptr, WSP(bf16, WS_XN) + (size_t)MP * DM, l + 1 < DEPTH ? nullptr : OUTF + (size_t)MP * DM, SSQP(2 * l + 2 < 8 ? 2 * l + 2 : 0) + MP);
            if (l + 1 < DEPTH) SEAM(pb + 10); PROBE_T1(14)
        }
    }
#undef IN
#undef SEAM
#ifdef PROBE_SUM
    if (PROBE_ID != 0) { __syncthreads(); if (F.tid == 0) __hip_atomic_fetch_add((unsigned*)(F.ctl + 40), (unsigned)F.MISC[20], RLX_AGENT);
        asm volatile("" : "+s"(bar.bar)); asm volatile("" : "+s"(bar.x)); xcd_barrier(bar);
        if (F.bid == 0 && F.tid == 0) { const unsigned long long t0 = __builtin_amdgcn_s_memrealtime(), dt = (unsigned long long)__hip_atomic_load((unsigned*)(F.ctl + 40), RLX_AGENT) * PROBE_MUL / 256;
            while (__builtin_amdgcn_s_memrealtime() - t0 < dt) __builtin_amdgcn_s_sleep(8); } }
#else
    if (PROBE_ID != 0) { __syncthreads(); if (F.tid == 0) { const unsigned long long t0 = __builtin_amdgcn_s_memrealtime(), dt = (unsigned long long)F.MISC[20] * PROBE_MUL;
        while (__builtin_amdgcn_s_memrealtime() - t0 < dt) __builtin_amdgcn_s_sleep(8); } }
#endif
}

extern "C" void kernel_launch(void* const* d_in, const int* in_sizes, int n_in, void* d_out, int out_size, void* d_ws, size_t ws_size, hipStream_t stream) {
    static int grid = 0;
    if (grid == 0) {
        if (n_in != N_IN || (size_t)out_size != O_END || ws_size < WS_END) { fprintf(stderr, "kernel_launch: unexpected shapes: n_in %d out %d ws %zu (need %zu)\n", n_in, out_size, ws_size, (size_t)WS_END); grid = -1; return; }
        int dev = 0, cus = 0, per_cu = 0;
        if (hipGetDevice(&dev) != hipSuccess || hipDeviceGetAttribute(&cus, hipDeviceAttributeMultiprocessorCount, dev) != hipSuccess) { grid = -1; return; }
        if (hipFuncSetAttribute((const void*)mk_fwd, hipFuncAttributeMaxDynamicSharedMemorySize, LDS_BYTES) != hipSuccess) { fprintf(stderr, "kernel_launch: hipFuncSetAttribute failed\n"); grid = -1; return; }
        if (hipOccupancyMaxActiveBlocksPerMultiprocessor(&per_cu, (const void*)mk_fwd, NTHREADS, LDS_BYTES) != hipSuccess || per_cu < 1) { fprintf(stderr, "kernel_launch: occupancy query says %d\n", per_cu); }
        (void)hipGetLastError();
        grid = cus;
        if (cus != 256) { fprintf(stderr, "kernel_launch: built for a 256-CU device (the mix phase splits the grid 128 + 128), found %d CUs\n", cus); if (cus > 256) grid = 256; }
    }
    if (grid < 0) return;
    if (hipMemsetAsync((char*)d_ws + WS_CTL, 0, CTL_RESERVED, stream) != hipSuccess) return;
    Args a{};
    for (int i = 0; i < N_IN; ++i) a.in[i] = (const float*)d_in[i];
    a.out = (float*)d_out; a.ws = (unsigned char*)d_ws;
#if MK_PER_PHASE
    for (int p = 0; p < N_PHASES; ++p) {
        if (p > 0) { const int l = (p - 1) / PH_PER_LAYER, q = (p - 1) % PH_PER_LAYER; if ((l & 1) && q >= 2 && q <= 5) continue; if (l == DEPTH - 1 && q == 11) continue; }
        a.ph_lo = p; a.ph_hi = p + 1;
        hipLaunchKernelGGL(mk_fwd, dim3(grid), dim3(NTHREADS), LDS_BYTES, stream, a);
    }
#else
    a.ph_lo = 0; a.ph_hi = N_PHASES;
    hipLaunchKernelGGL(mk_fwd, dim3(grid), dim3(NTHREADS), LDS_BYTES, stream, a);
#endif
    const hipError_t le = hipPeekAtLastError();
    if (le != hipSuccess) fprintf(stderr, "kernel_launch: launch failed: %s\n", hipGetErrorName(le));
}
```
